# Optimizing an MI355X kernel written in HIP

```python
import math
import jax, jax.numpy as jnp
from jax import lax
import numpy as np

D_MODEL = 2048
BATCH = 32
SEQ = 256
DEPTH = 2
DEC_BATCH = 8
DEC_SEQ = 1024
PAST_LEN = 256

GRID_W = 64
D_MIX = D_MODEL
N_MIXERS = 4
D_BRANCH = D_MIX // N_MIXERS
N_FFT_GROUPS = 4
FFT_GROUP = D_BRANCH // N_FFT_GROUPS
POOL_WINDOWS = (2, 4, 8, 16)
POOL_GROUP = D_BRANCH // len(POOL_WINDOWS)
N_ATT_HEADS = 4
DIFF_HEAD = D_BRANCH // (2 * N_ATT_HEADS)
QK_DIM = 2 * DIFF_HEAD
V_DIM = 2 * DIFF_HEAD
N_FREQ = DIFF_HEAD // 4
CONV_WIDTH = 31
ROPE_BASE = 10000.0
EPS = 1e-6
Q_BLOCK = 128
N_IN_CHUNKS = 11
D_IN_PROJ = N_IN_CHUNKS * D_BRANCH

kernel_name = 'hybrid_diffusion_parallel_mixer_step'


def rmsnorm(x, g):
    xf = x.astype(jnp.float32)
    y = xf * lax.rsqrt(jnp.mean(xf * xf, axis=-1, keepdims=True) + EPS)
    return (y * g.astype(jnp.float32)).astype(x.dtype)


def layernorm(x, g, b):
    xf = x.astype(jnp.float32)
    mu = jnp.mean(xf, axis=-1, keepdims=True)
    var = jnp.mean(jnp.square(xf - mu), axis=-1, keepdims=True)
    y = (xf - mu) * lax.rsqrt(var + EPS)
    return (y * g.astype(jnp.float32) + b.astype(jnp.float32)).astype(x.dtype)


def axial_rope_tables(rows):
    t_row = jnp.repeat(jnp.arange(rows), GRID_W).astype(jnp.float32)
    t_col = jnp.tile(jnp.arange(GRID_W), rows).astype(jnp.float32)
    inv = ROPE_BASE ** (-jnp.arange(N_FREQ, dtype=jnp.float32) / N_FREQ)
    ang = jnp.stack([t_row[:, None] * inv, t_col[:, None] * inv], axis=1)
    return jnp.cos(ang), jnp.sin(ang)


def apply_rope(x, cos, sin):
    xs = x.astype(jnp.float32).reshape(x.shape[:-1] + (2, 2, N_FREQ))
    x1, x2 = xs[..., 0, :], xs[..., 1, :]
    cs, sn = cos[:, None], sin[:, None]
    y = jnp.stack([x1 * cs - x2 * sn, x2 * cs + x1 * sn], axis=-2)
    return y.reshape(x.shape).astype(x.dtype)


def fourier_mix(u, w_f):
    b, s, _ = u.shape
    uf = u.astype(jnp.float32).reshape(b, s, N_FFT_GROUPS, FFT_GROUP)
    mixed = jnp.fft.fft2(uf, axes=(1, 3), norm='ortho').real
    return mixed.reshape(b, s, D_BRANCH).astype(u.dtype) @ w_f


def pool_mix(u, w_pool, pool_scale):
    b, s, _ = u.shape
    uf = u.astype(jnp.float32)
    cs = jnp.pad(jnp.cumsum(uf, axis=1), ((0, 0), (1, 0), (0, 0)))
    t = jnp.arange(s)
    outs = []
    for gi, w in enumerate(POOL_WINDOWS):
        lo = jnp.clip(t - w // 2, 0, s)
        hi = jnp.clip(t - w // 2 + w, 0, s)
        sl = slice(gi * POOL_GROUP, (gi + 1) * POOL_GROUP)
        csg = cs[..., sl]
        mean = (csg[:, hi] - csg[:, lo]) / (hi - lo).astype(jnp.float32)[:, None]
        outs.append(mean - uf[..., sl])
    pooled = jnp.stack(outs, axis=2).astype(u.dtype)
    mixed = jnp.einsum('bsgc,gcd->bsgd', pooled, w_pool)
    return mixed.reshape(b, s, D_BRANCH) * pool_scale


def conv_module(a, g_glu, dw, dw_b, ln_g, ln_b, w_pw):
    u = a * jax.nn.sigmoid(g_glu)
    pad = CONV_WIDTH // 2
    y = lax.conv_general_dilated(u, dw[:, None, :].astype(u.dtype), window_strides=(1,),
                                 padding=[(pad, pad)], dimension_numbers=('NWC', 'WIO', 'NWC'),
                                 feature_group_count=D_BRANCH) + dw_b
    y = jax.nn.silu(layernorm(y, ln_g, ln_b))
    return y @ w_pw


def diff_attention(q, k, v, lam):
    b, h, sq = q.shape[:3]
    nblk = sq // Q_BLOCK
    qb = jnp.moveaxis(q.reshape(b, h, nblk, Q_BLOCK, 2, DIFF_HEAD), 2, 0)

    def block(qi):
        s = jnp.einsum('bhqmd,bhkmd->bhmqk', qi, k,
                       preferred_element_type=jnp.float32) * (DIFF_HEAD ** -0.5)
        p = jax.nn.softmax(s, axis=-1)
        att = p[:, :, 0] - lam * p[:, :, 1]
        return jnp.einsum('bhqk,bhkv->bhqv', att.astype(v.dtype), v)

    ob = lax.map(block, qb)
    return jnp.moveaxis(ob, 0, 2).reshape(b, h, sq, V_DIM)


def trunk_layer(x, cvec, l, p, rope=None, ctx_k=None, ctx_v=None):
    b, s, _ = x.shape
    shift, scale, gate = jnp.split(jax.nn.silu(cvec) @ p['w_mod'][l] + p['b_mod'][l], 3, axis=-1)
    h = rmsnorm(x, p['norm_g'][l]) * (1 + scale) + shift
    (f_x, f_g, p_x, p_g, q, k, v, a_g, c_a, c_b, c_g) = jnp.split(h @ p['w_in'][l], N_IN_CHUNKS, axis=-1)
    y_f = fourier_mix(f_x, p['w_fourier'][l]) * jax.nn.silu(f_g)
    y_p = pool_mix(p_x, p['w_pool'][l], p['pool_scale'][l]) * jax.nn.silu(p_g)
    y_c = conv_module(c_a, c_b, p['conv_dw'][l], p['conv_dw_b'][l], p['conv_ln_g'][l],
                      p['conv_ln_b'][l], p['w_conv_pw'][l]) * jax.nn.silu(c_g)
    q = q.reshape(b, s, N_ATT_HEADS, 2, DIFF_HEAD).transpose(0, 2, 1, 3, 4)
    k = k.reshape(b, s, N_ATT_HEADS, 2, DIFF_HEAD).transpose(0, 2, 1, 3, 4)
    v = v.reshape(b, s, N_ATT_HEADS, V_DIM).transpose(0, 2, 1, 3)
    lam_init = 0.8 - 0.6 * math.exp(-0.3 * l)
    lq1, lk1, lq2, lk2 = p['diff_lambda'][l].astype(jnp.float32)
    lam = jnp.exp(jnp.sum(lq1 * lk1)) - jnp.exp(jnp.sum(lq2 * lk2)) + lam_init
    if rope is None:
        o = diff_attention(q, k, v, lam)
    else:
        cos, sin = rope
        k_all = jnp.concatenate([ctx_k, apply_rope(k, cos, sin)], axis=2)
        v_all = jnp.concatenate([ctx_v, v], axis=2)
        o = diff_attention(apply_rope(q, cos, sin), k_all, v_all, lam)
    o = rmsnorm(o, p['subln_g'][l]) * (1 - lam_init)
    y_a = o.transpose(0, 2, 1, 3).reshape(b, s, D_BRANCH) * jax.nn.silu(a_g)
    y = jnp.concatenate([y_f, y_p, y_a, y_c], axis=-1) @ p['w_out'][l]
    return x + gate * y, k, v


def setup_inputs(seed: int = 0) -> dict:
    key = jax.random.key(seed)
    ks = jax.random.split(key, 24)
    f32 = jnp.float32

    def nrm(k, shape, scale=1.0):
        return jax.random.normal(k, shape, f32) * scale

    return {
        'x_prompt': nrm(ks[0], (BATCH, SEQ, D_MODEL)),
        'x_sample': nrm(ks[1], (DEC_BATCH, DEC_SEQ, D_MODEL)),
        'cache_k': nrm(ks[2], (DEC_BATCH, DEPTH, N_ATT_HEADS, PAST_LEN, QK_DIM)),
        'cache_v': nrm(ks[3], (DEC_BATCH, DEPTH, N_ATT_HEADS, PAST_LEN, V_DIM)),
        'c': nrm(ks[4], (DEC_BATCH, D_MODEL)),
        'c_ctx': nrm(ks[5], (D_MODEL,)),
        'norm_g': 1.0 + nrm(ks[6], (DEPTH, D_MODEL), 0.02),
        'w_mod': nrm(ks[7], (DEPTH, D_MODEL, 3 * D_MODEL), 0.3 * D_MODEL ** -0.5),
        'b_mod': nrm(ks[8], (DEPTH, 3 * D_MODEL), 0.02),
        'w_in': nrm(ks[9], (DEPTH, D_MODEL, D_IN_PROJ), D_MODEL ** -0.5),
        'w_fourier': nrm(ks[10], (DEPTH, D_BRANCH, D_BRANCH), D_BRANCH ** -0.5),
        'w_pool': nrm(ks[11], (DEPTH, len(POOL_WINDOWS), POOL_GROUP, POOL_GROUP), POOL_GROUP ** -0.5),
        'pool_scale': 1.0 + nrm(ks[12], (DEPTH, D_BRANCH), 0.02),
        'diff_lambda': nrm(ks[13], (DEPTH, 4, DIFF_HEAD), 0.1),
        'subln_g': 1.0 + nrm(ks[14], (DEPTH, V_DIM), 0.02),
        'conv_dw': nrm(ks[15], (DEPTH, CONV_WIDTH, D_BRANCH), CONV_WIDTH ** -0.5),
        'conv_dw_b': nrm(ks[16], (DEPTH, D_BRANCH), 0.02),
        'conv_ln_g': 1.0 + nrm(ks[17], (DEPTH, D_BRANCH), 0.02),
        'conv_ln_b': nrm(ks[18], (DEPTH, D_BRANCH), 0.02),
        'w_conv_pw': nrm(ks[19], (DEPTH, D_BRANCH, D_BRANCH), D_BRANCH ** -0.5),
        'w_out': nrm(ks[20], (DEPTH, D_MIX, D_MODEL), D_MIX ** -0.5),
        'final_g': 1.0 + nrm(ks[21], (D_MODEL,), 0.02),
    }


def reference(x_prompt, x_sample, cache_k, cache_v, c, c_ctx, norm_g, w_mod, b_mod, w_in,
              w_fourier, w_pool, pool_scale, diff_lambda, subln_g, conv_dw, conv_dw_b,
              conv_ln_g, conv_ln_b, w_conv_pw, w_out, final_g):
    p = {'norm_g': norm_g, 'w_mod': w_mod, 'b_mod': b_mod, 'w_in': w_in, 'w_fourier': w_fourier,
         'w_pool': w_pool, 'pool_scale': pool_scale, 'diff_lambda': diff_lambda,
         'subln_g': subln_g, 'conv_dw': conv_dw, 'conv_dw_b': conv_dw_b, 'conv_ln_g': conv_ln_g,
         'conv_ln_b': conv_ln_b, 'w_conv_pw': w_conv_pw, 'w_out': w_out}

    x = x_prompt
    ctx_keys, ctx_vals = [], []
    for l in range(DEPTH):
        x, k, v = trunk_layer(x, c_ctx, l, p)
        ctx_keys.append(k.reshape(k.shape[:3] + (QK_DIM,)))
        ctx_vals.append(v)
    y_prompt = rmsnorm(x, final_g)
    new_cache_k = jnp.stack(ctx_keys, axis=1)
    new_cache_v = jnp.stack(ctx_vals, axis=1)

    rows = x_sample.shape[1] // GRID_W
    rope = axial_rope_tables(rows)
    x = x_sample
    for l in range(DEPTH):
        ck = cache_k[:, l]
        ctx_k = ck.reshape(ck.shape[:3] + (2, DIFF_HEAD))
        x, _, _ = trunk_layer(x, c[:, None, :], l, p, rope, ctx_k, cache_v[:, l])
    y_sample = rmsnorm(x, final_g)
    return (y_prompt, y_sample, new_cache_k, new_cache_v)
```

```cpp
#include <hip/hip_runtime.h>
#include <hip/hip_cooperative_groups.h>
#include <stdint.h>
#include <cstdio>
namespace cg = cooperative_groups;

typedef unsigned short bf16_t;
typedef short bf16x8 __attribute__((ext_vector_type(8)));
typedef short s16x4 __attribute__((ext_vector_type(4)));
typedef float f32x4 __attribute__((ext_vector_type(4)));
typedef float f32x2 __attribute__((ext_vector_type(2)));
typedef unsigned u32x4 __attribute__((ext_vector_type(4)));
typedef unsigned u32x2 __attribute__((ext_vector_type(2)));
#define DI __device__ __forceinline__
#define LDSP __attribute__((address_space(3))) void*
#define MFMA16(a, b, c) __builtin_amdgcn_mfma_f32_16x16x32_bf16((a), (b), (c), 0, 0, 0)

constexpr int DM = 2048, NTOK = 16384, NCTX = 8192;
constexpr int LDP = 5120;
constexpr int PC_FX = 0, PC_FG = 512, PC_PX = 1024, PC_PG = 1536, PC_Q = 2048, PC_K = 2560, PC_AG = 3072, PC_CA = 3584, PC_CB = 4096, PC_CG = 4608;
constexpr float EPS = 1e-6f;
constexpr int LDD = 2112;
constexpr int LDZ = 2112;
constexpr int LDC = 576;

constexpr size_t OFF_SYNC = 0;
constexpr size_t OFF_QUEUE = 16384;
constexpr size_t OFF_MODV = 20480;
constexpr size_t SZ_MODV = 2ull * 9 * 6144 * 4;
constexpr size_t ZERO_BYTES = OFF_MODV + SZ_MODV;
constexpr size_t OFF_ROPE = ZERO_BYTES;
constexpr size_t OFF_P = OFF_ROPE + 8192;
constexpr size_t OFF_H = OFF_P + (size_t)NTOK * LDP * 2;
constexpr size_t OFF_ZT = OFF_H + (size_t)NTOK * DM * 2;
constexpr size_t OFF_VTN = OFF_ZT + (32ull * 262144 + 8ull * 512 * LDZ) * 2;
constexpr size_t OFF_POOLED = OFF_VTN + (size_t)NTOK * 512 * 2;
constexpr size_t OFF_CONVACT = OFF_POOLED + (size_t)NTOK * 512 * 2;
constexpr size_t OFF_WINT = OFF_CONVACT + (size_t)NTOK * 512 * 2;
constexpr size_t OFF_WOUTT = OFF_WINT + 2ull * 5632 * 2048 * 2;
constexpr size_t OFF_WCST = OFF_WOUTT + 2ull * 2048 * 2048 * 2;
constexpr size_t OFF_WPOOLT = OFF_WCST + 2ull * 1024 * 512 * 2;
constexpr size_t OFF_WPWT = OFF_WPOOLT + 2ull * 2 * 256 * 256 * 2;
constexpr size_t OFF_KC = OFF_WPWT + 2ull * 512 * 512 * 2;
constexpr size_t OFF_VTC = OFF_KC + 8ull * 2 * 4 * 256 * 128 * 2;
constexpr size_t OFF_DCTX = OFF_VTC + 8ull * 2 * 4 * 256 * 128 * 2;
constexpr size_t OFF_DDEC = OFF_DCTX + 256ull * LDC * 2;
constexpr size_t OFF_SMALL = OFF_DDEC + 1024ull * LDD * 2;
constexpr int SM_NORMG = 0, SM_POOLSC = 4096, SM_DLAM = 5120, SM_SUBLN = 5632, SM_DW = 5888, SM_DWB = 37632, SM_LNG = 38656, SM_LNB = 39680, SM_FINALG = 40704, SM_TOTAL = 42752;
constexpr size_t WS_TOTAL = OFF_SMALL + (size_t)SM_TOTAL * 4;
static_assert(WS_TOTAL <= 402653184ull, "workspace too large");

struct Params {
  const float *x_prompt, *x_sample, *cache_k, *cache_v, *c, *c_ctx, *norm_g, *w_mod, *b_mod, *w_in, *w_fourier, *w_pool,
      *pool_scale, *diff_lambda, *subln_g, *conv_dw, *conv_dw_b, *conv_ln_g, *conv_ln_b, *w_conv_pw, *w_out, *final_g;
  float* out;
  unsigned char* ws;
  unsigned long long never;
};

extern __shared__ __attribute__((aligned(16))) char g_smem[];
constexpr size_t kDynLds = 131072;
#define HSM (g_smem + (half_id() << 16))
__shared__ unsigned g_sh[4];

#define SMALLP(p, off) ((const float*)((p).ws + OFF_SMALL) + (off))
DI size_t slab_idx(int row, int col, int nrows) { return ((size_t)(col >> 5) * nrows + row) * 32 + (col & 31); }
DI float bf2f(unsigned u16) { return __uint_as_float(u16 << 16); }
DI float bflo(unsigned w) { return __uint_as_float(w << 16); }
DI float bfhi(unsigned w) { return __uint_as_float(w & 0xffff0000u); }
DI unsigned pack_bf16(float lo, float hi) { unsigned r; asm("v_cvt_pk_bf16_f32 %0, %1, %2" : "=v"(r) : "v"(lo), "v"(hi)); return r; }
DI float silu_f(float x) { return x * __builtin_amdgcn_rcpf(1.f + __expf(-x)); }
DI float sigmoid_f(float x) { return __builtin_amdgcn_rcpf(1.f + __expf(-x)); }
DI int opaque_tid() { int t = threadIdx.x; asm volatile("" : "+v"(t)); return t; }
DI int half_tid() { return opaque_tid() & 255; }
DI int half_id() { return opaque_tid() >> 8; }
DI float wave_sum(float v) {
#pragma unroll
  for (int o = 32; o >= 1; o >>= 1) v += __shfl_xor(v, o);
  return v;
}
typedef __bf16 bf2_t __attribute__((ext_vector_type(2)));
DI float dot2bf(unsigned a, unsigned b, float c) { return __builtin_amdgcn_fdot2_f32_bf16(__builtin_bit_cast(bf2_t, a), __builtin_bit_cast(bf2_t, b), c, false); }
DI float xrow_max(float v) {
  u32x2 r = __builtin_amdgcn_permlane16_swap(__float_as_uint(v), __float_as_uint(v), false, false);
  v = fmaxf(__uint_as_float(r[0]), __uint_as_float(r[1]));
  r = __builtin_amdgcn_permlane32_swap(__float_as_uint(v), __float_as_uint(v), false, false);
  return fmaxf(__uint_as_float(r[0]), __uint_as_float(r[1]));
}
DI float xrow_sum(float v) {
  u32x2 r = __builtin_amdgcn_permlane16_swap(__float_as_uint(v), __float_as_uint(v), false, false);
  v = __uint_as_float(r[0]) + __uint_as_float(r[1]);
  r = __builtin_amdgcn_permlane32_swap(__float_as_uint(v), __float_as_uint(v), false, false);
  return __uint_as_float(r[0]) + __uint_as_float(r[1]);
}
DI u32x2 pack4(f32x4 v) { u32x2 r; r.x = pack_bf16(v[0], v[1]); r.y = pack_bf16(v[2], v[3]); return r; }

#define XB_TMO      128
#define XB_XCNT(j)  (256  + 64 * (j))
#define XB_XSUB(j)  (1280 + 64 * (j))
#define XB_XGEN(j)  (2304 + 64 * (j))
#define XB_TOP      3328
#define XB_TOPGEN   3392
#define XB_SPIN_CAP (1u << 20)
DI unsigned xb_ld(unsigned* p) { return __hip_atomic_load(p, __ATOMIC_RELAXED, __HIP_MEMORY_SCOPE_AGENT); }
DI unsigned xb_add(unsigned* p, unsigned v) { return __hip_atomic_fetch_add(p, v, __ATOMIC_RELAXED, __HIP_MEMORY_SCOPE_AGENT); }
DI unsigned xb_xcc_id() { return (unsigned)__builtin_amdgcn_s_getreg((3 << 11) | 20) & 0xFu; }
#define XB_SPIN(cond, bar) do { unsigned _sp = 0; while (cond) { __builtin_amdgcn_s_sleep(1); \
    if ((++_sp & 255u) == 0u) { if (xb_ld(&(bar)[XB_TMO])) break; if (_sp > XB_SPIN_CAP) { atomicAdd(&(bar)[XB_TMO], 1u); break; } } } } while (0)
DI void xcd_barrier_complete(unsigned* bar, unsigned x, unsigned& nloc, unsigned& nx) {
  const unsigned G = gridDim.x;
  unsigned sum, cnt, mine, sp = 0u;
  for (;;) {
    sum = 0u; cnt = 0u; mine = 0u;
#pragma unroll
    for (unsigned j = 0; j < 16; ++j) { const unsigned c = xb_ld(&bar[XB_XCNT(j)]); sum += c; cnt += (c > 0u) ? 1u : 0u; mine = (j == x) ? c : mine; }
    if (sum == G) break;
    __builtin_amdgcn_s_sleep(1);
    if ((++sp & 255u) == 0u) { if (xb_ld(&bar[XB_TMO])) break; if (sp > XB_SPIN_CAP) { atomicAdd(&bar[XB_TMO], 1u); break; } }
  }
  nloc = mine > 0u ? mine : 1u; nx = cnt > 0u ? cnt : 1u;
}
DI void grid_barrier(unsigned* bar, unsigned) {
  asm volatile("s_waitcnt vmcnt(0)" ::: "memory");
  __syncthreads();
  if (threadIdx.x == 0) {
    __builtin_amdgcn_s_waitcnt(0);
    const unsigned x = xb_xcc_id();
    volatile unsigned* st = g_sh;
    unsigned nloc = st[1], nx = st[2];
    if (nloc == 0u) { xcd_barrier_complete(bar, x, nloc, nx); st[1] = nloc; st[2] = nx; }
    const unsigned old = xb_add(&bar[XB_XSUB(x)], 1u);
    const unsigned gen = old / nloc;
    if (old + 1u == (gen + 1u) * nloc) {
      __builtin_amdgcn_fence(__ATOMIC_RELEASE, "agent");
      asm volatile("s_waitcnt vmcnt(0)" ::: "memory");
      const unsigned og = xb_add(&bar[XB_TOP], 1u);
      const unsigned tg = og / nx;
      if (og + 1u == (tg + 1u) * nx) xb_add(&bar[XB_TOPGEN], 1u);
      else XB_SPIN(xb_ld(&bar[XB_TOPGEN]) == tg, bar);
      __builtin_amdgcn_fence(__ATOMIC_ACQUIRE, "agent");
      xb_add(&bar[XB_XGEN(x)], 1u);
      asm volatile("s_waitcnt vmcnt(0)" ::: "memory");
    } else {
      XB_SPIN(xb_ld(&bar[XB_XGEN(x)]) == gen, bar);
      __builtin_amdgcn_fence(__ATOMIC_ACQUIRE, "agent");
      asm volatile("s_waitcnt vmcnt(0)" ::: "memory");
    }
  }
  __syncthreads();
}

DI int queue_next(unsigned* q) {
  __syncthreads();
  if (threadIdx.x == 0) g_sh[0] = __hip_atomic_fetch_add(q, 1u, __ATOMIC_RELAXED, __HIP_MEMORY_SCOPE_AGENT);
  __syncthreads();
  return (int)g_sh[0];
}

template <int CTRL, int ROWMASK> DI float dpp_add(float v) {
  const int t = __builtin_amdgcn_update_dpp(0, __float_as_int(v), CTRL, ROWMASK, 0xf, false);
  return v + __int_as_float(t);
}
DI float wave_sum_dpp(float v) {
  v = dpp_add<0x111, 0xf>(v); v = dpp_add<0x112, 0xf>(v); v = dpp_add<0x114, 0xf>(v); v = dpp_add<0x118, 0xf>(v);
  v = dpp_add<0x142, 0xa>(v); v = dpp_add<0x143, 0xc>(v);
  return __int_as_float(__builtin_amdgcn_readlane(__float_as_int(v), 63));
}

template <bool TRANS, bool PERM, int MI = 8>
DI void gemm_main(const bf16_t* A, int lda, size_t ksA, const bf16_t* B, int ldb, size_t ksB, int K, f32x4 (&acc)[MI][4]) {
  const int tid = opaque_tid(), lane = tid & 63, wid = tid >> 6, wr = wid >> 2, wc = wid & 3, fr = lane & 15, fq = lane >> 4;
  const int lrow = tid >> 2, lch = tid & 3;
  const int lsw = (lch ^ (((lrow >> 3) & 1) << 1)) * 8;
  const bf16_t* ga = A + (size_t)lrow * lda + lsw;
  const int rho = lrow & 31;
  const int lrow_b = PERM ? ((lrow & ~31) | (8 * ((rho & 15) >> 2) + 4 * (rho >> 4) + (rho & 3))) : lrow;
  const bf16_t* gb = B + (size_t)lrow_b * ldb + lsw;
  const size_t sa = (size_t)128 * lda, sb = (size_t)128 * ldb;
#pragma unroll
  for (int mi = 0; mi < MI; ++mi)
#pragma unroll
    for (int ni = 0; ni < 4; ++ni) acc[mi][ni] = (f32x4){0.f, 0.f, 0.f, 0.f};
  char* lbase = g_smem + tid * 16;
#define GLDS_ISSUE(STG)                                                                                              \
  do {                                                                                                               \
    char* l_ = lbase + (STG) * 32768;                                                                                \
    __builtin_amdgcn_global_load_lds((const unsigned*)(ga), (LDSP)(l_), 16, 0, 0);                                   \
    if (MI == 8) __builtin_amdgcn_global_load_lds((const unsigned*)(ga + sa), (LDSP)(l_ + 8192), 16, 0, 0);          \
    __builtin_amdgcn_global_load_lds((const unsigned*)(gb), (LDSP)(l_ + 16384), 16, 0, 0);                           \
    __builtin_amdgcn_global_load_lds((const unsigned*)(gb + sb), (LDSP)(l_ + 24576), 16, 0, 0);                      \
    ga += ksA; gb += ksB;                                                                                            \
  } while (0)
  asm volatile("s_waitcnt vmcnt(0)" ::: "memory");
  __syncthreads();
  const int nk = K >> 5;
  GLDS_ISSUE(0);
  GLDS_ISSUE(1);
  GLDS_ISSUE(2);
  const int rsw = (fq ^ (((fr >> 3) & 1) << 1)) * 16;
  const int aofs = (wr * (MI * 16) + fr) * 64 + rsw;
  const int bofs = 16384 + (wc * 64 + fr) * 64 + rsw;
  if (MI == 8) asm volatile("s_waitcnt vmcnt(8)" ::: "memory"); else asm volatile("s_waitcnt vmcnt(6)" ::: "memory");
  __builtin_amdgcn_s_barrier();
  if (wid >= 4) __builtin_amdgcn_s_barrier();
  int scur = 0, snxt = 3;
  for (int kt = 0; kt < nk; ++kt) {
    const char* st = g_smem + scur * 32768;
    bf16x8 af[MI], bfr[4];
#pragma unroll
    for (int mi = 0; mi < MI; ++mi) af[mi] = *(const bf16x8*)(st + aofs + mi * 1024);
#pragma unroll
    for (int ni = 0; ni < 4; ++ni) bfr[ni] = *(const bf16x8*)(st + bofs + ni * 1024);
    if (kt + 3 < nk) { GLDS_ISSUE(snxt); if (MI == 8) asm volatile("s_waitcnt vmcnt(8) lgkmcnt(0)" ::: "memory"); else asm volatile("s_waitcnt vmcnt(6) lgkmcnt(0)" ::: "memory"); }
    else if (kt + 2 < nk) { if (MI == 8) asm volatile("s_waitcnt vmcnt(4) lgkmcnt(0)" ::: "memory"); else asm volatile("s_waitcnt vmcnt(3) lgkmcnt(0)" ::: "memory"); }
    else asm volatile("s_waitcnt vmcnt(0) lgkmcnt(0)" ::: "memory");
    __builtin_amdgcn_sched_barrier(0);
    __builtin_amdgcn_s_barrier();
    __builtin_amdgcn_sched_barrier(0);
#pragma unroll
    for (int mi = 0; mi < MI; ++mi)
#pragma unroll
      for (int ni = 0; ni < 4; ++ni)
        acc[mi][ni] = TRANS ? MFMA16(bfr[ni], af[mi], acc[mi][ni]) : MFMA16(af[mi], bfr[ni], acc[mi][ni]);
    __builtin_amdgcn_sched_barrier(0);
    __builtin_amdgcn_s_barrier();
    __builtin_amdgcn_sched_barrier(0);
    scur = (scur + 1) & 3;
    snxt = (snxt + 1) & 3;
  }
  if (wid < 4) __builtin_amdgcn_s_barrier();
#undef GLDS_ISSUE
}

DI void transpose_tile(const float* src, int ldn, bf16_t* dst, int ldk, int k0, int n0, int slab_rows = 0) {
  float* t = (float*)HSM;
  const int tid = half_tid();
  __syncthreads();
  f32x4 v[8];
#pragma unroll
  for (int i = 0; i < 8; ++i) {
    const int idx = tid + i * 256, r = idx >> 5, c4 = (idx & 31) * 4;
    v[i] = *(const f32x4*)(src + (size_t)(k0 + r) * ldn + n0 + c4);
  }
#pragma unroll
  for (int i = 0; i < 8; ++i) {
    const int idx = tid + i * 256, r = idx >> 5, c4 = (idx & 31) * 4;
    t[r * 129 + c4 + 0] = v[i][0]; t[r * 129 + c4 + 1] = v[i][1]; t[r * 129 + c4 + 2] = v[i][2]; t[r * 129 + c4 + 3] = v[i][3];
  }
  __syncthreads();
#pragma unroll
  for (int i = 0; i < 4; ++i) {
    const int idx = tid + i * 256, n = idx >> 3, kc = (idx & 7) * 8;
    u32x4 o;
    o[0] = pack_bf16(t[(kc + 0) * 129 + n], t[(kc + 1) * 129 + n]);
    o[1] = pack_bf16(t[(kc + 2) * 129 + n], t[(kc + 3) * 129 + n]);
    o[2] = pack_bf16(t[(kc + 4) * 129 + n], t[(kc + 5) * 129 + n]);
    o[3] = pack_bf16(t[(kc + 6) * 129 + n], t[(kc + 7) * 129 + n]);
    if (slab_rows) *(u32x4*)(dst + slab_idx(n0 + n, k0 + kc, slab_rows)) = o;
    else *(u32x4*)(dst + (size_t)(n0 + n) * ldk + k0 + kc) = o;
  }
}

DI void mod_item(const Params& p, int it) {
  const int tid = half_tid();
  const int l = it / 192, r = it % 192, kc = r / 6, cb = r % 6;
  float* sl = (float*)HSM;
  __syncthreads();
  for (int idx = tid; idx < 576; idx += 256) {
    const int j = idx >> 6, k = idx & 63;
    const float* src = (j == 0) ? p.c_ctx : p.c + (j - 1) * 2048;
    sl[idx] = silu_f(src[kc * 64 + k]);
  }
  __syncthreads();
  const int col = cb * 1024 + tid * 4;
  f32x4 acc[9];
#pragma unroll
  for (int j = 0; j < 9; ++j) acc[j] = (f32x4){0.f, 0.f, 0.f, 0.f};
  const float* w = p.w_mod + ((size_t)l * 2048 + kc * 64) * 6144 + col;
#pragma unroll 4
  for (int k = 0; k < 64; ++k) {
    const f32x4 wv = *(const f32x4*)(w + (size_t)k * 6144);
#pragma unroll
    for (int j = 0; j < 9; ++j) acc[j] += wv * sl[j * 64 + k];
  }
  if (kc == 0) {
    const f32x4 bv = *(const f32x4*)(p.b_mod + l * 6144 + col);
#pragma unroll
    for (int j = 0; j < 9; ++j) acc[j] += bv;
  }
  float* modv = (float*)(p.ws + OFF_MODV);
#pragma unroll
  for (int j = 0; j < 9; ++j)
#pragma unroll
    for (int e = 0; e < 4; ++e)
      __hip_atomic_fetch_add(modv + (l * 9 + j) * 6144 + col + e, acc[j][e], __ATOMIC_RELAXED, __HIP_MEMORY_SCOPE_AGENT);
}

DI void fourier_fold_item(const Params& p, int it) {
  const int tid = half_tid();
  const int l = it >> 10, r = it & 1023, k = r >> 1, nb = r & 1;
  const int g = k >> 7, c = k & 127, n = nb * 256 + tid;
  float* tab = (float*)HSM;
  __syncthreads();
  if (tid < 128) { const float rev = (float)tid * (1.f / 128.f); tab[tid] = __builtin_amdgcn_cosf(rev); tab[128 + tid] = __builtin_amdgcn_sinf(rev); }
  __syncthreads();
  const float* w = p.w_fourier + ((size_t)(l * 512 + g * 128)) * 512 + n;
  float ac = 0.f, as = 0.f;
#pragma unroll 16
  for (int j = 0; j < 128; ++j) { const float wv = w[(size_t)j * 512]; const int ti = (c * j) & 127; ac += tab[ti] * wv; as += tab[128 + ti] * wv; }
  bf16_t* dst = (bf16_t*)(p.ws + OFF_WCST);
  dst[((size_t)(l * 1024 + n)) * 512 + k] = (bf16_t)(pack_bf16(ac * 0.08838834764831845f, 0.f) & 0xffffu);
  dst[((size_t)(l * 1024 + 512 + n)) * 512 + k] = (bf16_t)(pack_bf16(as * 0.08838834764831845f, 0.f) & 0xffffu);
}

DI void phase0(const Params& p) {
  const int tid = half_tid();
  constexpr int N_MOD = 384, N_WIN = 2816, N_WOUT = 1024, N_WPW = 64, N_WPOOL = 128, N_CV = 256, N_CK = 1024, N_DCTX = 64, N_DDEC = 1024, N_ROPE = 2, N_FF = 2048, N_SM = 10;
  constexpr int E0 = N_MOD, E1 = E0 + N_WIN, E2 = E1 + N_WOUT, E3 = E2 + N_WPW, E4 = E3 + N_WPOOL, E5 = E4 + N_CV, E6 = E5 + N_CK, E7 = E6 + N_DCTX,
                E8 = E7 + N_DDEC, E9 = E8 + N_ROPE, E10 = E9 + N_FF, E11 = E10 + N_SM;
  for (int itp = blockIdx.x; itp < E11 / 2; itp += gridDim.x) {
    const int it = itp * 2 + half_id();
    if (it < E0) {
      mod_item(p, it);
    } else if (it < E1) {
      const int t = it - E0, l = t / 1408, r = t % 1408, kt = r / 44, nt = r % 44;
      transpose_tile(p.w_in + (size_t)l * 2048 * 5632, 5632, (bf16_t*)(p.ws + OFF_WINT) + (size_t)l * 5632 * 2048, 2048, kt * 64, nt * 128, 5632);
    } else if (it < E2) {
      const int t = it - E1, l = t >> 9, r = t & 511, kt = r >> 4, nt = r & 15;
      transpose_tile(p.w_out + (size_t)l * 2048 * 2048, 2048, (bf16_t*)(p.ws + OFF_WOUTT) + (size_t)l * 2048 * 2048, 2048, kt * 64, nt * 128, 2048);
    } else if (it < E3) {
      const int t = it - E2, l = t >> 5, r = t & 31, kt = r >> 2, nt = r & 3;
      transpose_tile(p.w_conv_pw + (size_t)l * 512 * 512, 512, (bf16_t*)(p.ws + OFF_WPWT) + (size_t)l * 512 * 512, 512, kt * 64, nt * 128);
    } else if (it < E4) {
      const int t = it - E3, lp = t >> 5;
      const int e0 = (t & 31) * 2048 + tid * 8, n = e0 >> 8, k0 = e0 & 255;
      const int g = (lp & 1) * 2 + (n >> 7);
      u32x4 o = (u32x4){0u, 0u, 0u, 0u};
      if ((k0 >> 7) == (n >> 7)) {
        const float* w = p.w_pool + ((size_t)((lp >> 1) * 4 + g) * 128 + (k0 & 127)) * 128 + (n & 127);
#pragma unroll
        for (int e = 0; e < 4; ++e) o[e] = pack_bf16(w[(size_t)(2 * e) * 128], w[(size_t)(2 * e + 1) * 128]);
      }
      *(u32x4*)((bf16_t*)(p.ws + OFF_WPOOLT) + (size_t)lp * 65536 + e0) = o;
    } else if (it < E5) {
      const int t = it - E4, blh = t >> 2, kt = t & 3;
      transpose_tile(p.cache_v + (size_t)blh * 256 * 128, 128, (bf16_t*)(p.ws + OFF_VTC) + (size_t)blh * 128 * 256, 256, kt * 64, 0);
    } else if (it < E6) {
      const size_t e = (size_t)(it - E5) * 2048 + tid * 8;
      const f32x4 a = *(const f32x4*)(p.cache_k + e), b = *(const f32x4*)(p.cache_k + e + 4);
      u32x4 o; o[0] = pack_bf16(a[0], a[1]); o[1] = pack_bf16(a[2], a[3]); o[2] = pack_bf16(b[0], b[1]); o[3] = pack_bf16(b[2], b[3]);
      *(u32x4*)((bf16_t*)(p.ws + OFF_KC) + e) = o;
    } else if (it < E8) {
      const bool dec = it >= E7;
      const int e0 = (dec ? it - E7 : it - E6) * 2048 + tid * 8;
      const int S = dec ? 1024 : 256, sh = dec ? 11 : 9;
      const float nrm = dec ? 0.03125f : 0.0625f, invS = dec ? (1.f / 1024.f) : (1.f / 256.f);
      float v[8];
#pragma unroll
      for (int i = 0; i < 8; ++i) {
        const int e = e0 + i, t = e & (2 * S - 1);
        const int s = e >> sh;
        const int tt = t & (S - 1);
        const float rev = (float)((s * tt) & (S - 1)) * invS;
        v[i] = (t < S) ? __builtin_amdgcn_cosf(rev) * nrm : -__builtin_amdgcn_sinf(rev) * nrm;
      }
      u32x4 o; o[0] = pack_bf16(v[0], v[1]); o[1] = pack_bf16(v[2], v[3]); o[2] = pack_bf16(v[4], v[5]); o[3] = pack_bf16(v[6], v[7]);
      *(u32x4*)((bf16_t*)(p.ws + (dec ? OFF_DDEC : OFF_DCTX)) + (size_t)(e0 >> sh) * (dec ? LDD : LDC) + (e0 & (2 * S - 1))) = o;
    } else if (it < E9) {
      f32x2* rope = (f32x2*)(p.ws + OFF_ROPE);
#pragma unroll
      for (int i = 0; i < 4; ++i) {
        const int idx = tid + i * 256, pos = idx >> 4, f = idx & 15;
        const float inv = exp2f(-(float)f * (13.287712379549449f / 16.f));
        const float ang = (float)pos * inv;
        float rev = ang * 0.15915494309189535f;
        rev -= floorf(rev);
        f32x2 cs; cs.x = __builtin_amdgcn_cosf(rev); cs.y = __builtin_amdgcn_sinf(rev);
        rope[idx] = cs;
      }
    } else if (it < E10) {
      fourier_fold_item(p, it - E9);
    } else {
      const int j = it - E10;
      const float* src; int n, off;
      switch (j) {
        case 0: src = p.norm_g; n = 4096; off = SM_NORMG; break;
        case 1: src = p.pool_scale; n = 1024; off = SM_POOLSC; break;
        case 2: src = p.diff_lambda; n = 512; off = SM_DLAM; break;
        case 3: src = p.subln_g; n = 256; off = SM_SUBLN; break;
        case 4: src = p.conv_dw; n = 31744; off = SM_DW; break;
        case 5: src = p.conv_dw_b; n = 1024; off = SM_DWB; break;
        case 6: src = p.conv_ln_g; n = 1024; off = SM_LNG; break;
        case 7: src = p.conv_ln_b; n = 1024; off = SM_LNB; break;
        case 8: src = p.final_g; n = 2048; off = SM_FINALG; break;
        default: src = p.final_g; n = 0; off = SM_FINALG; break;
      }
      float* dst = (float*)(p.ws + OFF_SMALL) + off;
      for (int i = tid; i < n; i += 256) dst[i] = src[i];
    }
  }
}

DI const float* x_row_l0(const Params& p, int m) { return (m < NCTX) ? p.x_prompt + (size_t)m * DM : p.x_sample + (size_t)(m - NCTX) * DM; }
DI int cvec_of_row(int m) { return (m < NCTX) ? 0 : 1 + ((m - NCTX) >> 10); }

DI void norm_phase(const Params& p, int l) {
  const int tid_ = opaque_tid(); const int lane = tid_ & 63, wid = tid_ >> 6;
  const int rr = lane >> 5, q = lane & 31;
  bf16_t* H = (bf16_t*)(p.ws + OFF_H);
  const float* modv = (const float*)(p.ws + OFF_MODV);
  const float* g = SMALLP(p, SM_NORMG) + l * DM;
  for (int mp = blockIdx.x * 8 + wid; mp < NTOK / 2; mp += gridDim.x * 8) {
    const int m = mp * 2 + rr;
    const float* x = (l == 0) ? x_row_l0(p, m) : p.out + (size_t)m * DM;
    const float* mv = modv + (size_t)(l * 9 + cvec_of_row(m)) * 6144;
    f32x4 v[16];
    float ss = 0.f;
#pragma unroll
    for (int i = 0; i < 8; ++i) {
      const int c = i * 256 + q * 8;
      v[2 * i] = *(const f32x4*)(x + c); v[2 * i + 1] = *(const f32x4*)(x + c + 4);
#pragma unroll
      for (int e = 0; e < 4; ++e) ss += v[2 * i][e] * v[2 * i][e] + v[2 * i + 1][e] * v[2 * i + 1][e];
    }
#pragma unroll
    for (int o = 16; o >= 1; o >>= 1) ss += __shfl_xor(ss, o);
    const float rstd = rsqrtf(ss * (1.f / 2048.f) + EPS);
#pragma unroll
    for (int i = 0; i < 8; ++i) {
      const int c = i * 256 + q * 8;
      u32x4 o4;
#pragma unroll
      for (int hh = 0; hh < 2; ++hh) {
        const f32x4 gg = *(const f32x4*)(g + c + 4 * hh), sh = *(const f32x4*)(mv + c + 4 * hh), sc = *(const f32x4*)(mv + 2048 + c + 4 * hh);
        f32x4 h;
#pragma unroll
        for (int e = 0; e < 4; ++e) h[e] = v[2 * i + hh][e] * rstd * gg[e] * (1.f + sc[e]) + sh[e];
        o4[2 * hh] = pack_bf16(h[0], h[1]); o4[2 * hh + 1] = pack_bf16(h[2], h[3]);
      }
      *(u32x4*)(H + slab_idx(m, c, NTOK)) = o4;
    }
  }
}

DI void final_phase(const Params& p) {
  const int tid_ = opaque_tid(); const int lane = tid_ & 63, wid = tid_ >> 6;
  for (int m = blockIdx.x * 8 + wid; m < NTOK; m += gridDim.x * 8) {
    float* x = p.out + (size_t)m * DM;
    f32x4 v[8];
    float ss = 0.f;
#pragma unroll
    for (int i = 0; i < 8; ++i) { v[i] = *(const f32x4*)(x + (i * 64 + lane) * 4); ss += v[i][0] * v[i][0] + v[i][1] * v[i][1] + v[i][2] * v[i][2] + v[i][3] * v[i][3]; }
    ss = wave_sum(ss);
    const float rstd = rsqrtf(ss * (1.f / 2048.f) + EPS);
#pragma unroll
    for (int i = 0; i < 8; ++i) {
      const int c = (i * 64 + lane) * 4;
      const f32x4 gg = *(const f32x4*)(SMALLP(p, SM_FINALG) + c);
      f32x4 h;
#pragma unroll
      for (int e = 0; e < 4; ++e) h[e] = v[i][e] * rstd * gg[e];
      *(f32x4*)(x + c) = h;
    }
  }
}

DI void g1_tile(const Params& p, int l, int t) {
  const int pm = t & 63, pn = t >> 6;
  const int tid = opaque_tid(), lane = tid & 63, wid = tid >> 6, wr = wid >> 2, wc = wid & 3, fr = lane & 15, fq = lane >> 4;
  const bf16_t* A = (const bf16_t*)(p.ws + OFF_H) + (size_t)pm * 256 * 32;
  const bf16_t* B = (const bf16_t*)(p.ws + OFF_WINT) + (size_t)l * 5632 * 2048 + (size_t)pn * 256 * 32;
  bf16_t* P = (bf16_t*)(p.ws + OFF_P);
  const int m0 = pm * 256, n0 = pn * 256;
  const int nw = n0 + wc * 64;
  const bool dec = m0 >= NCTX;
  f32x4 acc[8][4];
  if (pn == 12 || pn == 13) {
    gemm_main<false, false>(A, 32, (size_t)NTOK * 32, B, 32, (size_t)5632 * 32, DM, acc);
    const int vc = nw - 3072, h = vc >> 7;
    bf16_t* vtn = (bf16_t*)(p.ws + OFF_VTN);
    int S, s0; size_t vbase; int b;
    if (!dec) { b = m0 >> 8; S = 256; s0 = 0; vbase = (size_t)b * 131072; }
    else { const int dm = m0 - NCTX; b = dm >> 10; S = 1024; s0 = dm & 1023; vbase = (size_t)32 * 131072 + (size_t)b * 524288; }
    float* ncv = p.out + 41943040ull + ((size_t)((b * 2 + l) * 4 + h)) * 32768;
#pragma unroll
    for (int mi = 0; mi < 8; ++mi)
#pragma unroll
      for (int ni = 0; ni < 4; ++ni) {
        const int s = s0 + wr * 128 + mi * 16 + 4 * fq, dv = (vc & 127) + ni * 16 + fr;
        *(u32x2*)(vtn + vbase + (size_t)(h * 128 + dv) * S + s) = pack4(acc[mi][ni]);
        if (!dec) {
#pragma unroll
          for (int j = 0; j < 4; ++j) ncv[(size_t)(s + j) * 128 + dv] = acc[mi][ni][j];
        }
      }
  } else {
    const int chunk = pn >> 1;
    if (dec && (chunk == 4 || chunk == 5)) {
      gemm_main<true, false>(A, 32, (size_t)NTOK * 32, B, 32, (size_t)5632 * 32, DM, acc);
      const f32x4* rope = (const f32x4*)(p.ws + OFF_ROPE);
#pragma unroll
      for (int mi = 0; mi < 8; ++mi) {
        const int s = (m0 - NCTX + wr * 128 + mi * 16 + fr) & 1023;
        const int prow = s >> 6, pcol = s & 63;
#pragma unroll
        for (int ax = 0; ax < 2; ++ax) {
          const int pos = ax ? pcol : prow;
          const f32x4 t0 = rope[pos * 8 + fq * 2], t1 = rope[pos * 8 + fq * 2 + 1];
          const float cs[4] = {t0[0], t0[2], t1[0], t1[2]}, sn[4] = {t0[1], t0[3], t1[1], t1[3]};
#pragma unroll
          for (int j = 0; j < 4; ++j) {
            const float x1 = acc[mi][ax * 2][j], x2 = acc[mi][ax * 2 + 1][j];
            acc[mi][ax * 2][j] = x1 * cs[j] - x2 * sn[j];
            acc[mi][ax * 2 + 1][j] = x2 * cs[j] + x1 * sn[j];
          }
        }
      }
      const int pc0 = nw + 4 * fq;
#pragma unroll
      for (int mi = 0; mi < 8; ++mi) {
        const int m = m0 + wr * 128 + mi * 16 + fr;
#pragma unroll
        for (int ni = 0; ni < 4; ++ni) *(u32x2*)(P + (size_t)m * LDP + pc0 + ni * 16) = pack4(acc[mi][ni]);
      }
    } else {
      gemm_main<true, true>(A, 32, (size_t)NTOK * 32, B, 32, (size_t)5632 * 32, DM, acc);
      const int pc0 = (nw < 3072 ? nw : nw - 512) + 8 * fq;
#pragma unroll
      for (int mi = 0; mi < 8; ++mi) {
        const int m = m0 + wr * 128 + mi * 16 + fr;
#pragma unroll
        for (int q = 0; q < 2; ++q) {
          u32x4 o; const u32x2 a = pack4(acc[mi][2 * q]), b = pack4(acc[mi][2 * q + 1]);
          o[0] = a.x; o[1] = a.y; o[2] = b.x; o[3] = b.y;
          *(u32x4*)(P + (size_t)m * LDP + pc0 + q * 32) = o;
        }
      }
      if (!dec && chunk == 5) {
        const int kc = nw - 2560, h = kc >> 7;
        const int b = m0 >> 8;
        float* nck = p.out + 33554432ull + ((size_t)((b * 2 + l) * 4 + h)) * 32768;
#pragma unroll
        for (int mi = 0; mi < 8; ++mi) {
          const int s = wr * 128 + mi * 16 + fr;
#pragma unroll
          for (int q = 0; q < 2; ++q) {
            float* dst = nck + (size_t)s * 128 + (kc & 127) + q * 32 + 8 * fq;
            *(f32x4*)dst = acc[mi][2 * q]; *(f32x4*)(dst + 4) = acc[mi][2 * q + 1];
          }
        }
      }
    }
  }
}

DI void g1_half_tile(const Params& p, int l, int ht) {
  const int t = 1280 + (ht >> 1), pm = t & 63, pn = t >> 6;
  const int tid = opaque_tid(), lane = tid & 63, wid = tid >> 6, wr = wid >> 2, wc = wid & 3, fr = lane & 15, fq = lane >> 4;
  const int m0 = pm * 256 + (ht & 1) * 128, nw = pn * 256 + wc * 64;
  const bf16_t* A = (const bf16_t*)(p.ws + OFF_H) + (size_t)m0 * 32;
  const bf16_t* B = (const bf16_t*)(p.ws + OFF_WINT) + (size_t)l * 5632 * 2048 + (size_t)pn * 256 * 32;
  bf16_t* P = (bf16_t*)(p.ws + OFF_P);
  f32x4 acc[4][4];
  gemm_main<true, true, 4>(A, 32, (size_t)NTOK * 32, B, 32, (size_t)5632 * 32, DM, acc);
  const int pc0 = (nw - 512) + 8 * fq;
#pragma unroll
  for (int mi = 0; mi < 4; ++mi) {
    const int m = m0 + wr * 64 + mi * 16 + fr;
#pragma unroll
    for (int q = 0; q < 2; ++q) {
      u32x4 o; const u32x2 a = pack4(acc[mi][2 * q]), b = pack4(acc[mi][2 * q + 1]);
      o[0] = a.x; o[1] = a.y; o[2] = b.x; o[3] = b.y;
      *(u32x4*)(P + (size_t)m * LDP + pc0 + q * 32) = o;
    }
  }
}

template <int MI = 8>
DI void gated_gemm_tile(const Params& p, const bf16_t* A, int lda, const bf16_t* B, int ldb, int K, int tok0, int ncol0, int gcol, int ycol, const float* colscale) {
  const int tid = opaque_tid(), lane = tid & 63, wid = tid >> 6, wr = wid >> 2, wc = wid & 3, fr = lane & 15, fq = lane >> 4;
  f32x4 acc[MI][4];
  gemm_main<true, true, MI>(A, lda, 32, B, ldb, 32, K, acc);
  const bf16_t* P = (const bf16_t*)(p.ws + OFF_P);
  bf16_t* Y = (bf16_t*)(p.ws + OFF_H);
#pragma unroll
  for (int q = 0; q < 2; ++q) {
    const int n = ncol0 + wc * 64 + q * 32 + 8 * fq;
    f32x4 cs0 = (f32x4){1.f, 1.f, 1.f, 1.f}, cs1 = cs0;
    if (colscale) { cs0 = *(const f32x4*)(colscale + n); cs1 = *(const f32x4*)(colscale + n + 4); }
#pragma unroll
    for (int mi = 0; mi < MI; ++mi) {
      const int tok = tok0 + wr * (MI * 16) + mi * 16 + fr;
      const u32x4 gw = *(const u32x4*)(P + (size_t)tok * LDP + gcol + n);
      const f32x4 a0 = acc[mi][2 * q], a1 = acc[mi][2 * q + 1];
      u32x4 o;
      o[0] = pack_bf16(a0[0] * cs0[0] * silu_f(bflo(gw[0])), a0[1] * cs0[1] * silu_f(bfhi(gw[0])));
      o[1] = pack_bf16(a0[2] * cs0[2] * silu_f(bflo(gw[1])), a0[3] * cs0[3] * silu_f(bfhi(gw[1])));
      o[2] = pack_bf16(a1[0] * cs1[0] * silu_f(bflo(gw[2])), a1[1] * cs1[1] * silu_f(bfhi(gw[2])));
      o[3] = pack_bf16(a1[2] * cs1[2] * silu_f(bflo(gw[3])), a1[3] * cs1[3] * silu_f(bfhi(gw[3])));
      *(u32x4*)(Y + slab_idx(tok, ycol + n, NTOK)) = o;
    }
  }
}

DI void z_tile(const Params& p, int l, int t) {
  const int pm = t & 63, pn = t >> 6;
  const int tid = opaque_tid(), lane = tid & 63, wid = tid >> 6, wr = wid >> 2, wc = wid & 3, fr = lane & 15, fq = lane >> 4;
  const bf16_t* A = (const bf16_t*)(p.ws + OFF_P) + (size_t)pm * 256 * LDP + PC_FX;
  const bf16_t* B = (const bf16_t*)(p.ws + OFF_WCST) + ((size_t)l * 1024 + pn * 256) * 512;
  f32x4 acc[8][4];
  gemm_main<false, false>(A, LDP, 32, B, 512, 32, 512, acc);
  bf16_t* ZT = (bf16_t*)(p.ws + OFF_ZT);
  const int m0 = pm * 256;
  int S, t0; size_t base;
  if (m0 < NCTX) { S = 256; t0 = 0; base = (size_t)(m0 >> 8) * 262144; }
  else { const int dm = m0 - NCTX; S = 1024; t0 = dm & 1023; base = 32ull * 262144 + (size_t)(dm >> 10) * 512 * LDZ; }
#pragma unroll
  for (int ni = 0; ni < 4; ++ni) {
    const int np = pn * 256 + wc * 64 + ni * 16 + fr, n = np & 511, half = np >> 9;
    bf16_t* row = ZT + base + (size_t)n * (S == 256 ? 512 : LDZ) + half * S + t0;
#pragma unroll
    for (int mi = 0; mi < 8; ++mi) *(u32x2*)(row + wr * 128 + mi * 16 + 4 * fq) = pack4(acc[mi][ni]);
  }
}

DI void out_tile(const Params& p, int l, int t) {
  const int pm = t & 63, pn = t >> 6;
  const int tid = opaque_tid(), lane = tid & 63, wid = tid >> 6, wr = wid >> 2, wc = wid & 3, fr = lane & 15, fq = lane >> 4;
  const bf16_t* A = (const bf16_t*)(p.ws + OFF_H) + (size_t)pm * 256 * 32;
  const bf16_t* B = (const bf16_t*)(p.ws + OFF_WOUTT) + (size_t)l * 2048 * 2048 + (size_t)pn * 256 * 32;
  f32x4 acc[8][4];
  gemm_main<true, true>(A, 32, (size_t)NTOK * 32, B, 32, (size_t)2048 * 32, DM, acc);
  const int m0 = pm * 256;
  const float* gate = (const float*)(p.ws + OFF_MODV) + (size_t)(l * 9 + cvec_of_row(m0)) * 6144 + 4096;
#pragma unroll
  for (int q = 0; q < 2; ++q) {
    const int n = pn * 256 + wc * 64 + q * 32 + 8 * fq;
    const f32x4 g0 = *(const f32x4*)(gate + n), g1 = *(const f32x4*)(gate + n + 4);
#pragma unroll
    for (int mi = 0; mi < 8; ++mi) {
      const int m = m0 + wr * 128 + mi * 16 + fr;
      const float* xin = ((l == 0) ? x_row_l0(p, m) : p.out + (size_t)m * DM) + n;
      const f32x4 x0 = *(const f32x4*)(xin), x1 = *(const f32x4*)(xin + 4);
      float* dst = p.out + (size_t)m * DM + n;
      *(f32x4*)dst = x0 + g0 * acc[mi][2 * q];
      *(f32x4*)(dst + 4) = x1 + g1 * acc[mi][2 * q + 1];
    }
  }
}

DI void seq_of_tok(int tok0, int& S, int& sbase) {
  if (tok0 < NCTX) { S = 256; sbase = tok0 & ~255; } else { S = 1024; sbase = NCTX + ((tok0 - NCTX) & ~1023); }
}

template <int W>
DI void pool_task(const bf16_t* base, int S, int sA, bf16_t* outp) {
  constexpr int HW = W / 2, NR = 7 + W;
  u32x4 rows[NR];
#pragma unroll
  for (int r = 0; r < NR; ++r) {
    const int s = sA - HW + r;
    const bool ok = (s >= 0) && (s < S);
    const u32x4 v = *(const u32x4*)(base + (size_t)min(max(s, 0), S - 1) * LDP);
#pragma unroll
    for (int e = 0; e < 4; ++e) rows[r][e] = ok ? v[e] : 0u;
  }
  float sum[8];
#pragma unroll
  for (int e = 0; e < 8; ++e) sum[e] = 0.f;
#pragma unroll
  for (int r = 0; r < W; ++r)
#pragma unroll
    for (int e = 0; e < 4; ++e) { sum[2 * e] += bflo(rows[r][e]); sum[2 * e + 1] += bfhi(rows[r][e]); }
#pragma unroll
  for (int k = 0; k < 8; ++k) {
    const int s = sA + k;
    const int lo = max(s - HW, 0), hi = min(s - HW + W, S);
    const float inv = 1.f / (float)(hi - lo);
    const u32x4 xv = rows[k + HW];
    u32x4 o4;
#pragma unroll
    for (int e = 0; e < 4; ++e) o4[e] = pack_bf16(sum[2 * e] * inv - bflo(xv[e]), sum[2 * e + 1] * inv - bfhi(xv[e]));
    *(u32x4*)(outp + (size_t)k * 512) = o4;
    if (k < 7) {
#pragma unroll
      for (int e = 0; e < 4; ++e) {
        sum[2 * e] += bflo(rows[k + W][e]) - bflo(rows[k][e]);
        sum[2 * e + 1] += bfhi(rows[k + W][e]) - bfhi(rows[k][e]);
      }
    }
  }
}

DI void pool_item(const Params& p, int t) {
  const int tid = half_tid(), tok0 = t * 32;
  int S, sbase; seq_of_tok(tok0, S, sbase);
  const int g = tid >> 6, run = (tid >> 4) & 3, c0 = g * 128 + (tid & 15) * 8;
  const int sA = tok0 - sbase + run * 8;
  const bf16_t* base = (const bf16_t*)(p.ws + OFF_P) + (size_t)sbase * LDP + PC_PX + c0;
  bf16_t* outp = (bf16_t*)(p.ws + OFF_POOLED) + (size_t)(sbase + sA) * 512 + c0;
  if (g == 0) pool_task<2>(base, S, sA, outp);
  else if (g == 1) pool_task<4>(base, S, sA, outp);
  else if (g == 2) pool_task<8>(base, S, sA, outp);
  else pool_task<16>(base, S, sA, outp);
}

DI void conv_item(const Params& p, int l, int t) {
  const int tid = half_tid(), lane = tid & 63, wid = tid >> 6, tok0 = t * 32;
  int S, sbase; seq_of_tok(tok0, S, sbase);
  const int s0 = tok0 - sbase;
  const bf16_t* P = (const bf16_t*)(p.ws + OFF_P);
  bf16_t* U = (bf16_t*)HSM;
  float* red = (float*)(HSM + 63488);
#pragma unroll 4
  for (int idx = tid; idx < 62 * 64; idx += 256) {
    const int rr = idx >> 6, ch = (idx & 63) * 8, s = s0 - 15 + rr;
    const bool ok = (s >= 0) && (s < S);
    const int sc = min(max(s, 0), S - 1);
    const bf16_t* row = P + (size_t)(sbase + sc) * LDP;
    const u32x4 a = *(const u32x4*)(row + PC_CA + ch), b = *(const u32x4*)(row + PC_CB + ch);
    u32x4 o;
#pragma unroll
    for (int e = 0; e < 4; ++e) { const unsigned v = pack_bf16(bflo(a[e]) * sigmoid_f(bflo(b[e])), bfhi(a[e]) * sigmoid_f(bfhi(b[e]))); o[e] = ok ? v : 0u; }
    *(u32x4*)(U + rr * 512 + ch) = o;
  }
  __syncthreads();
  const int c2 = tid * 2;
  float y0[32], y1[32];
  {
    const f32x2 bb = *(const f32x2*)(SMALLP(p, SM_DWB) + l * 512 + c2);
#pragma unroll
    for (int i = 0; i < 32; ++i) { y0[i] = bb.x; y1[i] = bb.y; }
  }
  const float* dw = SMALLP(p, SM_DW) + (size_t)l * 31 * 512 + c2;
  f32x2 wn = *(const f32x2*)dw;
#pragma unroll 1
  for (int j = 0; j < 31; ++j) {
    const f32x2 w = wn;
    if (j + 1 < 31) wn = *(const f32x2*)(dw + (j + 1) * 512);
    const unsigned wpk = pack_bf16(w.x, w.y), wlo = wpk & 0xffffu, whi = wpk & 0xffff0000u;
    const bf16_t* up = U + j * 512 + c2;
#pragma unroll
    for (int i = 0; i < 32; ++i) {
      const unsigned u = *(const unsigned*)(up + i * 512);
      y0[i] = dot2bf(u, wlo, y0[i]); y1[i] = dot2bf(u, whi, y1[i]);
    }
  }
#pragma unroll
  for (int i = 0; i < 32; ++i) {
    const float s1 = wave_sum_dpp(y0[i] + y1[i]);
    const float s2 = wave_sum_dpp(y0[i] * y0[i] + y1[i] * y1[i]);
    if (lane == 0) { red[(wid * 32 + i) * 2] = s1; red[(wid * 32 + i) * 2 + 1] = s2; }
  }
  __syncthreads();
  const f32x2 lg = *(const f32x2*)(SMALLP(p, SM_LNG) + l * 512 + c2), lb = *(const f32x2*)(SMALLP(p, SM_LNB) + l * 512 + c2);
  bf16_t* out = (bf16_t*)(p.ws + OFF_CONVACT);
#pragma unroll
  for (int i = 0; i < 32; ++i) {
    float s1 = 0.f, s2 = 0.f;
#pragma unroll
    for (int w = 0; w < 4; ++w) { s1 += red[(w * 32 + i) * 2]; s2 += red[(w * 32 + i) * 2 + 1]; }
    const float mean = s1 * (1.f / 512.f), var = s2 * (1.f / 512.f) - mean * mean, rstd = rsqrtf(var + EPS);
    const float a0 = silu_f((y0[i] - mean) * rstd * lg.x + lb.x), a1 = silu_f((y1[i] - mean) * rstd * lg.y + lb.y);
    *(unsigned*)(out + (size_t)(tok0 + i) * 512 + c2) = pack_bf16(a0, a1);
  }
}

DI void attn_item(const Params& p, int l, bool dec, int b, int h, int qt) {
  const int tid = half_tid(), lane = tid & 63, wid = tid >> 6, fr = lane & 15, fq = lane >> 4;
  const int S = dec ? 1024 : 256;
  const int tok0 = dec ? NCTX + b * 1024 : b * 256;
  const int nkt = dec ? 20 : 4, ncache = dec ? 4 : 0;
  const bf16_t* P = (const bf16_t*)(p.ws + OFF_P);
  const float lam_init = (l == 0) ? 0.2f : 0.35550906f;
  float lam;
  {
    const float* dl = SMALLP(p, SM_DLAM) + l * 256;
    const float a = wave_sum(dl[lane] * dl[64 + lane]), c = wave_sum(dl[128 + lane] * dl[192 + lane]);
    lam = __expf(a) - __expf(c) + lam_init;
  }
  const int q0 = qt * 64 + wid * 16;
  bf16x8 qf[2][2];
  {
    const bf16_t* qrow = P + (size_t)(tok0 + q0 + fr) * LDP + PC_Q + h * 128;
#pragma unroll
    for (int m = 0; m < 2; ++m)
#pragma unroll
      for (int ks = 0; ks < 2; ++ks) qf[m][ks] = *(const bf16x8*)(qrow + m * 64 + ks * 32 + fq * 8);
  }
  const size_t blh = (size_t)((b * 2 + l) * 4 + h);
  const bf16_t* kc = (const bf16_t*)(p.ws + OFF_KC) + blh * 32768;
  const bf16_t* vtc = (const bf16_t*)(p.ws + OFF_VTC) + blh * 32768;
  const bf16_t* kn = P + (size_t)tok0 * LDP + PC_K + h * 128;
  const bf16_t* vtn = (const bf16_t*)(p.ws + OFF_VTN) + (dec ? (size_t)32 * 131072 + (size_t)b * 524288 : (size_t)b * 131072) + (size_t)h * 128 * S;
  char* Ks = HSM;
  char* Vs = HSM + 17408;
  u32x4 rk[4], rv[4];
  auto load_tile = [&](int kt) {
    if (kt < ncache) {
#pragma unroll
      for (int i = 0; i < 4; ++i) {
        const int idx = tid + i * 256;
        rk[i] = *(const u32x4*)(kc + (size_t)(kt * 64 + (idx >> 4)) * 128 + (idx & 15) * 8);
        rv[i] = *(const u32x4*)(vtc + (size_t)(idx >> 3) * 256 + kt * 64 + (idx & 7) * 8);
      }
    } else {
      const int kk = (kt - ncache) * 64;
#pragma unroll
      for (int i = 0; i < 4; ++i) {
        const int idx = tid + i * 256;
        rk[i] = *(const u32x4*)(kn + (size_t)(kk + (idx >> 4)) * LDP + (idx & 15) * 8);
        rv[i] = *(const u32x4*)(vtn + (size_t)(idx >> 3) * S + kk + (idx & 7) * 8);
      }
    }
  };
  float m_run[2] = {-INFINITY, -INFINITY}, l_run[2] = {0.f, 0.f};
  f32x4 O[2][8];
#pragma unroll
  for (int m = 0; m < 2; ++m)
#pragma unroll
    for (int d = 0; d < 8; ++d) O[m][d] = (f32x4){0.f, 0.f, 0.f, 0.f};
  const float cexp = 0.125f * 1.4426950408889634f;
  load_tile(0);
#pragma unroll 1
  for (int kt = 0; kt < nkt; ++kt) {
    __syncthreads();
#pragma unroll
    for (int i = 0; i < 4; ++i) {
      const int idx = tid + i * 256;
      *(u32x4*)(Ks + (idx >> 4) * 272 + (idx & 15) * 16) = rk[i];
      *(u32x4*)(Vs + (idx >> 3) * 144 + (idx & 7) * 16) = rv[i];
    }
    __syncthreads();
    if (kt + 1 < nkt) load_tile(kt + 1);
    bf16x8 pf[2][2];
#pragma unroll
    for (int m = 0; m < 2; ++m) {
      f32x4 s[4];
#pragma unroll
      for (int ksub = 0; ksub < 4; ++ksub) {
        f32x4 a = (f32x4){0.f, 0.f, 0.f, 0.f};
#pragma unroll
        for (int ks = 0; ks < 2; ++ks) {
          const bf16x8 kf = *(const bf16x8*)(Ks + (ksub * 16 + fr) * 272 + m * 128 + ks * 64 + fq * 16);
          a = MFMA16(kf, qf[m][ks], a);
        }
        s[ksub] = a;
      }
      float mx = s[0][0];
#pragma unroll
      for (int ksub = 0; ksub < 4; ++ksub)
#pragma unroll
        for (int j = 0; j < 4; ++j) mx = fmaxf(mx, s[ksub][j]);
      mx = xrow_max(mx);
      const float mn = fmaxf(m_run[m], mx);
      const float alpha = __builtin_amdgcn_exp2f((m_run[m] - mn) * cexp);
      m_run[m] = mn;
      float ls = 0.f;
#pragma unroll
      for (int ksub = 0; ksub < 4; ++ksub)
#pragma unroll
        for (int j = 0; j < 4; ++j) { const float e = __builtin_amdgcn_exp2f((s[ksub][j] - mn) * cexp); s[ksub][j] = e; ls += e; }
      l_run[m] = l_run[m] * alpha + ls;
      if (__any(alpha != 1.f)) {
#pragma unroll
        for (int d = 0; d < 8; ++d) O[m][d] *= alpha;
      }
#pragma unroll
      for (int k2 = 0; k2 < 2; ++k2) {
        u32x4 w;
        w[0] = pack_bf16(s[2 * k2][0], s[2 * k2][1]); w[1] = pack_bf16(s[2 * k2][2], s[2 * k2][3]);
        w[2] = pack_bf16(s[2 * k2 + 1][0], s[2 * k2 + 1][1]); w[3] = pack_bf16(s[2 * k2 + 1][2], s[2 * k2 + 1][3]);
        pf[m][k2] = __builtin_bit_cast(bf16x8, w);
      }
    }
#pragma unroll
    for (int k2 = 0; k2 < 2; ++k2) {
#pragma unroll
      for (int d = 0; d < 8; ++d) {
        const char* vp = Vs + (d * 16 + fr) * 144 + (k2 * 32 + 4 * fq) * 2;
        const s16x4 lo = *(const s16x4*)vp, hi = *(const s16x4*)(vp + 32);
        const bf16x8 vf = __builtin_shufflevector(lo, hi, 0, 1, 2, 3, 4, 5, 6, 7);
        O[0][d] = MFMA16(vf, pf[0][k2], O[0][d]);
        O[1][d] = MFMA16(vf, pf[1][k2], O[1][d]);
      }
    }
  }
#pragma unroll
  for (int m = 0; m < 2; ++m) l_run[m] = xrow_sum(l_run[m]);
  const float inv1 = 1.f / l_run[0], inv2 = lam / l_run[1];
  float ss = 0.f;
#pragma unroll
  for (int d = 0; d < 8; ++d)
#pragma unroll
    for (int j = 0; j < 4; ++j) { const float o = O[0][d][j] * inv1 - O[1][d][j] * inv2; O[0][d][j] = o; ss += o * o; }
  ss = xrow_sum(ss);
  const float rstd = rsqrtf(ss * (1.f / 128.f) + EPS) * (1.f - lam_init);
  const int tok = tok0 + q0 + fr;
  bf16_t* Y = (bf16_t*)(p.ws + OFF_H);
#pragma unroll
  for (int d = 0; d < 8; ++d) {
    const int dv = d * 16 + 4 * fq;
    const f32x4 g4 = *(const f32x4*)(SMALLP(p, SM_SUBLN) + l * 128 + dv);
    const u32x2 gw = *(const u32x2*)(P + (size_t)tok * LDP + PC_AG + h * 128 + dv);
    f32x4 o;
    o[0] = O[0][d][0] * rstd * g4[0] * silu_f(bflo(gw.x));
    o[1] = O[0][d][1] * rstd * g4[1] * silu_f(bfhi(gw.x));
    o[2] = O[0][d][2] * rstd * g4[2] * silu_f(bflo(gw.y));
    o[3] = O[0][d][3] * rstd * g4[3] * silu_f(bfhi(gw.y));
    *(u32x2*)(Y + slab_idx(tok, 1024 + h * 128 + dv, NTOK)) = pack4(o);
  }
}

__global__ void __launch_bounds__(512, 2) fwd_megakernel(Params p) {
  cg::grid_group grid = cg::this_grid();
  unsigned* sync = (unsigned*)(p.ws + OFF_SYNC);
  unsigned* queues = (unsigned*)(p.ws + OFF_QUEUE);
  if (threadIdx.x == 0) { g_sh[1] = 0u; g_sh[2] = 0u; }
  __syncthreads();
  if (threadIdx.x == 0) (void)xb_add(&sync[XB_XCNT(xb_xcc_id())], 1u);
  if (p.never) grid.sync();
  phase0(p);
  grid_barrier(sync, 0);
  for (int l = 0; l < 2; ++l) {
    norm_phase(p, l);
    grid_barrier(sync, 0);
    for (int t = blockIdx.x; t < 1280; t += gridDim.x) g1_tile(p, l, t);
    for (int ht = blockIdx.x; ht < 256; ht += gridDim.x) g1_half_tile(p, l, ht);
    grid_barrier(sync, 0);
    {
      unsigned* q = queues + 64 * (l * 2);
      for (;;) {
        const int it = queue_next(q);
        if (it >= 1280) break;
        const int hf = half_id();
        if (it < 256) { const int a = it * 2 + hf; attn_item(p, l, true, a >> 6, (a >> 4) & 3, a & 15); }
        else if (it < 512) z_tile(p, l, it - 256);
        else if (it < 768) conv_item(p, l, (it - 512) * 2 + hf);
        else if (it < 1024) { const int a = (it - 768) * 2 + hf; attn_item(p, l, false, a >> 4, (a >> 2) & 3, a & 3); }
        else pool_item(p, (it - 1024) * 2 + hf);
      }
    }
    grid_barrier(sync, 0);
    {
      unsigned* q = queues + 64 * (1 + l * 2);
      for (;;) {
        const int it = queue_next(q);
        if (it >= 448) break;
        if (it < 128) {
          const int seq = it >> 4, mh = (it >> 1) & 7, nt = it & 1;
          gated_gemm_tile<4>(p, (const bf16_t*)(p.ws + OFF_DDEC) + (size_t)mh * 128 * LDD, LDD,
                             (const bf16_t*)(p.ws + OFF_ZT) + 32ull * 262144 + (size_t)seq * 512 * LDZ + (size_t)nt * 256 * LDZ, LDZ, 2048,
                             NCTX + seq * 1024 + mh * 128, nt * 256, PC_FG, 0, nullptr);
        } else if (it < 256) {
          const int t = it - 128, pm = t & 63, pn = t >> 6;
          gated_gemm_tile(p, (const bf16_t*)(p.ws + OFF_CONVACT) + (size_t)pm * 256 * 512, 512,
                          (const bf16_t*)(p.ws + OFF_WPWT) + ((size_t)l * 512 + pn * 256) * 512, 512, 512, pm * 256, pn * 256, PC_CG, 1536, nullptr);
        } else if (it < 320) {
          const int t = it - 256, seq = t >> 1, nt = t & 1;
          gated_gemm_tile(p, (const bf16_t*)(p.ws + OFF_DCTX), LDC, (const bf16_t*)(p.ws + OFF_ZT) + (size_t)seq * 262144 + (size_t)nt * 256 * 512, 512, 512,
                          seq * 256, nt * 256, PC_FG, 0, nullptr);
        } else {
          const int t = it - 320, pm = t & 63, pr = t >> 6;
          gated_gemm_tile(p, (const bf16_t*)(p.ws + OFF_POOLED) + (size_t)pm * 256 * 512 + pr * 256, 512,
                          (const bf16_t*)(p.ws + OFF_WPOOLT) + (size_t)(l * 2 + pr) * 65536, 256, 256, pm * 256, pr * 256, PC_PG, 512, SMALLP(p, SM_POOLSC) + l * 512);
        }
      }
    }
    grid_barrier(sync, 0);
    for (int t = blockIdx.x; t < 64 * 8; t += gridDim.x) out_tile(p, l, t);
    grid_barrier(sync, 0);
  }
  final_phase(p);
}

extern "C" void kernel_launch(void* const* d_in, const int* in_sizes, int n_in, void* d_out, int out_size, void* d_ws, size_t ws_size,
                              hipStream_t stream) {
  static int grid_blocks = 0;
  if (!grid_blocks) {
    int dev = 0, cus = 0, per_cu = 0;
    (void)hipGetDevice(&dev);
    (void)hipDeviceGetAttribute(&cus, hipDeviceAttributeMultiprocessorCount, dev);
    (void)hipFuncSetAttribute((const void*)fwd_megakernel, hipFuncAttributeMaxDynamicSharedMemorySize, (int)kDynLds);
    (void)hipOccupancyMaxActiveBlocksPerMultiprocessor(&per_cu, fwd_megakernel, 512, kDynLds);
    if (per_cu > 1) per_cu = 1;
    if (per_cu < 1) per_cu = 1;
    grid_blocks = cus * per_cu;
  }
  Params p{};
  const float** pp = (const float**)&p;
  for (int i = 0; i < 22; ++i) pp[i] = (const float*)d_in[i];
  p.out = (float*)d_out;
  p.ws = (unsigned char*)d_ws;
  (void)hipMemsetAsync(d_ws, 0, ZERO_BYTES, stream);
  void* args[] = {&p};
  hipError_t e = hipLaunchCooperativeKernel((void*)fwd_megakernel, dim3(grid_blocks), dim3(512), args, kDynLds, stream);
  if (e != hipSuccess) fprintf(stderr, "cooperative launch failed: %s (grid %d)\n", hipGetErrorString(e), grid_blocks);
}
```

```cpp
#include <hip/hip_runtime.h>
#include <hip/hip_cooperative_groups.h>
#include <stdint.h>
#include <cstdio>
namespace cg = cooperative_groups;

typedef unsigned short bf16_t;
typedef short bf16x8 __attribute__((ext_vector_type(8)));
typedef short s16x4 __attribute__((ext_vector_type(4)));
typedef float f32x4 __attribute__((ext_vector_type(4)));
typedef float f32x2 __attribute__((ext_vector_type(2)));
typedef unsigned u32x4 __attribute__((ext_vector_type(4)));
typedef unsigned u32x2 __attribute__((ext_vector_type(2)));
#define DI __device__ __forceinline__
#define LDSP __attribute__((address_space(3))) void*
#define MFMA16(a, b, c) __builtin_amdgcn_mfma_f32_16x16x32_bf16((a), (b), (c), 0, 0, 0)

constexpr int DM = 2048, NTOK = 16384, NCTX = 8192;
constexpr int LDP = 5120;
constexpr int PC_FX = 0, PC_FG = 512, PC_PX = 1024, PC_PG = 1536, PC_Q = 2048, PC_K = 2560, PC_AG = 3072, PC_CA = 3584, PC_CB = 4096, PC_CG = 4608;
constexpr float EPS = 1e-6f;
constexpr int LDD = 2112;
constexpr int LDZ = 2112;
constexpr int LDC = 576;

constexpr size_t OFF_SYNC = 0;
constexpr size_t OFF_QUEUE = 16384;
constexpr size_t OFF_MODV = 20480;
constexpr size_t SZ_MODV = 2ull * 9 * 6144 * 4;
constexpr size_t ZERO_BYTES = OFF_MODV + SZ_MODV;
constexpr size_t OFF_ROPE = ZERO_BYTES;
constexpr size_t OFF_P = OFF_ROPE + 8192;
constexpr size_t OFF_H = OFF_P + (size_t)NTOK * LDP * 2;
constexpr size_t OFF_ZT = OFF_H + (size_t)NTOK * DM * 2;
constexpr size_t OFF_VTN = OFF_ZT + (32ull * 262144 + 8ull * 512 * LDZ) * 2;
constexpr size_t OFF_POOLED = OFF_VTN + (size_t)NTOK * 512 * 2;
constexpr size_t OFF_CONVACT = OFF_POOLED + (size_t)NTOK * 512 * 2;
constexpr size_t OFF_WINT = OFF_CONVACT + (size_t)NTOK * 512 * 2;
constexpr size_t OFF_WOUTT = OFF_WINT + 2ull * 5632 * 2048 * 2;
constexpr size_t OFF_WCST = OFF_WOUTT + 2ull * 2048 * 2048 * 2;
constexpr size_t OFF_WPOOLT = OFF_WCST + 2ull * 1024 * 512 * 2;
constexpr size_t OFF_WPWT = OFF_WPOOLT + 2ull * 2 * 256 * 256 * 2;
constexpr size_t OFF_KC = OFF_WPWT + 2ull * 512 * 512 * 2;
constexpr size_t OFF_VTC = OFF_KC + 8ull * 2 * 4 * 256 * 128 * 2;
constexpr size_t OFF_DCTX = OFF_VTC + 8ull * 2 * 4 * 256 * 128 * 2;
constexpr size_t OFF_DDEC = OFF_DCTX + 256ull * LDC * 2;
constexpr size_t OFF_SMALL = OFF_DDEC + 1024ull * LDD * 2;
constexpr int SM_NORMG = 0, SM_POOLSC = 4096, SM_DLAM = 5120, SM_SUBLN = 5632, SM_DW = 5888, SM_DWB = 37632, SM_LNG = 38656, SM_LNB = 39680, SM_FINALG = 40704, SM_TOTAL = 42752;
constexpr size_t WS_TOTAL = OFF_SMALL + (size_t)SM_TOTAL * 4;
static_assert(WS_TOTAL <= 402653184ull, "workspace too large");

struct Params {
  const float *x_prompt, *x_sample, *cache_k, *cache_v, *c, *c_ctx, *norm_g, *w_mod, *b_mod, *w_in, *w_fourier, *w_pool,
      *pool_scale, *diff_lambda, *subln_g, *conv_dw, *conv_dw_b, *conv_ln_g, *conv_ln_b, *w_conv_pw, *w_out, *final_g;
  float* out;
  unsigned char* ws;
  unsigned long long never;
};

extern __shared__ __attribute__((aligned(16))) char g_smem[];
constexpr size_t kDynLds = 131072;
#define HSM (g_smem + (half_id() << 16))
__shared__ unsigned g_sh[4];

#define SMALLP(p, off) ((const float*)((p).ws + OFF_SMALL) + (off))
DI size_t slab_idx(int row, int col, int nrows) { return ((size_t)(col >> 5) * nrows + row) * 32 + (col & 31); }
DI float bf2f(unsigned u16) { return __uint_as_float(u16 << 16); }
DI float bflo(unsigned w) { return __uint_as_float(w << 16); }
DI float bfhi(unsigned w) { return __uint_as_float(w & 0xffff0000u); }
DI unsigned pack_bf16(float lo, float hi) { unsigned r; asm("v_cvt_pk_bf16_f32 %0, %1, %2" : "=v"(r) : "v"(lo), "v"(hi)); return r; }
DI float silu_f(float x) { return x * __builtin_amdgcn_rcpf(1.f + __expf(-x)); }
DI float sigmoid_f(float x) { return __builtin_amdgcn_rcpf(1.f + __expf(-x)); }
DI int opaque_tid() { int t = threadIdx.x; asm volatile("" : "+v"(t)); return t; }
DI int half_tid() { return opaque_tid() & 255; }
DI int half_id() { return opaque_tid() >> 8; }
DI float wave_sum(float v) {
#pragma unroll
  for (int o = 32; o >= 1; o >>= 1) v += __shfl_xor(v, o);
  return v;
}
typedef __bf16 bf2_t __attribute__((ext_vector_type(2)));
DI float dot2bf(unsigned a, unsigned b, float c) { return __builtin_amdgcn_fdot2_f32_bf16(__builtin_bit_cast(bf2_t, a), __builtin_bit_cast(bf2_t, b), c, false); }
DI float xrow_max(float v) {
  u32x2 r = __builtin_amdgcn_permlane16_swap(__float_as_uint(v), __float_as_uint(v), false, false);
  v = fmaxf(__uint_as_float(r[0]), __uint_as_float(r[1]));
  r = __builtin_amdgcn_permlane32_swap(__float_as_uint(v), __float_as_uint(v), false, false);
  return fmaxf(__uint_as_float(r[0]), __uint_as_float(r[1]));
}
DI float xrow_sum(float v) {
  u32x2 r = __builtin_amdgcn_permlane16_swap(__float_as_uint(v), __float_as_uint(v), false, false);
  v = __uint_as_float(r[0]) + __uint_as_float(r[1]);
  r = __builtin_amdgcn_permlane32_swap(__float_as_uint(v), __float_as_uint(v), false, false);
  return __uint_as_float(r[0]) + __uint_as_float(r[1]);
}
DI u32x2 pack4(f32x4 v) { u32x2 r; r.x = pack_bf16(v[0], v[1]); r.y = pack_bf16(v[2], v[3]); return r; }

#define XB_TMO      128
#define XB_XCNT(j)  (256  + 64 * (j))
#define XB_XSUB(j)  (1280 + 64 * (j))
#define XB_XGEN(j)  (2304 + 64 * (j))
#define XB_TOP      3328
#define XB_TOPGEN   3392
#define XB_SPIN_CAP (1u << 20)
DI unsigned xb_ld(unsigned* p) { return __hip_atomic_load(p, __ATOMIC_RELAXED, __HIP_MEMORY_SCOPE_AGENT); }
DI unsigned xb_add(unsigned* p, unsigned v) { return __hip_atomic_fetch_add(p, v, __ATOMIC_RELAXED, __HIP_MEMORY_SCOPE_AGENT); }
DI unsigned xb_xcc_id() { return (unsigned)__builtin_amdgcn_s_getreg((3 << 11) | 20) & 0xFu; }
#define XB_SPIN(cond, bar) do { unsigned _sp = 0; while (cond) { __builtin_amdgcn_s_sleep(1); \
    if ((++_sp & 255u) == 0u) { if (xb_ld(&(bar)[XB_TMO])) break; if (_sp > XB_SPIN_CAP) { atomicAdd(&(bar)[XB_TMO], 1u); break; } } } } while (0)
DI void xcd_barrier_complete(unsigned* bar, unsigned x, unsigned& nloc, unsigned& nx) {
  const unsigned G = gridDim.x;
  unsigned sum, cnt, mine, sp = 0u;
  for (;;) {
    sum = 0u; cnt = 0u; mine = 0u;
#pragma unroll
    for (unsigned j = 0; j < 16; ++j) { const unsigned c = xb_ld(&bar[XB_XCNT(j)]); sum += c; cnt += (c > 0u) ? 1u : 0u; mine = (j == x) ? c : mine; }
    if (sum == G) break;
    __builtin_amdgcn_s_sleep(1);
    if ((++sp & 255u) == 0u) { if (xb_ld(&bar[XB_TMO])) break; if (sp > XB_SPIN_CAP) { atomicAdd(&bar[XB_TMO], 1u); break; } }
  }
  nloc = mine > 0u ? mine : 1u; nx = cnt > 0u ? cnt : 1u;
}
DI void grid_barrier(unsigned* bar, unsigned) {
  asm volatile("s_waitcnt vmcnt(0)" ::: "memory");
  __syncthreads();
  if (threadIdx.x == 0) {
    __builtin_amdgcn_s_waitcnt(0);
    const unsigned x = xb_xcc_id();
    volatile unsigned* st = g_sh;
    unsigned nloc = st[1], nx = st[2];
    if (nloc == 0u) { xcd_barrier_complete(bar, x, nloc, nx); st[1] = nloc; st[2] = nx; }
    const unsigned old = xb_add(&bar[XB_XSUB(x)], 1u);
    const unsigned gen = old / nloc;
    if (old + 1u == (gen + 1u) * nloc) {
      __builtin_amdgcn_fence(__ATOMIC_RELEASE, "agent");
      asm volatile("s_waitcnt vmcnt(0)" ::: "memory");
      const unsigned og = xb_add(&bar[XB_TOP], 1u);
      const unsigned tg = og / nx;
      if (og + 1u == (tg + 1u) * nx) xb_add(&bar[XB_TOPGEN], 1u);
      else XB_SPIN(xb_ld(&bar[XB_TOPGEN]) == tg, bar);
      __builtin_amdgcn_fence(__ATOMIC_ACQUIRE, "agent");
      xb_add(&bar[XB_XGEN(x)], 1u);
      asm volatile("s_waitcnt vmcnt(0)" ::: "memory");
    } else {
      XB_SPIN(xb_ld(&bar[XB_XGEN(x)]) == gen, bar);
      __builtin_amdgcn_fence(__ATOMIC_ACQUIRE, "agent");
      asm volatile("s_waitcnt vmcnt(0)" ::: "memory");
    }
  }
  __syncthreads();
}

DI int queue_next(unsigned* q) {
  __syncthreads();
  if (threadIdx.x == 0) g_sh[0] = __hip_atomic_fetch_add(q, 1u, __ATOMIC_RELAXED, __HIP_MEMORY_SCOPE_AGENT);
  __syncthreads();
  return (int)g_sh[0];
}

template <int CTRL, int ROWMASK> DI float dpp_add(float v) {
  const int t = __builtin_amdgcn_update_dpp(0, __float_as_int(v), CTRL, ROWMASK, 0xf, false);
  return v + __int_as_float(t);
}
DI float wave_sum_dpp(float v) {
  v = dpp_add<0x111, 0xf>(v); v = dpp_add<0x112, 0xf>(v); v = dpp_add<0x114, 0xf>(v); v = dpp_add<0x118, 0xf>(v);
  v = dpp_add<0x142, 0xa>(v); v = dpp_add<0x143, 0xc>(v);
  return __int_as_float(__builtin_amdgcn_readlane(__float_as_int(v), 63));
}

template <bool TRANS, bool PERM, int MI = 8>
DI void gemm_main(const bf16_t* A, int lda, size_t ksA, const bf16_t* B, int ldb, size_t ksB, int K, f32x4 (&acc)[MI][4]) {
  const int tid = opaque_tid(), lane = tid & 63, wid = tid >> 6, wr = wid >> 2, wc = wid & 3, fr = lane & 15, fq = lane >> 4;
  const int lrow = tid >> 2, lch = tid & 3;
  const int lsw = (lch ^ (((lrow >> 3) & 1) << 1)) * 8;
  const bf16_t* ga = A + (size_t)lrow * lda + lsw;
  const int rho = lrow & 31;
  const int lrow_b = PERM ? ((lrow & ~31) | (8 * ((rho & 15) >> 2) + 4 * (rho >> 4) + (rho & 3))) : lrow;
  const bf16_t* gb = B + (size_t)lrow_b * ldb + lsw;
  const size_t sa = (size_t)128 * lda, sb = (size_t)128 * ldb;
#pragma unroll
  for (int mi = 0; mi < MI; ++mi)
#pragma unroll
    for (int ni = 0; ni < 4; ++ni) acc[mi][ni] = (f32x4){0.f, 0.f, 0.f, 0.f};
  char* lbase = g_smem + tid * 16;
#define GLDS_ISSUE(STG)                                                                                              \
  do {                                                                                                               \
    char* l_ = lbase + (STG) * 32768;                                                                                \
    __builtin_amdgcn_global_load_lds((const unsigned*)(ga), (LDSP)(l_), 16, 0, 0);                                   \
    if (MI == 8) __builtin_amdgcn_global_load_lds((const unsigned*)(ga + sa), (LDSP)(l_ + 8192), 16, 0, 0);          \
    __builtin_amdgcn_global_load_lds((const unsigned*)(gb), (LDSP)(l_ + 16384), 16, 0, 0);                           \
    __builtin_amdgcn_global_load_lds((const unsigned*)(gb + sb), (LDSP)(l_ + 24576), 16, 0, 0);                      \
    ga += ksA; gb += ksB;                                                                                            \
  } while (0)
  asm volatile("s_waitcnt vmcnt(0)" ::: "memory");
  __syncthreads();
  const int nk = K >> 5;
  GLDS_ISSUE(0);
  GLDS_ISSUE(1);
  GLDS_ISSUE(2);
  const int rsw = (fq ^ (((fr >> 3) & 1) << 1)) * 16;
  const int aofs = (wr * (MI * 16) + fr) * 64 + rsw;
  const int bofs = 16384 + (wc * 64 + fr) * 64 + rsw;
  if (MI == 8) asm volatile("s_waitcnt vmcnt(8)" ::: "memory"); else asm volatile("s_waitcnt vmcnt(6)" ::: "memory");
  __builtin_amdgcn_s_barrier();
  if (wid >= 4) __builtin_amdgcn_s_barrier();
  int scur = 0, snxt = 3;
  for (int kt = 0; kt < nk; ++kt) {
    const char* st = g_smem + scur * 32768;
    bf16x8 af[MI], bfr[4];
#pragma unroll
    for (int mi = 0; mi < MI; ++mi) af[mi] = *(const bf16x8*)(st + aofs + mi * 1024);
#pragma unroll
    for (int ni = 0; ni < 4; ++ni) bfr[ni] = *(const bf16x8*)(st + bofs + ni * 1024);
    if (kt + 3 < nk) { GLDS_ISSUE(snxt); if (MI == 8) asm volatile("s_waitcnt vmcnt(8) lgkmcnt(0)" ::: "memory"); else asm volatile("s_waitcnt vmcnt(6) lgkmcnt(0)" ::: "memory"); }
    else if (kt + 2 < nk) { if (MI == 8) asm volatile("s_waitcnt vmcnt(4) lgkmcnt(0)" ::: "memory"); else asm volatile("s_waitcnt vmcnt(3) lgkmcnt(0)" ::: "memory"); }
    else asm volatile("s_waitcnt vmcnt(0) lgkmcnt(0)" ::: "memory");
    __builtin_amdgcn_sched_barrier(0);
    __builtin_amdgcn_s_barrier();
    __builtin_amdgcn_sched_barrier(0);
#pragma unroll
    for (int mi = 0; mi < MI; ++mi)
#pragma unroll
      for (int ni = 0; ni < 4; ++ni)
        acc[mi][ni] = TRANS ? MFMA16(bfr[ni], af[mi], acc[mi][ni]) : MFMA16(af[mi], bfr[ni], acc[mi][ni]);
    __builtin_amdgcn_sched_barrier(0);
    __builtin_amdgcn_s_barrier();
    __builtin_amdgcn_sched_barrier(0);
    scur = (scur + 1) & 3;
    snxt = (snxt + 1) & 3;
  }
  if (wid < 4) __builtin_amdgcn_s_barrier();
#undef GLDS_ISSUE
}

DI void transpose_tile(const float* src, int ldn, bf16_t* dst, int ldk, int k0, int n0, int slab_rows = 0) {
  float* t = (float*)HSM;
  const int tid = half_tid();
  __syncthreads();
  f32x4 v[8];
#pragma unroll
  for (int i = 0; i < 8; ++i) {
    const int idx = tid + i * 256, r = idx >> 5, c4 = (idx & 31) * 4;
    v[i] = *(const f32x4*)(src + (size_t)(k0 + r) * ldn + n0 + c4);
  }
#pragma unroll
  for (int i = 0; i < 8; ++i) {
    const int idx = tid + i * 256, r = idx >> 5, c4 = (idx & 31) * 4;
    t[r * 129 + c4 + 0] = v[i][0]; t[r * 129 + c4 + 1] = v[i][1]; t[r * 129 + c4 + 2] = v[i][2]; t[r * 129 + c4 + 3] = v[i][3];
  }
  __syncthreads();
#pragma unroll
  for (int i = 0; i < 4; ++i) {
    const int idx = tid + i * 256, n = idx >> 3, kc = (idx & 7) * 8;
    u32x4 o;
    o[0] = pack_bf16(t[(kc + 0) * 129 + n], t[(kc + 1) * 129 + n]);
    o[1] = pack_bf16(t[(kc + 2) * 129 + n], t[(kc + 3) * 129 + n]);
    o[2] = pack_bf16(t[(kc + 4) * 129 + n], t[(kc + 5) * 129 + n]);
    o[3] = pack_bf16(t[(kc + 6) * 129 + n], t[(kc + 7) * 129 + n]);
    if (slab_rows) *(u32x4*)(dst + slab_idx(n0 + n, k0 + kc, slab_rows)) = o;
    else *(u32x4*)(dst + (size_t)(n0 + n) * ldk + k0 + kc) = o;
  }
}

DI void mod_item(const Params& p, int it) {
  const int tid = half_tid();
  const int l = it / 192, r = it % 192, kc = r / 6, cb = r % 6;
  float* sl = (float*)HSM;
  __syncthreads();
  for (int idx = tid; idx < 576; idx += 256) {
    const int j = idx >> 6, k = idx & 63;
    const float* src = (j == 0) ? p.c_ctx : p.c + (j - 1) * 2048;
    sl[idx] = silu_f(src[kc * 64 + k]);
  }
  __syncthreads();
  const int col = cb * 1024 + tid * 4;
  f32x4 acc[9];
#pragma unroll
  for (int j = 0; j < 9; ++j) acc[j] = (f32x4){0.f, 0.f, 0.f, 0.f};
  const float* w = p.w_mod + ((size_t)l * 2048 + kc * 64) * 6144 + col;
#pragma unroll 4
  for (int k = 0; k < 64; ++k) {
    const f32x4 wv = *(const f32x4*)(w + (size_t)k * 6144);
#pragma unroll
    for (int j = 0; j < 9; ++j) acc[j] += wv * sl[j * 64 + k];
  }
  if (kc == 0) {
    const f32x4 bv = *(const f32x4*)(p.b_mod + l * 6144 + col);
#pragma unroll
    for (int j = 0; j < 9; ++j) acc[j] += bv;
  }
  float* modv = (float*)(p.ws + OFF_MODV);
#pragma unroll
  for (int j = 0; j < 9; ++j)
#pragma unroll
    for (int e = 0; e < 4; ++e)
      __hip_atomic_fetch_add(modv + (l * 9 + j) * 6144 + col + e, acc[j][e], __ATOMIC_RELAXED, __HIP_MEMORY_SCOPE_AGENT);
}

DI void fourier_fold_item(const Params& p, int it) {
  const int tid = half_tid();
  const int l = it >> 10, r = it & 1023, k = r >> 1, nb = r & 1;
  const int g = k >> 7, c = k & 127, n = nb * 256 + tid;
  float* tab = (float*)HSM;
  __syncthreads();
  if (tid < 128) { const float rev = (float)tid * (1.f / 128.f); tab[tid] = __builtin_amdgcn_cosf(rev); tab[128 + tid] = __builtin_amdgcn_sinf(rev); }
  __syncthreads();
  const float* w = p.w_fourier + ((size_t)(l * 512 + g * 128)) * 512 + n;
  float ac = 0.f, as = 0.f;
#pragma unroll 16
  for (int j = 0; j < 128; ++j) { const float wv = w[(size_t)j * 512]; const int ti = (c * j) & 127; ac += tab[ti] * wv; as += tab[128 + ti] * wv; }
  bf16_t* dst = (bf16_t*)(p.ws + OFF_WCST);
  dst[((size_t)(l * 1024 + n)) * 512 + k] = (bf16_t)(pack_bf16(ac * 0.08838834764831845f, 0.f) & 0xffffu);
  dst[((size_t)(l * 1024 + 512 + n)) * 512 + k] = (bf16_t)(pack_bf16(as * 0.08838834764831845f, 0.f) & 0xffffu);
}

DI void phase0(const Params& p) {
  const int tid = half_tid();
  constexpr int N_MOD = 384, N_WIN = 2816, N_WOUT = 1024, N_WPW = 64, N_WPOOL = 128, N_CV = 256, N_CK = 1024, N_DCTX = 64, N_DDEC = 1024, N_ROPE = 2, N_FF = 2048, N_SM = 24;
  constexpr int E0 = N_MOD, E1 = E0 + N_WIN, E2 = E1 + N_WOUT, E3 = E2 + N_WPW, E4 = E3 + N_WPOOL, E5 = E4 + N_CV, E6 = E5 + N_CK, E7 = E6 + N_DCTX,
                E8 = E7 + N_DDEC, E9 = E8 + N_ROPE, E10 = E9 + N_FF, E11 = E10 + N_SM;
  for (int itp = blockIdx.x; itp < E11 / 2; itp += gridDim.x) {
    const int it = itp * 2 + half_id();
    if (it < E0) {
      mod_item(p, it);
    } else if (it < E1) {
      const int t = it - E0, l = t / 1408, r = t % 1408, kt = r / 44, nt = r % 44;
      transpose_tile(p.w_in + (size_t)l * 2048 * 5632, 5632, (bf16_t*)(p.ws + OFF_WINT) + (size_t)l * 5632 * 2048, 2048, kt * 64, nt * 128, 5632);
    } else if (it < E2) {
      const int t = it - E1, l = t >> 9, r = t & 511, kt = r >> 4, nt = r & 15;
      transpose_tile(p.w_out + (size_t)l * 2048 * 2048, 2048, (bf16_t*)(p.ws + OFF_WOUTT) + (size_t)l * 2048 * 2048, 2048, kt * 64, nt * 128, 2048);
    } else if (it < E3) {
      const int t = it - E2, l = t >> 5, r = t & 31, kt = r >> 2, nt = r & 3;
      transpose_tile(p.w_conv_pw + (size_t)l * 512 * 512, 512, (bf16_t*)(p.ws + OFF_WPWT) + (size_t)l * 512 * 512, 512, kt * 64, nt * 128);
    } else if (it < E4) {
      const int t = it - E3, lp = t >> 5;
      const int e0 = (t & 31) * 2048 + tid * 8, n = e0 >> 8, k0 = e0 & 255;
      const int g = (lp & 1) * 2 + (n >> 7);
      u32x4 o = (u32x4){0u, 0u, 0u, 0u};
      if ((k0 >> 7) == (n >> 7)) {
        const float* w = p.w_pool + ((size_t)((lp >> 1) * 4 + g) * 128 + (k0 & 127)) * 128 + (n & 127);
#pragma unroll
        for (int e = 0; e < 4; ++e) o[e] = pack_bf16(w[(size_t)(2 * e) * 128], w[(size_t)(2 * e + 1) * 128]);
      }
      *(u32x4*)((bf16_t*)(p.ws + OFF_WPOOLT) + (size_t)lp * 65536 + e0) = o;
    } else if (it < E5) {
      const int t = it - E4, blh = t >> 2, kt = t & 3;
      transpose_tile(p.cache_v + (size_t)blh * 256 * 128, 128, (bf16_t*)(p.ws + OFF_VTC) + (size_t)blh * 128 * 256, 256, kt * 64, 0);
    } else if (it < E6) {
      const size_t e = (size_t)(it - E5) * 2048 + tid * 8;
      const f32x4 a = *(const f32x4*)(p.cache_k + e), b = *(const f32x4*)(p.cache_k + e + 4);
      u32x4 o; o[0] = pack_bf16(a[0], a[1]); o[1] = pack_bf16(a[2], a[3]); o[2] = pack_bf16(b[0], b[1]); o[3] = pack_bf16(b[2], b[3]);
      *(u32x4*)((bf16_t*)(p.ws + OFF_KC) + e) = o;
    } else if (it < E8) {
      const bool dec = it >= E7;
      const int e0 = (dec ? it - E7 : it - E6) * 2048 + tid * 8;
      const int S = dec ? 1024 : 256, sh = dec ? 11 : 9;
      const float nrm = dec ? 0.03125f : 0.0625f, invS = dec ? (1.f / 1024.f) : (1.f / 256.f);
      float v[8];
#pragma unroll
      for (int i = 0; i < 8; ++i) {
        const int e = e0 + i, t = e & (2 * S - 1);
        const int s = e >> sh;
        const int tt = t & (S - 1);
        const float rev = (float)((s * tt) & (S - 1)) * invS;
        v[i] = (t < S) ? __builtin_amdgcn_cosf(rev) * nrm : -__builtin_amdgcn_sinf(rev) * nrm;
      }
      u32x4 o; o[0] = pack_bf16(v[0], v[1]); o[1] = pack_bf16(v[2], v[3]); o[2] = pack_bf16(v[4], v[5]); o[3] = pack_bf16(v[6], v[7]);
      *(u32x4*)((bf16_t*)(p.ws + (dec ? OFF_DDEC : OFF_DCTX)) + (size_t)(e0 >> sh) * (dec ? LDD : LDC) + (e0 & (2 * S - 1))) = o;
    } else if (it < E9) {
      f32x2* rope = (f32x2*)(p.ws + OFF_ROPE);
#pragma unroll
      for (int i = 0; i < 4; ++i) {
        const int idx = tid + i * 256, pos = idx >> 4, f = idx & 15;
        const float inv = exp2f(-(float)f * (13.287712379549449f / 16.f));
        const float ang = (float)pos * inv;
        float rev = ang * 0.15915494309189535f;
        rev -= floorf(rev);
        f32x2 cs; cs.x = __builtin_amdgcn_cosf(rev); cs.y = __builtin_amdgcn_sinf(rev);
        rope[idx] = cs;
      }
    } else if (it < E10) {
      fourier_fold_item(p, it - E9);
    } else {
      const int j = it - E10;
      const float* src; int n, off;
      if (j >= 4 && j < 20) { src = p.conv_dw + (j - 4) * 1984; n = 1984; off = SM_DW + (j - 4) * 1984; }
      else switch (j) {
        case 0: src = p.norm_g; n = 4096; off = SM_NORMG; break;
        case 1: src = p.pool_scale; n = 1024; off = SM_POOLSC; break;
        case 2: src = p.diff_lambda; n = 512; off = SM_DLAM; break;
        case 3: src = p.subln_g; n = 256; off = SM_SUBLN; break;
        case 20: src = p.conv_dw_b; n = 1024; off = SM_DWB; break;
        case 21: src = p.conv_ln_g; n = 1024; off = SM_LNG; break;
        case 22: src = p.conv_ln_b; n = 1024; off = SM_LNB; break;
        default: src = p.final_g; n = 2048; off = SM_FINALG; break;
      }
      float* dst = (float*)(p.ws + OFF_SMALL) + off;
#pragma unroll
      for (int i = 0; i < 4; ++i) { const int e = (tid + i * 256) * 4; if (e < n) *(f32x4*)(dst + e) = *(const f32x4*)(src + e); }
    }
  }
}

DI const float* x_row_l0(const Params& p, int m) { return (m < NCTX) ? p.x_prompt + (size_t)m * DM : p.x_sample + (size_t)(m - NCTX) * DM; }
DI int cvec_of_row(int m) { return (m < NCTX) ? 0 : 1 + ((m - NCTX) >> 10); }

DI void norm_phase(const Params& p, int l) {
  const int tid_ = opaque_tid(); const int lane = tid_ & 63, wid = tid_ >> 6;
  const int rr = lane >> 5, q = lane & 31;
  bf16_t* H = (bf16_t*)(p.ws + OFF_H);
  const float* modv = (const float*)(p.ws + OFF_MODV);
  const float* g = SMALLP(p, SM_NORMG) + l * DM;
  for (int mp = blockIdx.x * 8 + wid; mp < NTOK / 2; mp += gridDim.x * 8) {
    const int m = mp * 2 + rr;
    const float* x = (l == 0) ? x_row_l0(p, m) : p.out + (size_t)m * DM;
    const float* mv = modv + (size_t)(l * 9 + cvec_of_row(m)) * 6144;
    f32x4 v[16];
    float ss = 0.f;
#pragma unroll
    for (int i = 0; i < 8; ++i) {
      const int c = i * 256 + q * 8;
      v[2 * i] = *(const f32x4*)(x + c); v[2 * i + 1] = *(const f32x4*)(x + c + 4);
#pragma unroll
      for (int e = 0; e < 4; ++e) ss += v[2 * i][e] * v[2 * i][e] + v[2 * i + 1][e] * v[2 * i + 1][e];
    }
#pragma unroll
    for (int o = 16; o >= 1; o >>= 1) ss += __shfl_xor(ss, o);
    const float rstd = rsqrtf(ss * (1.f / 2048.f) + EPS);
#pragma unroll
    for (int i = 0; i < 8; ++i) {
      const int c = i * 256 + q * 8;
      u32x4 o4;
#pragma unroll
      for (int hh = 0; hh < 2; ++hh) {
        const f32x4 gg = *(const f32x4*)(g + c + 4 * hh), sh = *(const f32x4*)(mv + c + 4 * hh), sc = *(const f32x4*)(mv + 2048 + c + 4 * hh);
        f32x4 h;
#pragma unroll
        for (int e = 0; e < 4; ++e) h[e] = v[2 * i + hh][e] * rstd * gg[e] * (1.f + sc[e]) + sh[e];
        o4[2 * hh] = pack_bf16(h[0], h[1]); o4[2 * hh + 1] = pack_bf16(h[2], h[3]);
      }
      *(u32x4*)(H + slab_idx(m, c, NTOK)) = o4;
    }
  }
}

DI void final_phase(const Params& p) {
  const int tid_ = opaque_tid(); const int lane = tid_ & 63, wid = tid_ >> 6;
  for (int m = blockIdx.x * 8 + wid; m < NTOK; m += gridDim.x * 8) {
    float* x = p.out + (size_t)m * DM;
    f32x4 v[8];
    float ss = 0.f;
#pragma unroll
    for (int i = 0; i < 8; ++i) { v[i] = *(const f32x4*)(x + (i * 64 + lane) * 4); ss += v[i][0] * v[i][0] + v[i][1] * v[i][1] + v[i][2] * v[i][2] + v[i][3] * v[i][3]; }
    ss = wave_sum(ss);
    const float rstd = rsqrtf(ss * (1.f / 2048.f) + EPS);
#pragma unroll
    for (int i = 0; i < 8; ++i) {
      const int c = (i * 64 + lane) * 4;
      const f32x4 gg = *(const f32x4*)(SMALLP(p, SM_FINALG) + c);
      f32x4 h;
#pragma unroll
      for (int e = 0; e < 4; ++e) h[e] = v[i][e] * rstd * gg[e];
      *(f32x4*)(x + c) = h;
    }
  }
}

DI void g1_tile(const Params& p, int l, int t) {
  const int pm = t & 63, pn = t >> 6;
  const int tid = opaque_tid(), lane = tid & 63, wid = tid >> 6, wr = wid >> 2, wc = wid & 3, fr = lane & 15, fq = lane >> 4;
  const bf16_t* A = (const bf16_t*)(p.ws + OFF_H) + (size_t)pm * 256 * 32;
  const bf16_t* B = (const bf16_t*)(p.ws + OFF_WINT) + (size_t)l * 5632 * 2048 + (size_t)pn * 256 * 32;
  bf16_t* P = (bf16_t*)(p.ws + OFF_P);
  const int m0 = pm * 256, n0 = pn * 256;
  const int nw = n0 + wc * 64;
  const bool dec = m0 >= NCTX;
  f32x4 acc[8][4];
  if (pn == 12 || pn == 13) {
    gemm_main<false, false>(A, 32, (size_t)NTOK * 32, B, 32, (size_t)5632 * 32, DM, acc);
    const int vc = nw - 3072, h = vc >> 7;
    bf16_t* vtn = (bf16_t*)(p.ws + OFF_VTN);
    int S, s0; size_t vbase; int b;
    if (!dec) { b = m0 >> 8; S = 256; s0 = 0; vbase = (size_t)b * 131072; }
    else { const int dm = m0 - NCTX; b = dm >> 10; S = 1024; s0 = dm & 1023; vbase = (size_t)32 * 131072 + (size_t)b * 524288; }
    float* ncv = p.out + 41943040ull + ((size_t)((b * 2 + l) * 4 + h)) * 32768;
#pragma unroll
    for (int mi = 0; mi < 8; ++mi)
#pragma unroll
      for (int ni = 0; ni < 4; ++ni) {
        const int s = s0 + wr * 128 + mi * 16 + 4 * fq, dv = (vc & 127) + ni * 16 + fr;
        *(u32x2*)(vtn + vbase + (size_t)(h * 128 + dv) * S + s) = pack4(acc[mi][ni]);
        if (!dec) {
#pragma unroll
          for (int j = 0; j < 4; ++j) ncv[(size_t)(s + j) * 128 + dv] = acc[mi][ni][j];
        }
      }
  } else {
    const int chunk = pn >> 1;
    if (dec && (chunk == 4 || chunk == 5)) {
      gemm_main<true, false>(A, 32, (size_t)NTOK * 32, B, 32, (size_t)5632 * 32, DM, acc);
      const f32x4* rope = (const f32x4*)(p.ws + OFF_ROPE);
#pragma unroll
      for (int mi = 0; mi < 8; ++mi) {
        const int s = (m0 - NCTX + wr * 128 + mi * 16 + fr) & 1023;
        const int prow = s >> 6, pcol = s & 63;
#pragma unroll
        for (int ax = 0; ax < 2; ++ax) {
          const int pos = ax ? pcol : prow;
          const f32x4 t0 = rope[pos * 8 + fq * 2], t1 = rope[pos * 8 + fq * 2 + 1];
          const float cs[4] = {t0[0], t0[2], t1[0], t1[2]}, sn[4] = {t0[1], t0[3], t1[1], t1[3]};
#pragma unroll
          for (int j = 0; j < 4; ++j) {
            const float x1 = acc[mi][ax * 2][j], x2 = acc[mi][ax * 2 + 1][j];
            acc[mi][ax * 2][j] = x1 * cs[j] - x2 * sn[j];
            acc[mi][ax * 2 + 1][j] = x2 * cs[j] + x1 * sn[j];
          }
        }
      }
      const int pc0 = nw + 4 * fq;
#pragma unroll
      for (int mi = 0; mi < 8; ++mi) {
        const int m = m0 + wr * 128 + mi * 16 + fr;
#pragma unroll
        for (int ni = 0; ni < 4; ++ni) *(u32x2*)(P + (size_t)m * LDP + pc0 + ni * 16) = pack4(acc[mi][ni]);
      }
    } else {
      gemm_main<true, true>(A, 32, (size_t)NTOK * 32, B, 32, (size_t)5632 * 32, DM, acc);
      const int pc0 = (nw < 3072 ? nw : nw - 512) + 8 * fq;
#pragma unroll
      for (int mi = 0; mi < 8; ++mi) {
        const int m = m0 + wr * 128 + mi * 16 + fr;
#pragma unroll
        for (int q = 0; q < 2; ++q) {
          u32x4 o; const u32x2 a = pack4(acc[mi][2 * q]), b = pack4(acc[mi][2 * q + 1]);
          o[0] = a.x; o[1] = a.y; o[2] = b.x; o[3] = b.y;
          *(u32x4*)(P + (size_t)m * LDP + pc0 + q * 32) = o;
        }
      }
      if (!dec && chunk == 5) {
        const int kc = nw - 2560, h = kc >> 7;
        const int b = m0 >> 8;
        float* nck = p.out + 33554432ull + ((size_t)((b * 2 + l) * 4 + h)) * 32768;
#pragma unroll
        for (int mi = 0; mi < 8; ++mi) {
          const int s = wr * 128 + mi * 16 + fr;
#pragma unroll
          for (int q = 0; q < 2; ++q) {
            float* dst = nck + (size_t)s * 128 + (kc & 127) + q * 32 + 8 * fq;
            *(f32x4*)dst = acc[mi][2 * q]; *(f32x4*)(dst + 4) = acc[mi][2 * q + 1];
          }
        }
      }
    }
  }
}

DI void g1_half_tile(const Params& p, int l, int ht) {
  const int t = 1280 + (ht >> 1), pm = t & 63, pn = t >> 6;
  const int tid = opaque_tid(), lane = tid & 63, wid = tid >> 6, wr = wid >> 2, wc = wid & 3, fr = lane & 15, fq = lane >> 4;
  const int m0 = pm * 256 + (ht & 1) * 128, nw = pn * 256 + wc * 64;
  const bf16_t* A = (const bf16_t*)(p.ws + OFF_H) + (size_t)m0 * 32;
  const bf16_t* B = (const bf16_t*)(p.ws + OFF_WINT) + (size_t)l * 5632 * 2048 + (size_t)pn * 256 * 32;
  bf16_t* P = (bf16_t*)(p.ws + OFF_P);
  f32x4 acc[4][4];
  gemm_main<true, true, 4>(A, 32, (size_t)NTOK * 32, B, 32, (size_t)5632 * 32, DM, acc);
  const int pc0 = (nw - 512) + 8 * fq;
#pragma unroll
  for (int mi = 0; mi < 4; ++mi) {
    const int m = m0 + wr * 64 + mi * 16 + fr;
#pragma unroll
    for (int q = 0; q < 2; ++q) {
      u32x4 o; const u32x2 a = pack4(acc[mi][2 * q]), b = pack4(acc[mi][2 * q + 1]);
      o[0] = a.x; o[1] = a.y; o[2] = b.x; o[3] = b.y;
      *(u32x4*)(P + (size_t)m * LDP + pc0 + q * 32) = o;
    }
  }
}

template <int MI = 8>
DI void gated_gemm_tile(const Params& p, const bf16_t* A, int lda, const bf16_t* B, int ldb, int K, int tok0, int ncol0, int gcol, int ycol, const float* colscale) {
  const int tid = opaque_tid(), lane = tid & 63, wid = tid >> 6, wr = wid >> 2, wc = wid & 3, fr = lane & 15, fq = lane >> 4;
  f32x4 acc[MI][4];
  gemm_main<true, true, MI>(A, lda, 32, B, ldb, 32, K, acc);
  const bf16_t* P = (const bf16_t*)(p.ws + OFF_P);
  bf16_t* Y = (bf16_t*)(p.ws + OFF_H);
#pragma unroll
  for (int q = 0; q < 2; ++q) {
    const int n = ncol0 + wc * 64 + q * 32 + 8 * fq;
    f32x4 cs0 = (f32x4){1.f, 1.f, 1.f, 1.f}, cs1 = cs0;
    if (colscale) { cs0 = *(const f32x4*)(colscale + n); cs1 = *(const f32x4*)(colscale + n + 4); }
#pragma unroll
    for (int mi = 0; mi < MI; ++mi) {
      const int tok = tok0 + wr * (MI * 16) + mi * 16 + fr;
      const u32x4 gw = *(const u32x4*)(P + (size_t)tok * LDP + gcol + n);
      const f32x4 a0 = acc[mi][2 * q], a1 = acc[mi][2 * q + 1];
      u32x4 o;
      o[0] = pack_bf16(a0[0] * cs0[0] * silu_f(bflo(gw[0])), a0[1] * cs0[1] * silu_f(bfhi(gw[0])));
      o[1] = pack_bf16(a0[2] * cs0[2] * silu_f(bflo(gw[1])), a0[3] * cs0[3] * silu_f(bfhi(gw[1])));
      o[2] = pack_bf16(a1[0] * cs1[0] * silu_f(bflo(gw[2])), a1[1] * cs1[1] * silu_f(bfhi(gw[2])));
      o[3] = pack_bf16(a1[2] * cs1[2] * silu_f(bflo(gw[3])), a1[3] * cs1[3] * silu_f(bfhi(gw[3])));
      *(u32x4*)(Y + slab_idx(tok, ycol + n, NTOK)) = o;
    }
  }
}

DI void z_tile(const Params& p, int l, int t) {
  const int pm = t & 63, pn = t >> 6;
  const int tid = opaque_tid(), lane = tid & 63, wid = tid >> 6, wr = wid >> 2, wc = wid & 3, fr = lane & 15, fq = lane >> 4;
  const bf16_t* A = (const bf16_t*)(p.ws + OFF_P) + (size_t)pm * 256 * LDP + PC_FX;
  const bf16_t* B = (const bf16_t*)(p.ws + OFF_WCST) + ((size_t)l * 1024 + pn * 256) * 512;
  f32x4 acc[8][4];
  gemm_main<false, false>(A, LDP, 32, B, 512, 32, 512, acc);
  bf16_t* ZT = (bf16_t*)(p.ws + OFF_ZT);
  const int m0 = pm * 256;
  int S, t0; size_t base;
  if (m0 < NCTX) { S = 256; t0 = 0; base = (size_t)(m0 >> 8) * 262144; }
  else { const int dm = m0 - NCTX; S = 1024; t0 = dm & 1023; base = 32ull * 262144 + (size_t)(dm >> 10) * 512 * LDZ; }
#pragma unroll
  for (int ni = 0; ni < 4; ++ni) {
    const int np = pn * 256 + wc * 64 + ni * 16 + fr, n = np & 511, half = np >> 9;
    bf16_t* row = ZT + base + (size_t)n * (S == 256 ? 512 : LDZ) + half * S + t0;
#pragma unroll
    for (int mi = 0; mi < 8; ++mi) *(u32x2*)(row + wr * 128 + mi * 16 + 4 * fq) = pack4(acc[mi][ni]);
  }
}

DI void out_tile(const Params& p, int l, int t) {
  const int pm = t & 63, pn = t >> 6;
  const int tid = opaque_tid(), lane = tid & 63, wid = tid >> 6, wr = wid >> 2, wc = wid & 3, fr = lane & 15, fq = lane >> 4;
  const bf16_t* A = (const bf16_t*)(p.ws + OFF_H) + (size_t)pm * 256 * 32;
  const bf16_t* B = (const bf16_t*)(p.ws + OFF_WOUTT) + (size_t)l * 2048 * 2048 + (size_t)pn * 256 * 32;
  f32x4 acc[8][4];
  gemm_main<true, true>(A, 32, (size_t)NTOK * 32, B, 32, (size_t)2048 * 32, DM, acc);
  const int m0 = pm * 256;
  const float* gate = (const float*)(p.ws + OFF_MODV) + (size_t)(l * 9 + cvec_of_row(m0)) * 6144 + 4096;
#pragma unroll
  for (int q = 0; q < 2; ++q) {
    const int n = pn * 256 + wc * 64 + q * 32 + 8 * fq;
    const f32x4 g0 = *(const f32x4*)(gate + n), g1 = *(const f32x4*)(gate + n + 4);
#pragma unroll
    for (int mi = 0; mi < 8; ++mi) {
      const int m = m0 + wr * 128 + mi * 16 + fr;
      const float* xin = ((l == 0) ? x_row_l0(p, m) : p.out + (size_t)m * DM) + n;
      const f32x4 x0 = *(const f32x4*)(xin), x1 = *(const f32x4*)(xin + 4);
      float* dst = p.out + (size_t)m * DM + n;
      *(f32x4*)dst = x0 + g0 * acc[mi][2 * q];
      *(f32x4*)(dst + 4) = x1 + g1 * acc[mi][2 * q + 1];
    }
  }
}

DI void seq_of_tok(int tok0, int& S, int& sbase) {
  if (tok0 < NCTX) { S = 256; sbase = tok0 & ~255; } else { S = 1024; sbase = NCTX + ((tok0 - NCTX) & ~1023); }
}

template <int W>
DI void pool_task(const bf16_t* base, int S, int sA, bf16_t* outp) {
  constexpr int HW = W / 2, NR = 7 + W;
  u32x4 rows[NR];
#pragma unroll
  for (int r = 0; r < NR; ++r) {
    const int s = sA - HW + r;
    const bool ok = (s >= 0) && (s < S);
    const u32x4 v = *(const u32x4*)(base + (size_t)min(max(s, 0), S - 1) * LDP);
#pragma unroll
    for (int e = 0; e < 4; ++e) rows[r][e] = ok ? v[e] : 0u;
  }
  float sum[8];
#pragma unroll
  for (int e = 0; e < 8; ++e) sum[e] = 0.f;
#pragma unroll
  for (int r = 0; r < W; ++r)
#pragma unroll
    for (int e = 0; e < 4; ++e) { sum[2 * e] += bflo(rows[r][e]); sum[2 * e + 1] += bfhi(rows[r][e]); }
#pragma unroll
  for (int k = 0; k < 8; ++k) {
    const int s = sA + k;
    const int lo = max(s - HW, 0), hi = min(s - HW + W, S);
    const float inv = 1.f / (float)(hi - lo);
    const u32x4 xv = rows[k + HW];
    u32x4 o4;
#pragma unroll
    for (int e = 0; e < 4; ++e) o4[e] = pack_bf16(sum[2 * e] * inv - bflo(xv[e]), sum[2 * e + 1] * inv - bfhi(xv[e]));
    *(u32x4*)(outp + (size_t)k * 512) = o4;
    if (k < 7) {
#pragma unroll
      for (int e = 0; e < 4; ++e) {
        sum[2 * e] += bflo(rows[k + W][e]) - bflo(rows[k][e]);
        sum[2 * e + 1] += bfhi(rows[k + W][e]) - bfhi(rows[k][e]);
      }
    }
  }
}

DI void pool_item(const Params& p, int t) {
  const int tid = half_tid(), tok0 = t * 32;
  int S, sbase; seq_of_tok(tok0, S, sbase);
  const int g = tid >> 6, run = (tid >> 4) & 3, c0 = g * 128 + (tid & 15) * 8;
  const int sA = tok0 - sbase + run * 8;
  const bf16_t* base = (const bf16_t*)(p.ws + OFF_P) + (size_t)sbase * LDP + PC_PX + c0;
  bf16_t* outp = (bf16_t*)(p.ws + OFF_POOLED) + (size_t)(sbase + sA) * 512 + c0;
  if (g == 0) pool_task<2>(base, S, sA, outp);
  else if (g == 1) pool_task<4>(base, S, sA, outp);
  else if (g == 2) pool_task<8>(base, S, sA, outp);
  else pool_task<16>(base, S, sA, outp);
}

DI void conv_item(const Params& p, int l, int t) {
  const int tid = half_tid(), lane = tid & 63, wid = tid >> 6, tok0 = t * 32;
  int S, sbase; seq_of_tok(tok0, S, sbase);
  const int s0 = tok0 - sbase;
  const bf16_t* P = (const bf16_t*)(p.ws + OFF_P);
  bf16_t* U = (bf16_t*)HSM;
  float* red = (float*)(HSM + 63488);
#pragma unroll 4
  for (int idx = tid; idx < 62 * 64; idx += 256) {
    const int rr = idx >> 6, ch = (idx & 63) * 8, s = s0 - 15 + rr;
    const bool ok = (s >= 0) && (s < S);
    const int sc = min(max(s, 0), S - 1);
    const bf16_t* row = P + (size_t)(sbase + sc) * LDP;
    const u32x4 a = *(const u32x4*)(row + PC_CA + ch), b = *(const u32x4*)(row + PC_CB + ch);
    u32x4 o;
#pragma unroll
    for (int e = 0; e < 4; ++e) { const unsigned v = pack_bf16(bflo(a[e]) * sigmoid_f(bflo(b[e])), bfhi(a[e]) * sigmoid_f(bfhi(b[e]))); o[e] = ok ? v : 0u; }
    *(u32x4*)(U + rr * 512 + ch) = o;
  }
  __syncthreads();
  const int c2 = tid * 2;
  float y0[32], y1[32];
  {
    const f32x2 bb = *(const f32x2*)(SMALLP(p, SM_DWB) + l * 512 + c2);
#pragma unroll
    for (int i = 0; i < 32; ++i) { y0[i] = bb.x; y1[i] = bb.y; }
  }
  const float* dw = SMALLP(p, SM_DW) + (size_t)l * 31 * 512 + c2;
  f32x2 wn = *(const f32x2*)dw;
#pragma unroll 1
  for (int j = 0; j < 31; ++j) {
    const f32x2 w = wn;
    if (j + 1 < 31) wn = *(const f32x2*)(dw + (j + 1) * 512);
    const unsigned wpk = pack_bf16(w.x, w.y), wlo = wpk & 0xffffu, whi = wpk & 0xffff0000u;
    const bf16_t* up = U + j * 512 + c2;
#pragma unroll
    for (int i = 0; i < 32; ++i) {
      const unsigned u = *(const unsigned*)(up + i * 512);
      y0[i] = dot2bf(u, wlo, y0[i]); y1[i] = dot2bf(u, whi, y1[i]);
    }
  }
#pragma unroll
  for (int i = 0; i < 32; ++i) {
    const float s1 = wave_sum_dpp(y0[i] + y1[i]);
    const float s2 = wave_sum_dpp(y0[i] * y0[i] + y1[i] * y1[i]);
    if (lane == 0) { red[(wid * 32 + i) * 2] = s1; red[(wid * 32 + i) * 2 + 1] = s2; }
  }
  __syncthreads();
  const f32x2 lg = *(const f32x2*)(SMALLP(p, SM_LNG) + l * 512 + c2), lb = *(const f32x2*)(SMALLP(p, SM_LNB) + l * 512 + c2);
  bf16_t* out = (bf16_t*)(p.ws + OFF_CONVACT);
#pragma unroll
  for (int i = 0; i < 32; ++i) {
    float s1 = 0.f, s2 = 0.f;
#pragma unroll
    for (int w = 0; w < 4; ++w) { s1 += red[(w * 32 + i) * 2]; s2 += red[(w * 32 + i) * 2 + 1]; }
    const float mean = s1 * (1.f / 512.f), var = s2 * (1.f / 512.f) - mean * mean, rstd = rsqrtf(var + EPS);
    const float a0 = silu_f((y0[i] - mean) * rstd * lg.x + lb.x), a1 = silu_f((y1[i] - mean) * rstd * lg.y + lb.y);
    *(unsigned*)(out + (size_t)(tok0 + i) * 512 + c2) = pack_bf16(a0, a1);
  }
}

DI void attn_item(const Params& p, int l, bool dec, int b, int h, int qt) {
  const int tid = half_tid(), lane = tid & 63, wid = tid >> 6, fr = lane & 15, fq = lane >> 4;
  const int S = dec ? 1024 : 256;
  const int tok0 = dec ? NCTX + b * 1024 : b * 256;
  const int nkt = dec ? 20 : 4, ncache = dec ? 4 : 0;
  const bf16_t* P = (const bf16_t*)(p.ws + OFF_P);
  const float lam_init = (l == 0) ? 0.2f : 0.35550906f;
  float lam;
  {
    const float* dl = SMALLP(p, SM_DLAM) + l * 256;
    const float a = wave_sum(dl[lane] * dl[64 + lane]), c = wave_sum(dl[128 + lane] * dl[192 + lane]);
    lam = __expf(a) - __expf(c) + lam_init;
  }
  const int q0 = qt * 64 + wid * 16;
  bf16x8 qf[2][2];
  {
    const bf16_t* qrow = P + (size_t)(tok0 + q0 + fr) * LDP + PC_Q + h * 128;
#pragma unroll
    for (int m = 0; m < 2; ++m)
#pragma unroll
      for (int ks = 0; ks < 2; ++ks) qf[m][ks] = *(const bf16x8*)(qrow + m * 64 + ks * 32 + fq * 8);
  }
  const size_t blh = (size_t)((b * 2 + l) * 4 + h);
  const bf16_t* kc = (const bf16_t*)(p.ws + OFF_KC) + blh * 32768;
  const bf16_t* vtc = (const bf16_t*)(p.ws + OFF_VTC) + blh * 32768;
  const bf16_t* kn = P + (size_t)tok0 * LDP + PC_K + h * 128;
  const bf16_t* vtn = (const bf16_t*)(p.ws + OFF_VTN) + (dec ? (size_t)32 * 131072 + (size_t)b * 524288 : (size_t)b * 131072) + (size_t)h * 128 * S;
  char* Ks = HSM;
  char* Vs = HSM + 17408;
  u32x4 rk[4], rv[4];
  auto load_tile = [&](int kt) {
    if (kt < ncache) {
#pragma unroll
      for (int i = 0; i < 4; ++i) {
        const int idx = tid + i * 256;
        rk[i] = *(const u32x4*)(kc + (size_t)(kt * 64 + (idx >> 4)) * 128 + (idx & 15) * 8);
        rv[i] = *(const u32x4*)(vtc + (size_t)(idx >> 3) * 256 + kt * 64 + (idx & 7) * 8);
      }
    } else {
      const int kk = (kt - ncache) * 64;
#pragma unroll
      for (int i = 0; i < 4; ++i) {
        const int idx = tid + i * 256;
        rk[i] = *(const u32x4*)(kn + (size_t)(kk + (idx >> 4)) * LDP + (idx & 15) * 8);
        rv[i] = *(const u32x4*)(vtn + (size_t)(idx >> 3) * S + kk + (idx & 7) * 8);
      }
    }
  };
  float m_run[2] = {-INFINITY, -INFINITY}, l_run[2] = {0.f, 0.f};
  f32x4 O[2][8];
#pragma unroll
  for (int m = 0; m < 2; ++m)
#pragma unroll
    for (int d = 0; d < 8; ++d) O[m][d] = (f32x4){0.f, 0.f, 0.f, 0.f};
  const float cexp = 0.125f * 1.4426950408889634f;
  load_tile(0);
#pragma unroll 1
  for (int kt = 0; kt < nkt; ++kt) {
    __syncthreads();
#pragma unroll
    for (int i = 0; i < 4; ++i) {
      const int idx = tid + i * 256;
      *(u32x4*)(Ks + (idx >> 4) * 272 + (idx & 15) * 16) = rk[i];
      *(u32x4*)(Vs + (idx >> 3) * 144 + (idx & 7) * 16) = rv[i];
    }
    __syncthreads();
    if (kt + 1 < nkt) load_tile(kt + 1);
    bf16x8 pf[2][2];
#pragma unroll
    for (int m = 0; m < 2; ++m) {
      f32x4 s[4];
#pragma unroll
      for (int ksub = 0; ksub < 4; ++ksub) {
        f32x4 a = (f32x4){0.f, 0.f, 0.f, 0.f};
#pragma unroll
        for (int ks = 0; ks < 2; ++ks) {
          const bf16x8 kf = *(const bf16x8*)(Ks + (ksub * 16 + fr) * 272 + m * 128 + ks * 64 + fq * 16);
          a = MFMA16(kf, qf[m][ks], a);
        }
        s[ksub] = a;
      }
      float mx = s[0][0];
#pragma unroll
      for (int ksub = 0; ksub < 4; ++ksub)
#pragma unroll
        for (int j = 0; j < 4; ++j) mx = fmaxf(mx, s[ksub][j]);
      mx = xrow_max(mx);
      const float mn = fmaxf(m_run[m], mx);
      const float alpha = __builtin_amdgcn_exp2f((m_run[m] - mn) * cexp);
      m_run[m] = mn;
      float ls = 0.f;
#pragma unroll
      for (int ksub = 0; ksub < 4; ++ksub)
#pragma unroll
        for (int j = 0; j < 4; ++j) { const float e = __builtin_amdgcn_exp2f((s[ksub][j] - mn) * cexp); s[ksub][j] = e; ls += e; }
      l_run[m] = l_run[m] * alpha + ls;
      if (__any(alpha != 1.f)) {
#pragma unroll
        for (int d = 0; d < 8; ++d) O[m][d] *= alpha;
      }
#pragma unroll
      for (int k2 = 0; k2 < 2; ++k2) {
        u32x4 w;
        w[0] = pack_bf16(s[2 * k2][0], s[2 * k2][1]); w[1] = pack_bf16(s[2 * k2][2], s[2 * k2][3]);
        w[2] = pack_bf16(s[2 * k2 + 1][0], s[2 * k2 + 1][1]); w[3] = pack_bf16(s[2 * k2 + 1][2], s[2 * k2 + 1][3]);
        pf[m][k2] = __builtin_bit_cast(bf16x8, w);
      }
      asm volatile("" ::: "memory");
    }
#pragma unroll
    for (int k2 = 0; k2 < 2; ++k2) {
      asm volatile("" ::: "memory");
#pragma unroll
      for (int d = 0; d < 8; ++d) {
        const char* vp = Vs + (d * 16 + fr) * 144 + (k2 * 32 + 4 * fq) * 2;
        const s16x4 lo = *(const s16x4*)vp, hi = *(const s16x4*)(vp + 32);
        const bf16x8 vf = __builtin_shufflevector(lo, hi, 0, 1, 2, 3, 4, 5, 6, 7);
        O[0][d] = MFMA16(vf, pf[0][k2], O[0][d]);
        O[1][d] = MFMA16(vf, pf[1][k2], O[1][d]);
      }
    }
  }
#pragma unroll
  for (int m = 0; m < 2; ++m) l_run[m] = xrow_sum(l_run[m]);
  const float inv1 = 1.f / l_run[0], inv2 = lam / l_run[1];
  float ss = 0.f;
#pragma unroll
  for (int d = 0; d < 8; ++d)
#pragma unroll
    for (int j = 0; j < 4; ++j) { const float o = O[0][d][j] * inv1 - O[1][d][j] * inv2; O[0][d][j] = o; ss += o * o; }
  ss = xrow_sum(ss);
  const float rstd = rsqrtf(ss * (1.f / 128.f) + EPS) * (1.f - lam_init);
  const int tok = tok0 + q0 + fr;
  bf16_t* Y = (bf16_t*)(p.ws + OFF_H);
#pragma unroll
  for (int d = 0; d < 8; ++d) {
    const int dv = d * 16 + 4 * fq;
    const f32x4 g4 = *(const f32x4*)(SMALLP(p, SM_SUBLN) + l * 128 + dv);
    const u32x2 gw = *(const u32x2*)(P + (size_t)tok * LDP + PC_AG + h * 128 + dv);
    f32x4 o;
    o[0] = O[0][d][0] * rstd * g4[0] * silu_f(bflo(gw.x));
    o[1] = O[0][d][1] * rstd * g4[1] * silu_f(bfhi(gw.x));
    o[2] = O[0][d][2] * rstd * g4[2] * silu_f(bflo(gw.y));
    o[3] = O[0][d][3] * rstd * g4[3] * silu_f(bfhi(gw.y));
    *(u32x2*)(Y + slab_idx(tok, 1024 + h * 128 + dv, NTOK)) = pack4(o);
  }
}

__global__ void __launch_bounds__(512, 2) fwd_megakernel(Params p) {
  cg::grid_group grid = cg::this_grid();
  unsigned* sync = (unsigned*)(p.ws + OFF_SYNC);
  unsigned* queues = (unsigned*)(p.ws + OFF_QUEUE);
  if (threadIdx.x == 0) { g_sh[1] = 0u; g_sh[2] = 0u; }
  __syncthreads();
  if (threadIdx.x == 0) (void)xb_add(&sync[XB_XCNT(xb_xcc_id())], 1u);
  if (p.never) grid.sync();
  phase0(p);
  grid_barrier(sync, 0);
  for (int l = 0; l < 2; ++l) {
    norm_phase(p, l);
    grid_barrier(sync, 0);
    for (int t = blockIdx.x; t < 1280; t += gridDim.x) g1_tile(p, l, t);
    for (int ht = blockIdx.x; ht < 256; ht += gridDim.x) g1_half_tile(p, l, ht);
    grid_barrier(sync, 0);
    {
      unsigned* q = queues + 64 * (l * 2);
      for (;;) {
        const int it = queue_next(q);
        if (it >= 1280) break;
        const int hf = half_id();
        if (it < 256) { const int a = it * 2 + hf; attn_item(p, l, true, a >> 6, (a >> 4) & 3, a & 15); }
        else if (it < 512) z_tile(p, l, it - 256);
        else if (it < 768) conv_item(p, l, (it - 512) * 2 + hf);
        else if (it < 1024) { const int a = (it - 768) * 2 + hf; attn_item(p, l, false, a >> 4, (a >> 2) & 3, a & 3); }
        else pool_item(p, (it - 1024) * 2 + hf);
      }
    }
    grid_barrier(sync, 0);
    {
      unsigned* q = queues + 64 * (1 + l * 2);
      for (;;) {
        const int it = queue_next(q);
        if (it >= 448) break;
        if (it < 128) {
          const int seq = it >> 4, mh = (it >> 1) & 7, nt = it & 1;
          gated_gemm_tile<4>(p, (const bf16_t*)(p.ws + OFF_DDEC) + (size_t)mh * 128 * LDD, LDD,
                             (const bf16_t*)(p.ws + OFF_ZT) + 32ull * 262144 + (size_t)seq * 512 * LDZ + (size_t)nt * 256 * LDZ, LDZ, 2048,
                             NCTX + seq * 1024 + mh * 128, nt * 256, PC_FG, 0, nullptr);
        } else if (it < 256) {
          const int t = it - 128, pm = t & 63, pn = t >> 6;
          gated_gemm_tile(p, (const bf16_t*)(p.ws + OFF_CONVACT) + (size_t)pm * 256 * 512, 512,
                          (const bf16_t*)(p.ws + OFF_WPWT) + ((size_t)l * 512 + pn * 256) * 512, 512, 512, pm * 256, pn * 256, PC_CG, 1536, nullptr);
        } else if (it < 320) {
          const int t = it - 256, seq = t >> 1, nt = t & 1;
          gated_gemm_tile(p, (const bf16_t*)(p.ws + OFF_DCTX), LDC, (const bf16_t*)(p.ws + OFF_ZT) + (size_t)seq * 262144 + (size_t)nt * 256 * 512, 512, 512,
                          seq * 256, nt * 256, PC_FG, 0, nullptr);
        } else {
          const int t = it - 320, pm = t & 63, pr = t >> 6;
          gated_gemm_tile(p, (const bf16_t*)(p.ws + OFF_POOLED) + (size_t)pm * 256 * 512 + pr * 256, 512,
                          (const bf16_t*)(p.ws + OFF_WPOOLT) + (size_t)(l * 2 + pr) * 65536, 256, 256, pm * 256, pr * 256, PC_PG, 512, SMALLP(p, SM_POOLSC) + l * 512);
        }
      }
    }
    grid_barrier(sync, 0);
    for (int t = blockIdx.x; t < 64 * 8; t += gridDim.x) out_tile(p, l, t);
    grid_barrier(sync, 0);
  }
  final_phase(p);
}

extern "C" void kernel_launch(void* const* d_in, const int* in_sizes, int n_in, void* d_out, int out_size, void* d_ws, size_t ws_size,
                              hipStream_t stream) {
  static int grid_blocks = 0;
  if (!grid_blocks) {
    int dev = 0, cus = 0, per_cu = 0;
    (void)hipGetDevice(&dev);
    (void)hipDeviceGetAttribute(&cus, hipDeviceAttributeMultiprocessorCount, dev);
    (void)hipFuncSetAttribute((const void*)fwd_megakernel, hipFuncAttributeMaxDynamicSharedMemorySize, (int)kDynLds);
    (void)hipOccupancyMaxActiveBlocksPerMultiprocessor(&per_cu, fwd_megakernel, 512, kDynLds);
    if (per_cu > 1) per_cu = 1;
    if (per_cu < 1) per_cu = 1;
    grid_blocks = cus * per_cu;
  }
  Params p{};
  const float** pp = (const float**)&p;
  for (int i = 0; i < 22; ++i) pp[i] = (const float*)d_in[i];
  p.out = (float*)d_out;
  p.ws = (unsigned char*)d_ws;
  (void)hipMemsetAsync(d_ws, 0, ZERO_BYTES, stream);
  void* args[] = {&p};
  hipError_t e = hipLaunchCooperativeKernel((void*)fwd_megakernel, dim3(grid_blocks), dim3(512), args, kDynLds, stream);
  if (e != hipSuccess) fprintf(stderr, "cooperative launch failed: %s (grid %d)\n", hipGetErrorString(e), grid_blocks);
}
```

```cpp
#include <hip/hip_runtime.h>
#include <hip/hip_cooperative_groups.h>
#include <stdint.h>
#include <cstdio>
namespace cg = cooperative_groups;

typedef unsigned short bf16_t;
typedef short bf16x8 __attribute__((ext_vector_type(8)));
typedef short s16x4 __attribute__((ext_vector_type(4)));
typedef float f32x4 __attribute__((ext_vector_type(4)));
typedef float f32x2 __attribute__((ext_vector_type(2)));
typedef unsigned u32x4 __attribute__((ext_vector_type(4)));
typedef unsigned u32x2 __attribute__((ext_vector_type(2)));
#define DI __device__ __forceinline__
#define LDSP __attribute__((address_space(3))) void*
#define MFMA16(a, b, c) __builtin_amdgcn_mfma_f32_16x16x32_bf16((a), (b), (c), 0, 0, 0)

constexpr int DM = 2048, NTOK = 16384, NCTX = 8192;
constexpr int LDP = 5120;
constexpr int PC_FX = 0, PC_FG = 512, PC_PX = 1024, PC_PG = 1536, PC_Q = 2048, PC_K = 2560, PC_AG = 3072, PC_CA = 3584, PC_CB = 4096, PC_CG = 4608;
constexpr float EPS = 1e-6f;
constexpr int LDD = 2112;
constexpr int LDZ = 2112;
constexpr int LDC = 576;

constexpr size_t OFF_SYNC = 0;
constexpr size_t OFF_QUEUE = 16384;
constexpr size_t OFF_MODV = 20480;
constexpr size_t SZ_MODV = 2ull * 9 * 6144 * 4;
constexpr size_t ZERO_BYTES = OFF_MODV + SZ_MODV;
constexpr size_t OFF_ROPE = ZERO_BYTES;
constexpr size_t OFF_P = OFF_ROPE + 8192;
constexpr size_t OFF_H = OFF_P + (size_t)NTOK * LDP * 2;
constexpr size_t OFF_ZT = OFF_H + (size_t)NTOK * DM * 2;
constexpr size_t OFF_VTN = OFF_ZT + (32ull * 262144 + 8ull * 512 * LDZ) * 2;
constexpr size_t OFF_POOLED = OFF_VTN + (size_t)NTOK * 512 * 2;
constexpr size_t OFF_CONVACT = OFF_POOLED + (size_t)NTOK * 512 * 2;
constexpr size_t OFF_WINT = OFF_CONVACT + (size_t)NTOK * 512 * 2;
constexpr size_t OFF_WOUTT = OFF_WINT + 2ull * 5632 * 2048 * 2;
constexpr size_t OFF_WCST = OFF_WOUTT + 2ull * 2048 * 2048 * 2;
constexpr size_t OFF_WPOOLT = OFF_WCST + 2ull * 1024 * 512 * 2;
constexpr size_t OFF_WPWT = OFF_WPOOLT + 2ull * 2 * 256 * 256 * 2;
constexpr size_t OFF_KC = OFF_WPWT + 2ull * 512 * 512 * 2;
constexpr size_t OFF_VTC = OFF_KC + 8ull * 2 * 4 * 256 * 128 * 2;
constexpr size_t OFF_DCTX = OFF_VTC + 8ull * 2 * 4 * 256 * 128 * 2;
constexpr size_t OFF_DDEC = OFF_DCTX + 256ull * LDC * 2;
constexpr size_t OFF_SMALL = OFF_DDEC + 1024ull * LDD * 2;
constexpr int SM_NORMG = 0, SM_POOLSC = 4096, SM_DLAM = 5120, SM_SUBLN = 5632, SM_DW = 5888, SM_DWB = 37632, SM_LNG = 38656, SM_LNB = 39680, SM_FINALG = 40704, SM_TOTAL = 42752;
constexpr size_t WS_TOTAL = OFF_SMALL + (size_t)SM_TOTAL * 4;
static_assert(WS_TOTAL <= 402653184ull, "workspace too large");

struct Params {
  const float *x_prompt, *x_sample, *cache_k, *cache_v, *c, *c_ctx, *norm_g, *w_mod, *b_mod, *w_in, *w_fourier, *w_pool,
      *pool_scale, *diff_lambda, *subln_g, *conv_dw, *conv_dw_b, *conv_ln_g, *conv_ln_b, *w_conv_pw, *w_out, *final_g;
  float* out;
  unsigned char* ws;
  unsigned long long never;
};

extern __shared__ __attribute__((aligned(16))) char g_smem[];
constexpr size_t kDynLds = 131072;
#define HSM (g_smem + (half_id() << 16))
__shared__ unsigned g_sh[4];

#define SMALLP(p, off) ((const float*)((p).ws + OFF_SMALL) + (off))
DI size_t slab_idx(int row, int col, int nrows) { return ((size_t)(col >> 5) * nrows + row) * 32 + (col & 31); }
DI float bf2f(unsigned u16) { return __uint_as_float(u16 << 16); }
DI float bflo(unsigned w) { return __uint_as_float(w << 16); }
DI float bfhi(unsigned w) { return __uint_as_float(w & 0xffff0000u); }
DI unsigned pack_bf16(float lo, float hi) { unsigned r; asm("v_cvt_pk_bf16_f32 %0, %1, %2" : "=v"(r) : "v"(lo), "v"(hi)); return r; }
DI float silu_f(float x) { return x * __builtin_amdgcn_rcpf(1.f + __expf(-x)); }
DI float sigmoid_f(float x) { return __builtin_amdgcn_rcpf(1.f + __expf(-x)); }
DI int opaque_tid() { int t = threadIdx.x; asm volatile("" : "+v"(t)); return t; }
DI int half_tid() { return opaque_tid() & 255; }
DI int half_id() { return opaque_tid() >> 8; }
DI float wave_sum(float v) {
#pragma unroll
  for (int o = 32; o >= 1; o >>= 1) v += __shfl_xor(v, o);
  return v;
}
typedef __bf16 bf2_t __attribute__((ext_vector_type(2)));
DI float dot2bf(unsigned a, unsigned b, float c) { return __builtin_amdgcn_fdot2_f32_bf16(__builtin_bit_cast(bf2_t, a), __builtin_bit_cast(bf2_t, b), c, false); }
DI float xrow_max(float v) {
  u32x2 r = __builtin_amdgcn_permlane16_swap(__float_as_uint(v), __float_as_uint(v), false, false);
  v = fmaxf(__uint_as_float(r[0]), __uint_as_float(r[1]));
  r = __builtin_amdgcn_permlane32_swap(__float_as_uint(v), __float_as_uint(v), false, false);
  return fmaxf(__uint_as_float(r[0]), __uint_as_float(r[1]));
}
DI float xrow_sum(float v) {
  u32x2 r = __builtin_amdgcn_permlane16_swap(__float_as_uint(v), __float_as_uint(v), false, false);
  v = __uint_as_float(r[0]) + __uint_as_float(r[1]);
  r = __builtin_amdgcn_permlane32_swap(__float_as_uint(v), __float_as_uint(v), false, false);
  return __uint_as_float(r[0]) + __uint_as_float(r[1]);
}
DI u32x2 pack4(f32x4 v) { u32x2 r; r.x = pack_bf16(v[0], v[1]); r.y = pack_bf16(v[2], v[3]); return r; }

#define XB_TMO      128
#define XB_XCNT(j)  (256  + 64 * (j))
#define XB_XSUB(j)  (1280 + 64 * (j))
#define XB_XGEN(j)  (2304 + 64 * (j))
#define XB_TOP      3328
#define XB_TOPGEN   3392
#define XB_SPIN_CAP (1u << 20)
DI unsigned xb_ld(unsigned* p) { return __hip_atomic_load(p, __ATOMIC_RELAXED, __HIP_MEMORY_SCOPE_AGENT); }
DI unsigned xb_add(unsigned* p, unsigned v) { return __hip_atomic_fetch_add(p, v, __ATOMIC_RELAXED, __HIP_MEMORY_SCOPE_AGENT); }
DI unsigned xb_xcc_id() { return (unsigned)__builtin_amdgcn_s_getreg((3 << 11) | 20) & 0xFu; }
#define XB_SPIN(cond, bar) do { unsigned _sp = 0; while (cond) { __builtin_amdgcn_s_sleep(1); \
    if ((++_sp & 255u) == 0u) { if (xb_ld(&(bar)[XB_TMO])) break; if (_sp > XB_SPIN_CAP) { atomicAdd(&(bar)[XB_TMO], 1u); break; } } } } while (0)
DI void xcd_barrier_complete(unsigned* bar, unsigned x, unsigned& nloc, unsigned& nx) {
  const unsigned G = gridDim.x;
  unsigned sum, cnt, mine, sp = 0u;
  for (;;) {
    sum = 0u; cnt = 0u; mine = 0u;
#pragma unroll
    for (unsigned j = 0; j < 16; ++j) { const unsigned c = xb_ld(&bar[XB_XCNT(j)]); sum += c; cnt += (c > 0u) ? 1u : 0u; mine = (j == x) ? c : mine; }
    if (sum == G) break;
    __builtin_amdgcn_s_sleep(1);
    if ((++sp & 255u) == 0u) { if (xb_ld(&bar[XB_TMO])) break; if (sp > XB_SPIN_CAP) { atomicAdd(&bar[XB_TMO], 1u); break; } }
  }
  nloc = mine > 0u ? mine : 1u; nx = cnt > 0u ? cnt : 1u;
}
DI void grid_barrier(unsigned* bar, unsigned) {
  asm volatile("s_waitcnt vmcnt(0)" ::: "memory");
  __syncthreads();
  if (threadIdx.x == 0) {
    __builtin_amdgcn_s_waitcnt(0);
    const unsigned x = xb_xcc_id();
    volatile unsigned* st = g_sh;
    unsigned nloc = st[1], nx = st[2];
    if (nloc == 0u) { xcd_barrier_complete(bar, x, nloc, nx); st[1] = nloc; st[2] = nx; }
    const unsigned old = xb_add(&bar[XB_XSUB(x)], 1u);
    const unsigned gen = old / nloc;
    if (old + 1u == (gen + 1u) * nloc) {
      __builtin_amdgcn_fence(__ATOMIC_RELEASE, "agent");
      asm volatile("s_waitcnt vmcnt(0)" ::: "memory");
      const unsigned og = xb_add(&bar[XB_TOP], 1u);
      const unsigned tg = og / nx;
      if (og + 1u == (tg + 1u) * nx) xb_add(&bar[XB_TOPGEN], 1u);
      else XB_SPIN(xb_ld(&bar[XB_TOPGEN]) == tg, bar);
      __builtin_amdgcn_fence(__ATOMIC_ACQUIRE, "agent");
      xb_add(&bar[XB_XGEN(x)], 1u);
      asm volatile("s_waitcnt vmcnt(0)" ::: "memory");
    } else {
      XB_SPIN(xb_ld(&bar[XB_XGEN(x)]) == gen, bar);
      __builtin_amdgcn_fence(__ATOMIC_ACQUIRE, "agent");
      asm volatile("s_waitcnt vmcnt(0)" ::: "memory");
    }
  }
  __syncthreads();
}

DI int queue_next(unsigned* q) {
  __syncthreads();
  if (threadIdx.x == 0) g_sh[0] = __hip_atomic_fetch_add(q, 1u, __ATOMIC_RELAXED, __HIP_MEMORY_SCOPE_AGENT);
  __syncthreads();
  return (int)g_sh[0];
}

template <int CTRL, int ROWMASK> DI float dpp_add(float v) {
  const int t = __builtin_amdgcn_update_dpp(0, __float_as_int(v), CTRL, ROWMASK, 0xf, false);
  return v + __int_as_float(t);
}
DI float wave_sum_dpp(float v) {
  v = dpp_add<0x111, 0xf>(v); v = dpp_add<0x112, 0xf>(v); v = dpp_add<0x114, 0xf>(v); v = dpp_add<0x118, 0xf>(v);
  v = dpp_add<0x142, 0xa>(v); v = dpp_add<0x143, 0xc>(v);
  return __int_as_float(__builtin_amdgcn_readlane(__float_as_int(v), 63));
}

template <bool TRANS, bool PERM, int MI = 8>
DI void gemm_main(const bf16_t* A, int lda, size_t ksA, const bf16_t* B, int ldb, size_t ksB, int K, f32x4 (&acc)[MI][4]) {
  const int tid = opaque_tid(), lane = tid & 63, wid = tid >> 6, wr = wid >> 2, wc = wid & 3, fr = lane & 15, fq = lane >> 4;
  const int lrow = tid >> 2, lch = tid & 3;
  const int lsw = (lch ^ (((lrow >> 3) & 1) << 1)) * 8;
  const bf16_t* ga = A + (size_t)lrow * lda + lsw;
  const int rho = lrow & 31;
  const int lrow_b = PERM ? ((lrow & ~31) | (8 * ((rho & 15) >> 2) + 4 * (rho >> 4) + (rho & 3))) : lrow;
  const bf16_t* gb = B + (size_t)lrow_b * ldb + lsw;
  const size_t sa = (size_t)128 * lda, sb = (size_t)128 * ldb;
#pragma unroll
  for (int mi = 0; mi < MI; ++mi)
#pragma unroll
    for (int ni = 0; ni < 4; ++ni) acc[mi][ni] = (f32x4){0.f, 0.f, 0.f, 0.f};
  char* lbase = g_smem + tid * 16;
#define GLDS_ISSUE(STG)                                                                                              \
  do {                                                                                                               \
    char* l_ = lbase + (STG) * 32768;                                                                                \
    __builtin_amdgcn_global_load_lds((const unsigned*)(ga), (LDSP)(l_), 16, 0, 0);                                   \
    if (MI == 8) __builtin_amdgcn_global_load_lds((const unsigned*)(ga + sa), (LDSP)(l_ + 8192), 16, 0, 0);          \
    __builtin_amdgcn_global_load_lds((const unsigned*)(gb), (LDSP)(l_ + 16384), 16, 0, 0);                           \
    __builtin_amdgcn_global_load_lds((const unsigned*)(gb + sb), (LDSP)(l_ + 24576), 16, 0, 0);                      \
    ga += ksA; gb += ksB;                                                                                            \
  } while (0)
  asm volatile("s_waitcnt vmcnt(0)" ::: "memory");
  __syncthreads();
  const int nk = K >> 5;
  GLDS_ISSUE(0);
  GLDS_ISSUE(1);
  GLDS_ISSUE(2);
  const int rsw = (fq ^ (((fr >> 3) & 1) << 1)) * 16;
  const int aofs = (wr * (MI * 16) + fr) * 64 + rsw;
  const int bofs = 16384 + (wc * 64 + fr) * 64 + rsw;
  if (MI == 8) asm volatile("s_waitcnt vmcnt(8)" ::: "memory"); else asm volatile("s_waitcnt vmcnt(6)" ::: "memory");
  __builtin_amdgcn_s_barrier();
  if (wid >= 4) __builtin_amdgcn_s_barrier();
  int scur = 0, snxt = 3;
  for (int kt = 0; kt < nk; ++kt) {
    const char* st = g_smem + scur * 32768;
    bf16x8 af[MI], bfr[4];
#pragma unroll
    for (int mi = 0; mi < MI; ++mi) af[mi] = *(const bf16x8*)(st + aofs + mi * 1024);
#pragma unroll
    for (int ni = 0; ni < 4; ++ni) bfr[ni] = *(const bf16x8*)(st + bofs + ni * 1024);
    if (kt + 3 < nk) { GLDS_ISSUE(snxt); if (MI == 8) asm volatile("s_waitcnt vmcnt(8) lgkmcnt(0)" ::: "memory"); else asm volatile("s_waitcnt vmcnt(6) lgkmcnt(0)" ::: "memory"); }
    else if (kt + 2 < nk) { if (MI == 8) asm volatile("s_waitcnt vmcnt(4) lgkmcnt(0)" ::: "memory"); else asm volatile("s_waitcnt vmcnt(3) lgkmcnt(0)" ::: "memory"); }
    else asm volatile("s_waitcnt vmcnt(0) lgkmcnt(0)" ::: "memory");
    __builtin_amdgcn_sched_barrier(0);
    __builtin_amdgcn_s_barrier();
    __builtin_amdgcn_sched_barrier(0);
#pragma unroll
    for (int mi = 0; mi < MI; ++mi)
#pragma unroll
      for (int ni = 0; ni < 4; ++ni)
        acc[mi][ni] = TRANS ? MFMA16(bfr[ni], af[mi], acc[mi][ni]) : MFMA16(af[mi], bfr[ni], acc[mi][ni]);
    __builtin_amdgcn_sched_barrier(0);
    __builtin_amdgcn_s_barrier();
    __builtin_amdgcn_sched_barrier(0);
    scur = (scur + 1) & 3;
    snxt = (snxt + 1) & 3;
  }
  if (wid < 4) __builtin_amdgcn_s_barrier();
#undef GLDS_ISSUE
}

DI void transpose_tile(const float* src, int ldn, bf16_t* dst, int ldk, int k0, int n0, int slab_rows = 0) {
  float* t = (float*)HSM;
  const int tid = half_tid();
  __syncthreads();
  f32x4 v[8];
#pragma unroll
  for (int i = 0; i < 8; ++i) {
    const int idx = tid + i * 256, r = idx >> 5, c4 = (idx & 31) * 4;
    v[i] = *(const f32x4*)(src + (size_t)(k0 + r) * ldn + n0 + c4);
  }
#pragma unroll
  for (int i = 0; i < 8; ++i) {
    const int idx = tid + i * 256, r = idx >> 5, c4 = (idx & 31) * 4;
    t[r * 129 + c4 + 0] = v[i][0]; t[r * 129 + c4 + 1] = v[i][1]; t[r * 129 + c4 + 2] = v[i][2]; t[r * 129 + c4 + 3] = v[i][3];
  }
  __syncthreads();
#pragma unroll
  for (int i = 0; i < 4; ++i) {
    const int idx = tid + i * 256, n = idx >> 3, kc = (idx & 7) * 8;
    u32x4 o;
    o[0] = pack_bf16(t[(kc + 0) * 129 + n], t[(kc + 1) * 129 + n]);
    o[1] = pack_bf16(t[(kc + 2) * 129 + n], t[(kc + 3) * 129 + n]);
    o[2] = pack_bf16(t[(kc + 4) * 129 + n], t[(kc + 5) * 129 + n]);
    o[3] = pack_bf16(t[(kc + 6) * 129 + n], t[(kc + 7) * 129 + n]);
    if (slab_rows) *(u32x4*)(dst + slab_idx(n0 + n, k0 + kc, slab_rows)) = o;
    else *(u32x4*)(dst + (size_t)(n0 + n) * ldk + k0 + kc) = o;
  }
}

DI void mod_item(const Params& p, int it) {
  const int tid = half_tid();
  const int l = it / 192, r = it % 192, kc = r / 6, cb = r % 6;
  float* sl = (float*)HSM;
  __syncthreads();
  for (int idx = tid; idx < 576; idx += 256) {
    const int j = idx >> 6, k = idx & 63;
    const float* src = (j == 0) ? p.c_ctx : p.c + (j - 1) * 2048;
    sl[idx] = silu_f(src[kc * 64 + k]);
  }
  __syncthreads();
  const int col = cb * 1024 + tid * 4;
  f32x4 acc[9];
#pragma unroll
  for (int j = 0; j < 9; ++j) acc[j] = (f32x4){0.f, 0.f, 0.f, 0.f};
  const float* w = p.w_mod + ((size_t)l * 2048 + kc * 64) * 6144 + col;
#pragma unroll 4
  for (int k = 0; k < 64; ++k) {
    const f32x4 wv = *(const f32x4*)(w + (size_t)k * 6144);
#pragma unroll
    for (int j = 0; j < 9; ++j) acc[j] += wv * sl[j * 64 + k];
  }
  float* part = p.out + (size_t)(kc * 18 + l * 9) * 6144 + col;
#pragma unroll
  for (int j = 0; j < 9; ++j) *(f32x4*)(part + (size_t)j * 6144) = acc[j];
}

DI void mod_reduce(const Params& p) {
  float* modv = (float*)(p.ws + OFF_MODV);
  for (int e = (blockIdx.x * 512 + opaque_tid()) * 4; e < 18 * 6144; e += gridDim.x * 512 * 4) {
    const int lj = e / 6144, col = e - lj * 6144, l = lj / 9;
    f32x4 a = *(const f32x4*)(p.b_mod + l * 6144 + col);
#pragma unroll 8
    for (int kc = 0; kc < 32; ++kc) a += *(const f32x4*)(p.out + (size_t)kc * 18 * 6144 + e);
    *(f32x4*)(modv + e) = a;
  }
}

DI void fourier_fold_item(const Params& p, int it) {
  const int tid = half_tid();
  const int l = it >> 10, r = it & 1023, k = r >> 1, nb = r & 1;
  const int g = k >> 7, c = k & 127, n = nb * 256 + tid;
  float* tab = (float*)HSM;
  __syncthreads();
  if (tid < 128) { const float rev = (float)tid * (1.f / 128.f); tab[tid] = __builtin_amdgcn_cosf(rev); tab[128 + tid] = __builtin_amdgcn_sinf(rev); }
  __syncthreads();
  const float* w = p.w_fourier + ((size_t)(l * 512 + g * 128)) * 512 + n;
  float ac = 0.f, as = 0.f;
#pragma unroll 16
  for (int j = 0; j < 128; ++j) { const float wv = w[(size_t)j * 512]; const int ti = (c * j) & 127; ac += tab[ti] * wv; as += tab[128 + ti] * wv; }
  bf16_t* dst = (bf16_t*)(p.ws + OFF_WCST);
  dst[((size_t)(l * 1024 + n)) * 512 + k] = (bf16_t)(pack_bf16(ac * 0.08838834764831845f, 0.f) & 0xffffu);
  dst[((size_t)(l * 1024 + 512 + n)) * 512 + k] = (bf16_t)(pack_bf16(as * 0.08838834764831845f, 0.f) & 0xffffu);
}

DI void phase0(const Params& p) {
  const int tid = half_tid();
  constexpr int N_MOD = 384, N_WIN = 2816, N_WOUT = 1024, N_WPW = 64, N_WPOOL = 128, N_CV = 256, N_CK = 1024, N_DCTX = 64, N_DDEC = 1024, N_ROPE = 2, N_FF = 2048, N_SM = 24;
  constexpr int E0 = N_MOD, E1 = E0 + N_WIN, E2 = E1 + N_WOUT, E3 = E2 + N_WPW, E4 = E3 + N_WPOOL, E5 = E4 + N_CV, E6 = E5 + N_CK, E7 = E6 + N_DCTX,
                E8 = E7 + N_DDEC, E9 = E8 + N_ROPE, E10 = E9 + N_FF, E11 = E10 + N_SM;
  for (int itp = blockIdx.x; itp < E11 / 2; itp += gridDim.x) {
    const int it = itp * 2 + half_id();
    if (it < E0) {
      mod_item(p, it);
    } else if (it < E1) {
      const int t = it - E0, l = t / 1408, r = t % 1408, kt = r / 44, nt = r % 44;
      transpose_tile(p.w_in + (size_t)l * 2048 * 5632, 5632, (bf16_t*)(p.ws + OFF_WINT) + (size_t)l * 5632 * 2048, 2048, kt * 64, nt * 128, 5632);
    } else if (it < E2) {
      const int t = it - E1, l = t >> 9, r = t & 511, kt = r >> 4, nt = r & 15;
      transpose_tile(p.w_out + (size_t)l * 2048 * 2048, 2048, (bf16_t*)(p.ws + OFF_WOUTT) + (size_t)l * 2048 * 2048, 2048, kt * 64, nt * 128, 2048);
    } else if (it < E3) {
      const int t = it - E2, l = t >> 5, r = t & 31, kt = r >> 2, nt = r & 3;
      transpose_tile(p.w_conv_pw + (size_t)l * 512 * 512, 512, (bf16_t*)(p.ws + OFF_WPWT) + (size_t)l * 512 * 512, 512, kt * 64, nt * 128);
    } else if (it < E4) {
      const int t = it - E3, lp = t >> 5;
      const int e0 = (t & 31) * 2048 + tid * 8, n = e0 >> 8, k0 = e0 & 255;
      const int g = (lp & 1) * 2 + (n >> 7);
      u32x4 o = (u32x4){0u, 0u, 0u, 0u};
      if ((k0 >> 7) == (n >> 7)) {
        const float* w = p.w_pool + ((size_t)((lp >> 1) * 4 + g) * 128 + (k0 & 127)) * 128 + (n & 127);
#pragma unroll
        for (int e = 0; e < 4; ++e) o[e] = pack_bf16(w[(size_t)(2 * e) * 128], w[(size_t)(2 * e + 1) * 128]);
      }
      *(u32x4*)((bf16_t*)(p.ws + OFF_WPOOLT) + (size_t)lp * 65536 + e0) = o;
    } else if (it < E5) {
      const int t = it - E4, blh = t >> 2, kt = t & 3;
      transpose_tile(p.cache_v + (size_t)blh * 256 * 128, 128, (bf16_t*)(p.ws + OFF_VTC) + (size_t)blh * 128 * 256, 256, kt * 64, 0);
    } else if (it < E6) {
      const size_t e = (size_t)(it - E5) * 2048 + tid * 8;
      const f32x4 a = *(const f32x4*)(p.cache_k + e), b = *(const f32x4*)(p.cache_k + e + 4);
      u32x4 o; o[0] = pack_bf16(a[0], a[1]); o[1] = pack_bf16(a[2], a[3]); o[2] = pack_bf16(b[0], b[1]); o[3] = pack_bf16(b[2], b[3]);
      *(u32x4*)((bf16_t*)(p.ws + OFF_KC) + e) = o;
    } else if (it < E8) {
      const bool dec = it >= E7;
      const int e0 = (dec ? it - E7 : it - E6) * 2048 + tid * 8;
      const int S = dec ? 1024 : 256, sh = dec ? 11 : 9;
      const float nrm = dec ? 0.03125f : 0.0625f, invS = dec ? (1.f / 1024.f) : (1.f / 256.f);
      float v[8];
#pragma unroll
      for (int i = 0; i < 8; ++i) {
        const int e = e0 + i, t = e & (2 * S - 1);
        const int s = e >> sh;
        const int tt = t & (S - 1);
        const float rev = (float)((s * tt) & (S - 1)) * invS;
        v[i] = (t < S) ? __builtin_amdgcn_cosf(rev) * nrm : -__builtin_amdgcn_sinf(rev) * nrm;
      }
      u32x4 o; o[0] = pack_bf16(v[0], v[1]); o[1] = pack_bf16(v[2], v[3]); o[2] = pack_bf16(v[4], v[5]); o[3] = pack_bf16(v[6], v[7]);
      *(u32x4*)((bf16_t*)(p.ws + (dec ? OFF_DDEC : OFF_DCTX)) + (size_t)(e0 >> sh) * (dec ? LDD : LDC) + (e0 & (2 * S - 1))) = o;
    } else if (it < E9) {
      f32x2* rope = (f32x2*)(p.ws + OFF_ROPE);
#pragma unroll
      for (int i = 0; i < 4; ++i) {
        const int idx = tid + i * 256, pos = idx >> 4, f = idx & 15;
        const float inv = exp2f(-(float)f * (13.287712379549449f / 16.f));
        const float ang = (float)pos * inv;
        float rev = ang * 0.15915494309189535f;
        rev -= floorf(rev);
        f32x2 cs; cs.x = __builtin_amdgcn_cosf(rev); cs.y = __builtin_amdgcn_sinf(rev);
        rope[idx] = cs;
      }
    } else if (it < E10) {
      fourier_fold_item(p, it - E9);
    } else {
      const int j = it - E10;
      const float* src; int n, off;
      if (j >= 4 && j < 20) { src = p.conv_dw + (j - 4) * 1984; n = 1984; off = SM_DW + (j - 4) * 1984; }
      else switch (j) {
        case 0: src = p.norm_g; n = 4096; off = SM_NORMG; break;
        case 1: src = p.pool_scale; n = 1024; off = SM_POOLSC; break;
        case 2: src = p.diff_lambda; n = 512; off = SM_DLAM; break;
        case 3: src = p.subln_g; n = 256; off = SM_SUBLN; break;
        case 20: src = p.conv_dw_b; n = 1024; off = SM_DWB; break;
        case 21: src = p.conv_ln_g; n = 1024; off = SM_LNG; break;
        case 22: src = p.conv_ln_b; n = 1024; off = SM_LNB; break;
        default: src = p.final_g; n = 2048; off = SM_FINALG; break;
      }
      float* dst = (float*)(p.ws + OFF_SMALL) + off;
#pragma unroll
      for (int i = 0; i < 4; ++i) { const int e = (tid + i * 256) * 4; if (e < n) *(f32x4*)(dst + e) = *(const f32x4*)(src + e); }
    }
  }
}

DI const float* x_row_l0(const Params& p, int m) { return (m < NCTX) ? p.x_prompt + (size_t)m * DM : p.x_sample + (size_t)(m - NCTX) * DM; }
DI int cvec_of_row(int m) { return (m < NCTX) ? 0 : 1 + ((m - NCTX) >> 10); }

DI void norm_phase(const Params& p, int l) {
  const int tid_ = opaque_tid(); const int lane = tid_ & 63, wid = tid_ >> 6;
  const int rr = lane >> 5, q = lane & 31;
  bf16_t* H = (bf16_t*)(p.ws + OFF_H);
  const float* modv = (const float*)(p.ws + OFF_MODV);
  const float* g = SMALLP(p, SM_NORMG) + l * DM;
  for (int mp = blockIdx.x * 8 + wid; mp < NTOK / 2; mp += gridDim.x * 8) {
    const int m = mp * 2 + rr;
    const float* x = (l == 0) ? x_row_l0(p, m) : p.out + (size_t)m * DM;
    const float* mv = modv + (size_t)(l * 9 + cvec_of_row(m)) * 6144;
    f32x4 v[16];
    float ss = 0.f;
#pragma unroll
    for (int i = 0; i < 8; ++i) {
      const int c = i * 256 + q * 8;
      v[2 * i] = *(const f32x4*)(x + c); v[2 * i + 1] = *(const f32x4*)(x + c + 4);
#pragma unroll
      for (int e = 0; e < 4; ++e) ss += v[2 * i][e] * v[2 * i][e] + v[2 * i + 1][e] * v[2 * i + 1][e];
    }
#pragma unroll
    for (int o = 16; o >= 1; o >>= 1) ss += __shfl_xor(ss, o);
    const float rstd = rsqrtf(ss * (1.f / 2048.f) + EPS);
#pragma unroll
    for (int i = 0; i < 8; ++i) {
      const int c = i * 256 + q * 8;
      u32x4 o4;
#pragma unroll
      for (int hh = 0; hh < 2; ++hh) {
        const f32x4 gg = *(const f32x4*)(g + c + 4 * hh), sh = *(const f32x4*)(mv + c + 4 * hh), sc = *(const f32x4*)(mv + 2048 + c + 4 * hh);
        f32x4 h;
#pragma unroll
        for (int e = 0; e < 4; ++e) h[e] = v[2 * i + hh][e] * rstd * gg[e] * (1.f + sc[e]) + sh[e];
        o4[2 * hh] = pack_bf16(h[0], h[1]); o4[2 * hh + 1] = pack_bf16(h[2], h[3]);
      }
      *(u32x4*)(H + slab_idx(m, c, NTOK)) = o4;
    }
  }
}

DI void final_phase(const Params& p) {
  const int tid_ = opaque_tid(); const int lane = tid_ & 63, wid = tid_ >> 6;
  for (int m = blockIdx.x * 8 + wid; m < NTOK; m += gridDim.x * 8) {
    float* x = p.out + (size_t)m * DM;
    f32x4 v[8];
    float ss = 0.f;
#pragma unroll
    for (int i = 0; i < 8; ++i) { v[i] = *(const f32x4*)(x + (i * 64 + lane) * 4); ss += v[i][0] * v[i][0] + v[i][1] * v[i][1] + v[i][2] * v[i][2] + v[i][3] * v[i][3]; }
    ss = wave_sum(ss);
    const float rstd = rsqrtf(ss * (1.f / 2048.f) + EPS);
#pragma unroll
    for (int i = 0; i < 8; ++i) {
      const int c = (i * 64 + lane) * 4;
      const f32x4 gg = *(const f32x4*)(SMALLP(p, SM_FINALG) + c);
      f32x4 h;
#pragma unroll
      for (int e = 0; e < 4; ++e) h[e] = v[i][e] * rstd * gg[e];
      *(f32x4*)(x + c) = h;
    }
  }
}

DI void g1_tile(const Params& p, int l, int t) {
  const int pm = t & 63, pn = t >> 6;
  const int tid = opaque_tid(), lane = tid & 63, wid = tid >> 6, wr = wid >> 2, wc = wid & 3, fr = lane & 15, fq = lane >> 4;
  const bf16_t* A = (const bf16_t*)(p.ws + OFF_H) + (size_t)pm * 256 * 32;
  const bf16_t* B = (const bf16_t*)(p.ws + OFF_WINT) + (size_t)l * 5632 * 2048 + (size_t)pn * 256 * 32;
  bf16_t* P = (bf16_t*)(p.ws + OFF_P);
  const int m0 = pm * 256, n0 = pn * 256;
  const int nw = n0 + wc * 64;
  const bool dec = m0 >= NCTX;
  f32x4 acc[8][4];
  if (pn == 12 || pn == 13) {
    gemm_main<false, false>(A, 32, (size_t)NTOK * 32, B, 32, (size_t)5632 * 32, DM, acc);
    const int vc = nw - 3072, h = vc >> 7;
    bf16_t* vtn = (bf16_t*)(p.ws + OFF_VTN);
    int S, s0; size_t vbase; int b;
    if (!dec) { b = m0 >> 8; S = 256; s0 = 0; vbase = (size_t)b * 131072; }
    else { const int dm = m0 - NCTX; b = dm >> 10; S = 1024; s0 = dm & 1023; vbase = (size_t)32 * 131072 + (size_t)b * 524288; }
    float* ncv = p.out + 41943040ull + ((size_t)((b * 2 + l) * 4 + h)) * 32768;
#pragma unroll
    for (int mi = 0; mi < 8; ++mi)
#pragma unroll
      for (int ni = 0; ni < 4; ++ni) {
        const int s = s0 + wr * 128 + mi * 16 + 4 * fq, dv = (vc & 127) + ni * 16 + fr;
        *(u32x2*)(vtn + vbase + (size_t)(h * 128 + dv) * S + s) = pack4(acc[mi][ni]);
        if (!dec) {
#pragma unroll
          for (int j = 0; j < 4; ++j) ncv[(size_t)(s + j) * 128 + dv] = acc[mi][ni][j];
        }
      }
  } else {
    const int chunk = pn >> 1;
    if (dec && (chunk == 4 || chunk == 5)) {
      gemm_main<true, false>(A, 32, (size_t)NTOK * 32, B, 32, (size_t)5632 * 32, DM, acc);
      const f32x4* rope = (const f32x4*)(p.ws + OFF_ROPE);
#pragma unroll
      for (int mi = 0; mi < 8; ++mi) {
        const int s = (m0 - NCTX + wr * 128 + mi * 16 + fr) & 1023;
        const int prow = s >> 6, pcol = s & 63;
#pragma unroll
        for (int ax = 0; ax < 2; ++ax) {
          const int pos = ax ? pcol : prow;
          const f32x4 t0 = rope[pos * 8 + fq * 2], t1 = rope[pos * 8 + fq * 2 + 1];
          const float cs[4] = {t0[0], t0[2], t1[0], t1[2]}, sn[4] = {t0[1], t0[3], t1[1], t1[3]};
#pragma unroll
          for (int j = 0; j < 4; ++j) {
            const float x1 = acc[mi][ax * 2][j], x2 = acc[mi][ax * 2 + 1][j];
            acc[mi][ax * 2][j] = x1 * cs[j] - x2 * sn[j];
            acc[mi][ax * 2 + 1][j] = x2 * cs[j] + x1 * sn[j];
          }
        }
      }
      const int pc0 = nw + 4 * fq;
#pragma unroll
      for (int mi = 0; mi < 8; ++mi) {
        const int m = m0 + wr * 128 + mi * 16 + fr;
#pragma unroll
        for (int ni = 0; ni < 4; ++ni) *(u32x2*)(P + (size_t)m * LDP + pc0 + ni * 16) = pack4(acc[mi][ni]);
      }
    } else {
      gemm_main<true, true>(A, 32, (size_t)NTOK * 32, B, 32, (size_t)5632 * 32, DM, acc);
      const int pc0 = (nw < 3072 ? nw : nw - 512) + 8 * fq;
#pragma unroll
      for (int mi = 0; mi < 8; ++mi) {
        const int m = m0 + wr * 128 + mi * 16 + fr;
#pragma unroll
        for (int q = 0; q < 2; ++q) {
          u32x4 o; const u32x2 a = pack4(acc[mi][2 * q]), b = pack4(acc[mi][2 * q + 1]);
          o[0] = a.x; o[1] = a.y; o[2] = b.x; o[3] = b.y;
          *(u32x4*)(P + (size_t)m * LDP + pc0 + q * 32) = o;
        }
      }
      if (!dec && chunk == 5) {
        const int kc = nw - 2560, h = kc >> 7;
        const int b = m0 >> 8;
        float* nck = p.out + 33554432ull + ((size_t)((b * 2 + l) * 4 + h)) * 32768;
#pragma unroll
        for (int mi = 0; mi < 8; ++mi) {
          const int s = wr * 128 + mi * 16 + fr;
#pragma unroll
          for (int q = 0; q < 2; ++q) {
            float* dst = nck + (size_t)s * 128 + (kc & 127) + q * 32 + 8 * fq;
            *(f32x4*)dst = acc[mi][2 * q]; *(f32x4*)(dst + 4) = acc[mi][2 * q + 1];
          }
        }
      }
    }
  }
}

DI void g1_half_tile(const Params& p, int l, int ht) {
  const int t = 1280 + (ht >> 1), pm = t & 63, pn = t >> 6;
  const int tid = opaque_tid(), lane = tid & 63, wid = tid >> 6, wr = wid >> 2, wc = wid & 3, fr = lane & 15, fq = lane >> 4;
  const int m0 = pm * 256 + (ht & 1) * 128, nw = pn * 256 + wc * 64;
  const bf16_t* A = (const bf16_t*)(p.ws + OFF_H) + (size_t)m0 * 32;
  const bf16_t* B = (const bf16_t*)(p.ws + OFF_WINT) + (size_t)l * 5632 * 2048 + (size_t)pn * 256 * 32;
  bf16_t* P = (bf16_t*)(p.ws + OFF_P);
  f32x4 acc[4][4];
  gemm_main<true, true, 4>(A, 32, (size_t)NTOK * 32, B, 32, (size_t)5632 * 32, DM, acc);
  const int pc0 = (nw - 512) + 8 * fq;
#pragma unroll
  for (int mi = 0; mi < 4; ++mi) {
    const int m = m0 + wr * 64 + mi * 16 + fr;
#pragma unroll
    for (int q = 0; q < 2; ++q) {
      u32x4 o; const u32x2 a = pack4(acc[mi][2 * q]), b = pack4(acc[mi][2 * q + 1]);
      o[0] = a.x; o[1] = a.y; o[2] = b.x; o[3] = b.y;
      *(u32x4*)(P + (size_t)m * LDP + pc0 + q * 32) = o;
    }
  }
}

template <int MI = 8>
DI void gated_gemm_tile(const Params& p, const bf16_t* A, int lda, const bf16_t* B, int ldb, int K, int tok0, int ncol0, int gcol, int ycol, const float* colscale) {
  const int tid = opaque_tid(), lane = tid & 63, wid = tid >> 6, wr = wid >> 2, wc = wid & 3, fr = lane & 15, fq = lane >> 4;
  f32x4 acc[MI][4];
  gemm_main<true, true, MI>(A, lda, 32, B, ldb, 32, K, acc);
  const bf16_t* P = (const bf16_t*)(p.ws + OFF_P);
  bf16_t* Y = (bf16_t*)(p.ws + OFF_H);
#pragma unroll
  for (int q = 0; q < 2; ++q) {
    const int n = ncol0 + wc * 64 + q * 32 + 8 * fq;
    f32x4 cs0 = (f32x4){1.f, 1.f, 1.f, 1.f}, cs1 = cs0;
    if (colscale) { cs0 = *(const f32x4*)(colscale + n); cs1 = *(const f32x4*)(colscale + n + 4); }
#pragma unroll
    for (int mi = 0; mi < MI; ++mi) {
      const int tok = tok0 + wr * (MI * 16) + mi * 16 + fr;
      const u32x4 gw = *(const u32x4*)(P + (size_t)tok * LDP + gcol + n);
      const f32x4 a0 = acc[mi][2 * q], a1 = acc[mi][2 * q + 1];
      u32x4 o;
      o[0] = pack_bf16(a0[0] * cs0[0] * silu_f(bflo(gw[0])), a0[1] * cs0[1] * silu_f(bfhi(gw[0])));
      o[1] = pack_bf16(a0[2] * cs0[2] * silu_f(bflo(gw[1])), a0[3] * cs0[3] * silu_f(bfhi(gw[1])));
      o[2] = pack_bf16(a1[0] * cs1[0] * silu_f(bflo(gw[2])), a1[1] * cs1[1] * silu_f(bfhi(gw[2])));
      o[3] = pack_bf16(a1[2] * cs1[2] * silu_f(bflo(gw[3])), a1[3] * cs1[3] * silu_f(bfhi(gw[3])));
      *(u32x4*)(Y + slab_idx(tok, ycol + n, NTOK)) = o;
    }
  }
}

DI void z_tile(const Params& p, int l, int t) {
  const int pm = t & 63, pn = t >> 6;
  const int tid = opaque_tid(), lane = tid & 63, wid = tid >> 6, wr = wid >> 2, wc = wid & 3, fr = lane & 15, fq = lane >> 4;
  const bf16_t* A = (const bf16_t*)(p.ws + OFF_P) + (size_t)pm * 256 * LDP + PC_FX;
  const bf16_t* B = (const bf16_t*)(p.ws + OFF_WCST) + ((size_t)l * 1024 + pn * 256) * 512;
  f32x4 acc[8][4];
  gemm_main<false, false>(A, LDP, 32, B, 512, 32, 512, acc);
  bf16_t* ZT = (bf16_t*)(p.ws + OFF_ZT);
  const int m0 = pm * 256;
  int S, t0; size_t base;
  if (m0 < NCTX) { S = 256; t0 = 0; base = (size_t)(m0 >> 8) * 262144; }
  else { const int dm = m0 - NCTX; S = 1024; t0 = dm & 1023; base = 32ull * 262144 + (size_t)(dm >> 10) * 512 * LDZ; }
#pragma unroll
  for (int ni = 0; ni < 4; ++ni) {
    const int np = pn * 256 + wc * 64 + ni * 16 + fr, n = np & 511, half = np >> 9;
    bf16_t* row = ZT + base + (size_t)n * (S == 256 ? 512 : LDZ) + half * S + t0;
#pragma unroll
    for (int mi = 0; mi < 8; ++mi) *(u32x2*)(row + wr * 128 + mi * 16 + 4 * fq) = pack4(acc[mi][ni]);
  }
}

DI void out_tile(const Params& p, int l, int t) {
  const int pm = t & 63, pn = t >> 6;
  const int tid = opaque_tid(), lane = tid & 63, wid = tid >> 6, wr = wid >> 2, wc = wid & 3, fr = lane & 15, fq = lane >> 4;
  const bf16_t* A = (const bf16_t*)(p.ws + OFF_H) + (size_t)pm * 256 * 32;
  const bf16_t* B = (const bf16_t*)(p.ws + OFF_WOUTT) + (size_t)l * 2048 * 2048 + (size_t)pn * 256 * 32;
  f32x4 acc[8][4];
  gemm_main<true, true>(A, 32, (size_t)NTOK * 32, B, 32, (size_t)2048 * 32, DM, acc);
  const int m0 = pm * 256;
  const float* gate = (const float*)(p.ws + OFF_MODV) + (size_t)(l * 9 + cvec_of_row(m0)) * 6144 + 4096;
#pragma unroll
  for (int q = 0; q < 2; ++q) {
    const int n = pn * 256 + wc * 64 + q * 32 + 8 * fq;
    const f32x4 g0 = *(const f32x4*)(gate + n), g1 = *(const f32x4*)(gate + n + 4);
#pragma unroll
    for (int mi = 0; mi < 8; ++mi) {
      const int m = m0 + wr * 128 + mi * 16 + fr;
      const float* xin = ((l == 0) ? x_row_l0(p, m) : p.out + (size_t)m * DM) + n;
      const f32x4 x0 = *(const f32x4*)(xin), x1 = *(const f32x4*)(xin + 4);
      float* dst = p.out + (size_t)m * DM + n;
      *(f32x4*)dst = x0 + g0 * acc[mi][2 * q];
      *(f32x4*)(dst + 4) = x1 + g1 * acc[mi][2 * q + 1];
    }
  }
}

DI void seq_of_tok(int tok0, int& S, int& sbase) {
  if (tok0 < NCTX) { S = 256; sbase = tok0 & ~255; } else { S = 1024; sbase = NCTX + ((tok0 - NCTX) & ~1023); }
}

template <int W>
DI void pool_task(const bf16_t* base, int S, int sA, bf16_t* outp) {
  constexpr int HW = W / 2, NR = 7 + W;
  u32x4 rows[NR];
#pragma unroll
  for (int r = 0; r < NR; ++r) {
    const int s = sA - HW + r;
    const bool ok = (s >= 0) && (s < S);
    const u32x4 v = *(const u32x4*)(base + (size_t)min(max(s, 0), S - 1) * LDP);
#pragma unroll
    for (int e = 0; e < 4; ++e) rows[r][e] = ok ? v[e] : 0u;
  }
  float sum[8];
#pragma unroll
  for (int e = 0; e < 8; ++e) sum[e] = 0.f;
#pragma unroll
  for (int r = 0; r < W; ++r)
#pragma unroll
    for (int e = 0; e < 4; ++e) { sum[2 * e] += bflo(rows[r][e]); sum[2 * e + 1] += bfhi(rows[r][e]); }
#pragma unroll
  for (int k = 0; k < 8; ++k) {
    const int s = sA + k;
    const int lo = max(s - HW, 0), hi = min(s - HW + W, S);
    const float inv = 1.f / (float)(hi - lo);
    const u32x4 xv = rows[k + HW];
    u32x4 o4;
#pragma unroll
    for (int e = 0; e < 4; ++e) o4[e] = pack_bf16(sum[2 * e] * inv - bflo(xv[e]), sum[2 * e + 1] * inv - bfhi(xv[e]));
    *(u32x4*)(outp + (size_t)k * 512) = o4;
    if (k < 7) {
#pragma unroll
      for (int e = 0; e < 4; ++e) {
        sum[2 * e] += bflo(rows[k + W][e]) - bflo(rows[k][e]);
        sum[2 * e + 1] += bfhi(rows[k + W][e]) - bfhi(rows[k][e]);
      }
    }
  }
}

DI void pool_item(const Params& p, int t) {
  const int tid = half_tid(), tok0 = t * 32;
  int S, sbase; seq_of_tok(tok0, S, sbase);
  const int g = tid >> 6, run = (tid >> 4) & 3, c0 = g * 128 + (tid & 15) * 8;
  const int sA = tok0 - sbase + run * 8;
  const bf16_t* base = (const bf16_t*)(p.ws + OFF_P) + (size_t)sbase * LDP + PC_PX + c0;
  bf16_t* outp = (bf16_t*)(p.ws + OFF_POOLED) + (size_t)(sbase + sA) * 512 + c0;
  if (g == 0) pool_task<2>(base, S, sA, outp);
  else if (g == 1) pool_task<4>(base, S, sA, outp);
  else if (g == 2) pool_task<8>(base, S, sA, outp);
  else pool_task<16>(base, S, sA, outp);
}

DI void conv_item(const Params& p, int l, int t) {
  const int tid = half_tid(), lane = tid & 63, wid = tid >> 6, tok0 = t * 32;
  int S, sbase; seq_of_tok(tok0, S, sbase);
  const int s0 = tok0 - sbase;
  const bf16_t* P = (const bf16_t*)(p.ws + OFF_P);
  bf16_t* U = (bf16_t*)HSM;
  float* red = (float*)(HSM + 63488);
#pragma unroll 4
  for (int idx = tid; idx < 62 * 64; idx += 256) {
    const int rr = idx >> 6, ch = (idx & 63) * 8, s = s0 - 15 + rr;
    const bool ok = (s >= 0) && (s < S);
    const int sc = min(max(s, 0), S - 1);
    const bf16_t* row = P + (size_t)(sbase + sc) * LDP;
    const u32x4 a = *(const u32x4*)(row + PC_CA + ch), b = *(const u32x4*)(row + PC_CB + ch);
    u32x4 o;
#pragma unroll
    for (int e = 0; e < 4; ++e) { const unsigned v = pack_bf16(bflo(a[e]) * sigmoid_f(bflo(b[e])), bfhi(a[e]) * sigmoid_f(bfhi(b[e]))); o[e] = ok ? v : 0u; }
    *(u32x4*)(U + rr * 512 + ch) = o;
  }
  __syncthreads();
  const int c2 = tid * 2;
  float y0[32], y1[32];
  {
    const f32x2 bb = *(const f32x2*)(SMALLP(p, SM_DWB) + l * 512 + c2);
#pragma unroll
    for (int i = 0; i < 32; ++i) { y0[i] = bb.x; y1[i] = bb.y; }
  }
  const float* dw = SMALLP(p, SM_DW) + (size_t)l * 31 * 512 + c2;
  f32x2 wn = *(const f32x2*)dw;
#pragma unroll 1
  for (int j = 0; j < 31; ++j) {
    const f32x2 w = wn;
    if (j + 1 < 31) wn = *(const f32x2*)(dw + (j + 1) * 512);
    const unsigned wpk = pack_bf16(w.x, w.y), wlo = wpk & 0xffffu, whi = wpk & 0xffff0000u;
    const bf16_t* up = U + j * 512 + c2;
#pragma unroll
    for (int i = 0; i < 32; ++i) {
      const unsigned u = *(const unsigned*)(up + i * 512);
      y0[i] = dot2bf(u, wlo, y0[i]); y1[i] = dot2bf(u, whi, y1[i]);
    }
  }
#pragma unroll
  for (int i = 0; i < 32; ++i) {
    const float s1 = wave_sum_dpp(y0[i] + y1[i]);
    const float s2 = wave_sum_dpp(y0[i] * y0[i] + y1[i] * y1[i]);
    if (lane == 0) { red[(wid * 32 + i) * 2] = s1; red[(wid * 32 + i) * 2 + 1] = s2; }
  }
  __syncthreads();
  const f32x2 lg = *(const f32x2*)(SMALLP(p, SM_LNG) + l * 512 + c2), lb = *(const f32x2*)(SMALLP(p, SM_LNB) + l * 512 + c2);
  bf16_t* out = (bf16_t*)(p.ws + OFF_CONVACT);
#pragma unroll
  for (int i = 0; i < 32; ++i) {
    float s1 = 0.f, s2 = 0.f;
#pragma unroll
    for (int w = 0; w < 4; ++w) { s1 += red[(w * 32 + i) * 2]; s2 += red[(w * 32 + i) * 2 + 1]; }
    const float mean = s1 * (1.f / 512.f), var = s2 * (1.f / 512.f) - mean * mean, rstd = rsqrtf(var + EPS);
    const float a0 = silu_f((y0[i] - mean) * rstd * lg.x + lb.x), a1 = silu_f((y1[i] - mean) * rstd * lg.y + lb.y);
    *(unsigned*)(out + (size_t)(tok0 + i) * 512 + c2) = pack_bf16(a0, a1);
  }
}

DI void attn_item(const Params& p, int l, bool dec, int b, int h, int qt) {
  const int tid = half_tid(), lane = tid & 63, wid = tid >> 6, fr = lane & 15, fq = lane >> 4;
  const int S = dec ? 1024 : 256;
  const int tok0 = dec ? NCTX + b * 1024 : b * 256;
  const int nkt = dec ? 20 : 4, ncache = dec ? 4 : 0;
  const bf16_t* P = (const bf16_t*)(p.ws + OFF_P);
  const float lam_init = (l == 0) ? 0.2f : 0.35550906f;
  float lam;
  {
    const float* dl = SMALLP(p, SM_DLAM) + l * 256;
    const float a = wave_sum(dl[lane] * dl[64 + lane]), c = wave_sum(dl[128 + lane] * dl[192 + lane]);
    lam = __expf(a) - __expf(c) + lam_init;
  }
  const int q0 = qt * 64 + wid * 16;
  bf16x8 qf[2][2];
  {
    const bf16_t* qrow = P + (size_t)(tok0 + q0 + fr) * LDP + PC_Q + h * 128;
#pragma unroll
    for (int m = 0; m < 2; ++m)
#pragma unroll
      for (int ks = 0; ks < 2; ++ks) qf[m][ks] = *(const bf16x8*)(qrow + m * 64 + ks * 32 + fq * 8);
  }
  const size_t blh = (size_t)((b * 2 + l) * 4 + h);
  const bf16_t* kc = (const bf16_t*)(p.ws + OFF_KC) + blh * 32768;
  const bf16_t* vtc = (const bf16_t*)(p.ws + OFF_VTC) + blh * 32768;
  const bf16_t* kn = P + (size_t)tok0 * LDP + PC_K + h * 128;
  const bf16_t* vtn = (const bf16_t*)(p.ws + OFF_VTN) + (dec ? (size_t)32 * 131072 + (size_t)b * 524288 : (size_t)b * 131072) + (size_t)h * 128 * S;
  char* Ks = HSM;
  char* Vs = HSM + 17408;
  u32x4 rk[4], rv[4];
  auto load_tile = [&](int kt) {
    if (kt < ncache) {
#pragma unroll
      for (int i = 0; i < 4; ++i) {
        const int idx = tid + i * 256;
        rk[i] = *(const u32x4*)(kc + (size_t)(kt * 64 + (idx >> 4)) * 128 + (idx & 15) * 8);
        rv[i] = *(const u32x4*)(vtc + (size_t)(idx >> 3) * 256 + kt * 64 + (idx & 7) * 8);
      }
    } else {
      const int kk = (kt - ncache) * 64;
#pragma unroll
      for (int i = 0; i < 4; ++i) {
        const int idx = tid + i * 256;
        rk[i] = *(const u32x4*)(kn + (size_t)(kk + (idx >> 4)) * LDP + (idx & 15) * 8);
        rv[i] = *(const u32x4*)(vtn + (size_t)(idx >> 3) * S + kk + (idx & 7) * 8);
      }
    }
  };
  float m_run[2] = {-INFINITY, -INFINITY}, l_run[2] = {0.f, 0.f};
  f32x4 O[2][8];
#pragma unroll
  for (int m = 0; m < 2; ++m)
#pragma unroll
    for (int d = 0; d < 8; ++d) O[m][d] = (f32x4){0.f, 0.f, 0.f, 0.f};
  const float cexp = 0.125f * 1.4426950408889634f;
  load_tile(0);
#pragma unroll 1
  for (int kt = 0; kt < nkt; ++kt) {
    __syncthreads();
#pragma unroll
    for (int i = 0; i < 4; ++i) {
      const int idx = tid + i * 256;
      *(u32x4*)(Ks + (idx >> 4) * 272 + (idx & 15) * 16) = rk[i];
      *(u32x4*)(Vs + (idx >> 3) * 144 + (idx & 7) * 16) = rv[i];
    }
    __syncthreads();
    if (kt + 1 < nkt) load_tile(kt + 1);
    bf16x8 pf[2][2];
#pragma unroll
    for (int m = 0; m < 2; ++m) {
      f32x4 s[4];
#pragma unroll
      for (int ksub = 0; ksub < 4; ++ksub) {
        f32x4 a = (f32x4){0.f, 0.f, 0.f, 0.f};
#pragma unroll
        for (int ks = 0; ks < 2; ++ks) {
          const bf16x8 kf = *(const bf16x8*)(Ks + (ksub * 16 + fr) * 272 + m * 128 + ks * 64 + fq * 16);
          a = MFMA16(kf, qf[m][ks], a);
        }
        s[ksub] = a;
      }
      float mx = s[0][0];
#pragma unroll
      for (int ksub = 0; ksub < 4; ++ksub)
#pragma unroll
        for (int j = 0; j < 4; ++j) mx = fmaxf(mx, s[ksub][j]);
      mx = xrow_max(mx);
      const float mn = fmaxf(m_run[m], mx);
      const float alpha = __builtin_amdgcn_exp2f((m_run[m] - mn) * cexp);
      m_run[m] = mn;
      float ls = 0.f;
#pragma unroll
      for (int ksub = 0; ksub < 4; ++ksub)
#pragma unroll
        for (int j = 0; j < 4; ++j) { const float e = __builtin_amdgcn_exp2f((s[ksub][j] - mn) * cexp); s[ksub][j] = e; ls += e; }
      l_run[m] = l_run[m] * alpha + ls;
      if (__any(alpha != 1.f)) {
#pragma unroll
        for (int d = 0; d < 8; ++d) O[m][d] *= alpha;
      }
#pragma unroll
      for (int k2 = 0; k2 < 2; ++k2) {
        u32x4 w;
        w[0] = pack_bf16(s[2 * k2][0], s[2 * k2][1]); w[1] = pack_bf16(s[2 * k2][2], s[2 * k2][3]);
        w[2] = pack_bf16(s[2 * k2 + 1][0], s[2 * k2 + 1][1]); w[3] = pack_bf16(s[2 * k2 + 1][2], s[2 * k2 + 1][3]);
        pf[m][k2] = __builtin_bit_cast(bf16x8, w);
      }
      asm volatile("" ::: "memory");
    }
#pragma unroll
    for (int k2 = 0; k2 < 2; ++k2) {
      asm volatile("" ::: "memory");
#pragma unroll
      for (int d = 0; d < 8; ++d) {
        const char* vp = Vs + (d * 16 + fr) * 144 + (k2 * 32 + 4 * fq) * 2;
        const s16x4 lo = *(const s16x4*)vp, hi = *(const s16x4*)(vp + 32);
        const bf16x8 vf = __builtin_shufflevector(lo, hi, 0, 1, 2, 3, 4, 5, 6, 7);
        O[0][d] = MFMA16(vf, pf[0][k2], O[0][d]);
        O[1][d] = MFMA16(vf, pf[1][k2], O[1][d]);
      }
    }
  }
#pragma unroll
  for (int m = 0; m < 2; ++m) l_run[m] = xrow_sum(l_run[m]);
  const float inv1 = 1.f / l_run[0], inv2 = lam / l_run[1];
  float ss = 0.f;
#pragma unroll
  for (int d = 0; d < 8; ++d)
#pragma unroll
    for (int j = 0; j < 4; ++j) { const float o = O[0][d][j] * inv1 - O[1][d][j] * inv2; O[0][d][j] = o; ss += o * o; }
  ss = xrow_sum(ss);
  const float rstd = rsqrtf(ss * (1.f / 128.f) + EPS) * (1.f - lam_init);
  const int tok = tok0 + q0 + fr;
  bf16_t* Y = (bf16_t*)(p.ws + OFF_H);
#pragma unroll
  for (int d = 0; d < 8; ++d) {
    const int dv = d * 16 + 4 * fq;
    const f32x4 g4 = *(const f32x4*)(SMALLP(p, SM_SUBLN) + l * 128 + dv);
    const u32x2 gw = *(const u32x2*)(P + (size_t)tok * LDP + PC_AG + h * 128 + dv);
    f32x4 o;
    o[0] = O[0][d][0] * rstd * g4[0] * silu_f(bflo(gw.x));
    o[1] = O[0][d][1] * rstd * g4[1] * silu_f(bfhi(gw.x));
    o[2] = O[0][d][2] * rstd * g4[2] * silu_f(bflo(gw.y));
    o[3] = O[0][d][3] * rstd * g4[3] * silu_f(bfhi(gw.y));
    *(u32x2*)(Y + slab_idx(tok, 1024 + h * 128 + dv, NTOK)) = pack4(o);
  }
}

__global__ void __launch_bounds__(512, 2) fwd_megakernel(Params p) {
  cg::grid_group grid = cg::this_grid();
  unsigned* sync = (unsigned*)(p.ws + OFF_SYNC);
  unsigned* queues = (unsigned*)(p.ws + OFF_QUEUE);
  if (threadIdx.x == 0) { g_sh[1] = 0u; g_sh[2] = 0u; }
  __syncthreads();
  if (threadIdx.x == 0) (void)xb_add(&sync[XB_XCNT(xb_xcc_id())], 1u);
  if (p.never) grid.sync();
  phase0(p);
  grid_barrier(sync, 0);
  mod_reduce(p);
  grid_barrier(sync, 0);
  for (int l = 0; l < 2; ++l) {
    norm_phase(p, l);
    grid_barrier(sync, 0);
    for (int t = blockIdx.x; t < 1280; t += gridDim.x) g1_tile(p, l, t);
    for (int ht = blockIdx.x; ht < 256; ht += gridDim.x) g1_half_tile(p, l, ht);
    grid_barrier(sync, 0);
    {
      unsigned* q = queues + 64 * (l * 2);
      for (;;) {
        const int it = queue_next(q);
        if (it >= 1280) break;
        const int hf = half_id();
        if (it < 256) { const int a = it * 2 + hf; attn_item(p, l, true, a >> 6, (a >> 4) & 3, a & 15); }
        else if (it < 512) z_tile(p, l, it - 256);
        else if (it < 768) conv_item(p, l, (it - 512) * 2 + hf);
        else if (it < 1024) { const int a = (it - 768) * 2 + hf; attn_item(p, l, false, a >> 4, (a >> 2) & 3, a & 3); }
        else pool_item(p, (it - 1024) * 2 + hf);
      }
    }
    grid_barrier(sync, 0);
    {
      unsigned* q = queues + 64 * (1 + l * 2);
      for (;;) {
        const int it = queue_next(q);
        if (it >= 448) break;
        if (it < 128) {
          const int seq = it >> 4, mh = (it >> 1) & 7, nt = it & 1;
          gated_gemm_tile<4>(p, (const bf16_t*)(p.ws + OFF_DDEC) + (size_t)mh * 128 * LDD, LDD,
                             (const bf16_t*)(p.ws + OFF_ZT) + 32ull * 262144 + (size_t)seq * 512 * LDZ + (size_t)nt * 256 * LDZ, LDZ, 2048,
                             NCTX + seq * 1024 + mh * 128, nt * 256, PC_FG, 0, nullptr);
        } else if (it < 256) {
          const int t = it - 128, pm = t & 63, pn = t >> 6;
          gated_gemm_tile(p, (const bf16_t*)(p.ws + OFF_CONVACT) + (size_t)pm * 256 * 512, 512,
                          (const bf16_t*)(p.ws + OFF_WPWT) + ((size_t)l * 512 + pn * 256) * 512, 512, 512, pm * 256, pn * 256, PC_CG, 1536, nullptr);
        } else if (it < 320) {
          const int t = it - 256, seq = t >> 1, nt = t & 1;
          gated_gemm_tile(p, (const bf16_t*)(p.ws + OFF_DCTX), LDC, (const bf16_t*)(p.ws + OFF_ZT) + (size_t)seq * 262144 + (size_t)nt * 256 * 512, 512, 512,
                          seq * 256, nt * 256, PC_FG, 0, nullptr);
        } else {
          const int t = it - 320, pm = t & 63, pr = t >> 6;
          gated_gemm_tile(p, (const bf16_t*)(p.ws + OFF_POOLED) + (size_t)pm * 256 * 512 + pr * 256, 512,
                          (const bf16_t*)(p.ws + OFF_WPOOLT) + (size_t)(l * 2 + pr) * 65536, 256, 256, pm * 256, pr * 256, PC_PG, 512, SMALLP(p, SM_POOLSC) + l * 512);
        }
      }
    }
    grid_barrier(sync, 0);
    for (int t = blockIdx.x; t < 64 * 8; t += gridDim.x) out_tile(p, l, t);
    grid_barrier(sync, 0);
  }
  final_phase(p);
}

extern "C" void kernel_launch(void* const* d_in, const int* in_sizes, int n_in, void* d_out, int out_size, void* d_ws, size_t ws_size,
                              hipStream_t stream) {
  static int grid_blocks = 0;
  if (!grid_blocks) {
    int dev = 0, cus = 0, per_cu = 0;
    (void)hipGetDevice(&dev);
    (void)hipDeviceGetAttribute(&cus, hipDeviceAttributeMultiprocessorCount, dev);
    (void)hipFuncSetAttribute((const void*)fwd_megakernel, hipFuncAttributeMaxDynamicSharedMemorySize, (int)kDynLds);
    (void)hipOccupancyMaxActiveBlocksPerMultiprocessor(&per_cu, fwd_megakernel, 512, kDynLds);
    if (per_cu > 1) per_cu = 1;
    if (per_cu < 1) per_cu = 1;
    grid_blocks = cus * per_cu;
  }
  Params p{};
  const float** pp = (const float**)&p;
  for (int i = 0; i < 22; ++i) pp[i] = (const float*)d_in[i];
  p.out = (float*)d_out;
  p.ws = (unsigned char*)d_ws;
  (void)hipMemsetAsync(d_ws, 0, ZERO_BYTES, stream);
  void* args[] = {&p};
  hipError_t e = hipLaunchCooperativeKernel((void*)fwd_megakernel, dim3(grid_blocks), dim3(512), args, kDynLds, stream);
  if (e != hipSuccess) fprintf(stderr, "cooperative launch failed: %s (grid %d)\n", hipGetErrorString(e), grid_blocks);
}
```

```cpp
#include <hip/hip_runtime.h>
#include <hip/hip_cooperative_groups.h>
#include <stdint.h>
#include <cstdio>
namespace cg = cooperative_groups;

typedef unsigned short bf16_t;
typedef short bf16x8 __attribute__((ext_vector_type(8)));
typedef short s16x4 __attribute__((ext_vector_type(4)));
typedef float f32x4 __attribute__((ext_vector_type(4)));
typedef float f32x2 __attribute__((ext_vector_type(2)));
typedef unsigned u32x4 __attribute__((ext_vector_type(4)));
typedef unsigned u32x2 __attribute__((ext_vector_type(2)));
#define DI __device__ __forceinline__
#define LDSP __attribute__((address_space(3))) void*
#define MFMA16(a, b, c) __builtin_amdgcn_mfma_f32_16x16x32_bf16((a), (b), (c), 0, 0, 0)

constexpr int DM = 2048, NTOK = 16384, NCTX = 8192;
constexpr int LDP = 5120;
constexpr int PC_FX = 0, PC_FG = 512, PC_PX = 1024, PC_PG = 1536, PC_Q = 2048, PC_K = 2560, PC_AG = 3072, PC_CA = 3584, PC_CB = 4096, PC_CG = 4608;
constexpr float EPS = 1e-6f;
constexpr int LDD = 2112;
constexpr int LDZ = 2112;
constexpr int LDC = 576;

constexpr size_t OFF_SYNC = 0;
constexpr size_t OFF_QUEUE = 16384;
constexpr size_t OFF_MODV = 20480;
constexpr size_t SZ_MODV = 2ull * 9 * 6144 * 4;
constexpr size_t ZERO_BYTES = OFF_MODV + SZ_MODV;
constexpr size_t OFF_ROPE = ZERO_BYTES;
constexpr size_t OFF_P = OFF_ROPE + 8192;
constexpr size_t OFF_H = OFF_P + (size_t)NTOK * LDP * 2;
constexpr size_t OFF_ZT = OFF_H + (size_t)NTOK * DM * 2;
constexpr size_t OFF_VTN = OFF_ZT + (32ull * 262144 + 8ull * 512 * LDZ) * 2;
constexpr size_t OFF_POOLED = OFF_VTN + (size_t)NTOK * 512 * 2;
constexpr size_t OFF_CONVACT = OFF_POOLED + (size_t)NTOK * 512 * 2;
constexpr size_t OFF_WINT = OFF_CONVACT + (size_t)NTOK * 512 * 2;
constexpr size_t OFF_WOUTT = OFF_WINT + 2ull * 5632 * 2048 * 2;
constexpr size_t OFF_WCST = OFF_WOUTT + 2ull * 2048 * 2048 * 2;
constexpr size_t OFF_WPOOLT = OFF_WCST + 2ull * 1024 * 512 * 2;
constexpr size_t OFF_WPWT = OFF_WPOOLT + 2ull * 2 * 256 * 256 * 2;
constexpr size_t OFF_KC = OFF_WPWT + 2ull * 512 * 512 * 2;
constexpr size_t OFF_VTC = OFF_KC + 8ull * 2 * 4 * 256 * 128 * 2;
constexpr size_t OFF_DCTX = OFF_VTC + 8ull * 2 * 4 * 256 * 128 * 2;
constexpr size_t OFF_DDEC = OFF_DCTX + 256ull * LDC * 2;
constexpr size_t OFF_SMALL = OFF_DDEC + 1024ull * LDD * 2;
constexpr int SM_NORMG = 0, SM_POOLSC = 4096, SM_DLAM = 5120, SM_SUBLN = 5632, SM_DW = 5888, SM_DWB = 37632, SM_LNG = 38656, SM_LNB = 39680, SM_FINALG = 40704, SM_TOTAL = 42752;
constexpr size_t WS_TOTAL = OFF_SMALL + (size_t)SM_TOTAL * 4;
static_assert(WS_TOTAL <= 402653184ull, "workspace too large");

struct Params {
  const float *x_prompt, *x_sample, *cache_k, *cache_v, *c, *c_ctx, *norm_g, *w_mod, *b_mod, *w_in, *w_fourier, *w_pool,
      *pool_scale, *diff_lambda, *subln_g, *conv_dw, *conv_dw_b, *conv_ln_g, *conv_ln_b, *w_conv_pw, *w_out, *final_g;
  float* out;
  unsigned char* ws;
  unsigned long long never;
};

extern __shared__ __attribute__((aligned(16))) char g_smem[];
constexpr size_t kDynLds = 131072;
#define HSM (g_smem + (half_id() << 16))
__shared__ unsigned g_sh[4];

#define SMALLP(p, off) ((const float*)((p).ws + OFF_SMALL) + (off))
DI size_t slab_idx(int row, int col, int nrows) { return ((size_t)(col >> 5) * nrows + row) * 32 + (col & 31); }
DI float bf2f(unsigned u16) { return __uint_as_float(u16 << 16); }
DI float bflo(unsigned w) { return __uint_as_float(w << 16); }
DI float bfhi(unsigned w) { return __uint_as_float(w & 0xffff0000u); }
DI unsigned pack_bf16(float lo, float hi) { unsigned r; asm("v_cvt_pk_bf16_f32 %0, %1, %2" : "=v"(r) : "v"(lo), "v"(hi)); return r; }
DI float silu_f(float x) { return x * __builtin_amdgcn_rcpf(1.f + __expf(-x)); }
DI float sigmoid_f(float x) { return __builtin_amdgcn_rcpf(1.f + __expf(-x)); }
DI int opaque_tid() { int t = threadIdx.x; asm volatile("" : "+v"(t)); return t; }
DI int half_tid() { return opaque_tid() & 255; }
DI int half_id() { return opaque_tid() >> 8; }
DI float wave_sum(float v) {
#pragma unroll
  for (int o = 32; o >= 1; o >>= 1) v += __shfl_xor(v, o);
  return v;
}
typedef __bf16 bf2_t __attribute__((ext_vector_type(2)));
DI float dot2bf(unsigned a, unsigned b, float c) { return __builtin_amdgcn_fdot2_f32_bf16(__builtin_bit_cast(bf2_t, a), __builtin_bit_cast(bf2_t, b), c, false); }
DI float xrow_max(float v) {
  u32x2 r = __builtin_amdgcn_permlane16_swap(__float_as_uint(v), __float_as_uint(v), false, false);
  v = fmaxf(__uint_as_float(r[0]), __uint_as_float(r[1]));
  r = __builtin_amdgcn_permlane32_swap(__float_as_uint(v), __float_as_uint(v), false, false);
  return fmaxf(__uint_as_float(r[0]), __uint_as_float(r[1]));
}
DI float xrow_sum(float v) {
  u32x2 r = __builtin_amdgcn_permlane16_swap(__float_as_uint(v), __float_as_uint(v), false, false);
  v = __uint_as_float(r[0]) + __uint_as_float(r[1]);
  r = __builtin_amdgcn_permlane32_swap(__float_as_uint(v), __float_as_uint(v), false, false);
  return __uint_as_float(r[0]) + __uint_as_float(r[1]);
}
DI u32x2 pack4(f32x4 v) { u32x2 r; r.x = pack_bf16(v[0], v[1]); r.y = pack_bf16(v[2], v[3]); return r; }

#define XB_TMO      128
#define XB_XCNT(j)  (256  + 64 * (j))
#define XB_XSUB(j)  (1280 + 64 * (j))
#define XB_XGEN(j)  (2304 + 64 * (j))
#define XB_TOP      3328
#define XB_TOPGEN   3392
#define XB_SPIN_CAP (1u << 20)
DI unsigned xb_ld(unsigned* p) { return __hip_atomic_load(p, __ATOMIC_RELAXED, __HIP_MEMORY_SCOPE_AGENT); }
DI unsigned xb_add(unsigned* p, unsigned v) { return __hip_atomic_fetch_add(p, v, __ATOMIC_RELAXED, __HIP_MEMORY_SCOPE_AGENT); }
DI unsigned xb_xcc_id() { return (unsigned)__builtin_amdgcn_s_getreg((3 << 11) | 20) & 0xFu; }
#define XB_SPIN(cond, bar) do { unsigned _sp = 0; while (cond) { __builtin_amdgcn_s_sleep(1); \
    if ((++_sp & 255u) == 0u) { if (xb_ld(&(bar)[XB_TMO])) break; if (_sp > XB_SPIN_CAP) { atomicAdd(&(bar)[XB_TMO], 1u); break; } } } } while (0)
DI void xcd_barrier_complete(unsigned* bar, unsigned x, unsigned& nloc, unsigned& nx) {
  const unsigned G = gridDim.x;
  unsigned sum, cnt, mine, sp = 0u;
  for (;;) {
    sum = 0u; cnt = 0u; mine = 0u;
#pragma unroll
    for (unsigned j = 0; j < 16; ++j) { const unsigned c = xb_ld(&bar[XB_XCNT(j)]); sum += c; cnt += (c > 0u) ? 1u : 0u; mine = (j == x) ? c : mine; }
    if (sum == G) break;
    __builtin_amdgcn_s_sleep(1);
    if ((++sp & 255u) == 0u) { if (xb_ld(&bar[XB_TMO])) break; if (sp > XB_SPIN_CAP) { atomicAdd(&bar[XB_TMO], 1u); break; } }
  }
  nloc = mine > 0u ? mine : 1u; nx = cnt > 0u ? cnt : 1u;
}
DI void grid_barrier(unsigned* bar, unsigned) {
  asm volatile("s_waitcnt vmcnt(0)" ::: "memory");
  __syncthreads();
  if (threadIdx.x == 0) {
    __builtin_amdgcn_s_waitcnt(0);
    const unsigned x = xb_xcc_id();
    volatile unsigned* st = g_sh;
    unsigned nloc = st[1], nx = st[2];
    if (nloc == 0u) { xcd_barrier_complete(bar, x, nloc, nx); st[1] = nloc; st[2] = nx; }
    const unsigned old = xb_add(&bar[XB_XSUB(x)], 1u);
    const unsigned gen = old / nloc;
    if (old + 1u == (gen + 1u) * nloc) {
      __builtin_amdgcn_fence(__ATOMIC_RELEASE, "agent");
      asm volatile("s_waitcnt vmcnt(0)" ::: "memory");
      const unsigned og = xb_add(&bar[XB_TOP], 1u);
      const unsigned tg = og / nx;
      if (og + 1u == (tg + 1u) * nx) xb_add(&bar[XB_TOPGEN], 1u);
      else XB_SPIN(xb_ld(&bar[XB_TOPGEN]) == tg, bar);
      __builtin_amdgcn_fence(__ATOMIC_ACQUIRE, "agent");
      xb_add(&bar[XB_XGEN(x)], 1u);
      asm volatile("s_waitcnt vmcnt(0)" ::: "memory");
    } else {
      XB_SPIN(xb_ld(&bar[XB_XGEN(x)]) == gen, bar);
      __builtin_amdgcn_fence(__ATOMIC_ACQUIRE, "agent");
      asm volatile("s_waitcnt vmcnt(0)" ::: "memory");
    }
  }
  __syncthreads();
}

DI int queue_next(unsigned* q) {
  __syncthreads();
  if (threadIdx.x == 0) g_sh[0] = __hip_atomic_fetch_add(q, 1u, __ATOMIC_RELAXED, __HIP_MEMORY_SCOPE_AGENT);
  __syncthreads();
  return (int)g_sh[0];
}

template <int CTRL, int ROWMASK> DI float dpp_add(float v) {
  const int t = __builtin_amdgcn_update_dpp(0, __float_as_int(v), CTRL, ROWMASK, 0xf, false);
  return v + __int_as_float(t);
}
DI float wave_sum_dpp(float v) {
  v = dpp_add<0x111, 0xf>(v); v = dpp_add<0x112, 0xf>(v); v = dpp_add<0x114, 0xf>(v); v = dpp_add<0x118, 0xf>(v);
  v = dpp_add<0x142, 0xa>(v); v = dpp_add<0x143, 0xc>(v);
  return __int_as_float(__builtin_amdgcn_readlane(__float_as_int(v), 63));
}

template <bool TRANS, bool PERM, int MI = 8>
DI void gemm_main(const bf16_t* A, int lda, size_t ksA, const bf16_t* B, int ldb, size_t ksB, int K, f32x4 (&acc)[MI][4]) {
  const int tid = opaque_tid(), lane = tid & 63, wid = tid >> 6, wr = wid >> 2, wc = wid & 3, fr = lane & 15, fq = lane >> 4;
  const int lrow = tid >> 2, lch = tid & 3;
  const int lsw = (lch ^ (((lrow >> 3) & 1) << 1)) * 8;
  const bf16_t* ga = A + (size_t)lrow * lda + lsw;
  const int rho = lrow & 31;
  const int lrow_b = PERM ? ((lrow & ~31) | (8 * ((rho & 15) >> 2) + 4 * (rho >> 4) + (rho & 3))) : lrow;
  const bf16_t* gb = B + (size_t)lrow_b * ldb + lsw;
  const size_t sa = (size_t)128 * lda, sb = (size_t)128 * ldb;
#pragma unroll
  for (int mi = 0; mi < MI; ++mi)
#pragma unroll
    for (int ni = 0; ni < 4; ++ni) acc[mi][ni] = (f32x4){0.f, 0.f, 0.f, 0.f};
  char* lbase = g_smem + tid * 16;
#define GLDS_ISSUE(STG)                                                                                              \
  do {                                                                                                               \
    char* l_ = lbase + (STG) * 32768;                                                                                \
    __builtin_amdgcn_global_load_lds((const unsigned*)(ga), (LDSP)(l_), 16, 0, 0);                                   \
    if (MI == 8) __builtin_amdgcn_global_load_lds((const unsigned*)(ga + sa), (LDSP)(l_ + 8192), 16, 0, 0);          \
    __builtin_amdgcn_global_load_lds((const unsigned*)(gb), (LDSP)(l_ + 16384), 16, 0, 0);                           \
    __builtin_amdgcn_global_load_lds((const unsigned*)(gb + sb), (LDSP)(l_ + 24576), 16, 0, 0);                      \
    ga += ksA; gb += ksB;                                                                                            \
  } while (0)
  asm volatile("s_waitcnt vmcnt(0)" ::: "memory");
  __syncthreads();
  const int nk = K >> 5;
  GLDS_ISSUE(0);
  GLDS_ISSUE(1);
  GLDS_ISSUE(2);
  const int rsw = (fq ^ (((fr >> 3) & 1) << 1)) * 16;
  const int aofs = (wr * (MI * 16) + fr) * 64 + rsw;
  const int bofs = 16384 + (wc * 64 + fr) * 64 + rsw;
  if (MI == 8) asm volatile("s_waitcnt vmcnt(8)" ::: "memory"); else asm volatile("s_waitcnt vmcnt(6)" ::: "memory");
  __builtin_amdgcn_s_barrier();
  if (wid >= 4) __builtin_amdgcn_s_barrier();
  int scur = 0, snxt = 3;
  for (int kt = 0; kt < nk; ++kt) {
    const char* st = g_smem + scur * 32768;
    bf16x8 af[MI], bfr[4];
#pragma unroll
    for (int mi = 0; mi < MI; ++mi) af[mi] = *(const bf16x8*)(st + aofs + mi * 1024);
#pragma unroll
    for (int ni = 0; ni < 4; ++ni) bfr[ni] = *(const bf16x8*)(st + bofs + ni * 1024);
    if (kt + 3 < nk) { GLDS_ISSUE(snxt); if (MI == 8) asm volatile("s_waitcnt vmcnt(8) lgkmcnt(0)" ::: "memory"); else asm volatile("s_waitcnt vmcnt(6) lgkmcnt(0)" ::: "memory"); }
    else if (kt + 2 < nk) { if (MI == 8) asm volatile("s_waitcnt vmcnt(4) lgkmcnt(0)" ::: "memory"); else asm volatile("s_waitcnt vmcnt(3) lgkmcnt(0)" ::: "memory"); }
    else asm volatile("s_waitcnt vmcnt(0) lgkmcnt(0)" ::: "memory");
    __builtin_amdgcn_sched_barrier(0);
    __builtin_amdgcn_s_barrier();
    __builtin_amdgcn_sched_barrier(0);
#pragma unroll
    for (int mi = 0; mi < MI; ++mi)
#pragma unroll
      for (int ni = 0; ni < 4; ++ni)
        acc[mi][ni] = TRANS ? MFMA16(bfr[ni], af[mi], acc[mi][ni]) : MFMA16(af[mi], bfr[ni], acc[mi][ni]);
    __builtin_amdgcn_sched_barrier(0);
    __builtin_amdgcn_s_barrier();
    __builtin_amdgcn_sched_barrier(0);
    scur = (scur + 1) & 3;
    snxt = (snxt + 1) & 3;
  }
  if (wid < 4) __builtin_amdgcn_s_barrier();
#undef GLDS_ISSUE
}

DI void transpose_tile(const float* src, int ldn, bf16_t* dst, int ldk, int k0, int n0, int slab_rows = 0) {
  float* t = (float*)HSM;
  const int tid = half_tid();
  __syncthreads();
  f32x4 v[8];
#pragma unroll
  for (int i = 0; i < 8; ++i) {
    const int idx = tid + i * 256, r = idx >> 5, c4 = (idx & 31) * 4;
    v[i] = *(const f32x4*)(src + (size_t)(k0 + r) * ldn + n0 + c4);
  }
#pragma unroll
  for (int i = 0; i < 8; ++i) {
    const int idx = tid + i * 256, r = idx >> 5, c4 = (idx & 31) * 4;
    t[r * 129 + c4 + 0] = v[i][0]; t[r * 129 + c4 + 1] = v[i][1]; t[r * 129 + c4 + 2] = v[i][2]; t[r * 129 + c4 + 3] = v[i][3];
  }
  __syncthreads();
#pragma unroll
  for (int i = 0; i < 4; ++i) {
    const int idx = tid + i * 256, n = idx >> 3, kc = (idx & 7) * 8;
    u32x4 o;
    o[0] = pack_bf16(t[(kc + 0) * 129 + n], t[(kc + 1) * 129 + n]);
    o[1] = pack_bf16(t[(kc + 2) * 129 + n], t[(kc + 3) * 129 + n]);
    o[2] = pack_bf16(t[(kc + 4) * 129 + n], t[(kc + 5) * 129 + n]);
    o[3] = pack_bf16(t[(kc + 6) * 129 + n], t[(kc + 7) * 129 + n]);
    if (slab_rows) *(u32x4*)(dst + slab_idx(n0 + n, k0 + kc, slab_rows)) = o;
    else *(u32x4*)(dst + (size_t)(n0 + n) * ldk + k0 + kc) = o;
  }
}

DI void mod_item(const Params& p, int it) {
  const int tid = half_tid();
  const int l = it / 192, r = it % 192, kc = r / 6, cb = r % 6;
  float* sl = (float*)HSM;
  __syncthreads();
  for (int idx = tid; idx < 576; idx += 256) {
    const int j = idx >> 6, k = idx & 63;
    const float* src = (j == 0) ? p.c_ctx : p.c + (j - 1) * 2048;
    sl[idx] = silu_f(src[kc * 64 + k]);
  }
  __syncthreads();
  const int col = cb * 1024 + tid * 4;
  f32x4 acc[9];
#pragma unroll
  for (int j = 0; j < 9; ++j) acc[j] = (f32x4){0.f, 0.f, 0.f, 0.f};
  const float* w = p.w_mod + ((size_t)l * 2048 + kc * 64) * 6144 + col;
#pragma unroll 4
  for (int k = 0; k < 64; ++k) {
    const f32x4 wv = *(const f32x4*)(w + (size_t)k * 6144);
#pragma unroll
    for (int j = 0; j < 9; ++j) acc[j] += wv * sl[j * 64 + k];
  }
  float* part = p.out + (size_t)(kc * 18 + l * 9) * 6144 + col;
#pragma unroll
  for (int j = 0; j < 9; ++j) *(f32x4*)(part + (size_t)j * 6144) = acc[j];
}

DI void mod_reduce(const Params& p) {
  float* modv = (float*)(p.ws + OFF_MODV);
  for (int e = (blockIdx.x * 512 + opaque_tid()) * 4; e < 18 * 6144; e += gridDim.x * 512 * 4) {
    const int lj = e / 6144, col = e - lj * 6144, l = lj / 9;
    f32x4 a = *(const f32x4*)(p.b_mod + l * 6144 + col);
#pragma unroll 8
    for (int kc = 0; kc < 32; ++kc) a += *(const f32x4*)(p.out + (size_t)kc * 18 * 6144 + e);
    *(f32x4*)(modv + e) = a;
  }
}

DI void fourier_fold_item(const Params& p, int it) {
  const int tid = half_tid();
  const int l = it >> 10, r = it & 1023, k = r >> 1, nb = r & 1;
  const int g = k >> 7, c = k & 127, n = nb * 256 + tid;
  float* tab = (float*)HSM;
  __syncthreads();
  if (tid < 128) { const float rev = (float)tid * (1.f / 128.f); tab[tid] = __builtin_amdgcn_cosf(rev); tab[128 + tid] = __builtin_amdgcn_sinf(rev); }
  __syncthreads();
  const float* w = p.w_fourier + ((size_t)(l * 512 + g * 128)) * 512 + n;
  float ac = 0.f, as = 0.f;
#pragma unroll 16
  for (int j = 0; j < 128; ++j) { const float wv = w[(size_t)j * 512]; const int ti = (c * j) & 127; ac += tab[ti] * wv; as += tab[128 + ti] * wv; }
  bf16_t* dst = (bf16_t*)(p.ws + OFF_WCST);
  dst[((size_t)(l * 1024 + n)) * 512 + k] = (bf16_t)(pack_bf16(ac * 0.08838834764831845f, 0.f) & 0xffffu);
  dst[((size_t)(l * 1024 + 512 + n)) * 512 + k] = (bf16_t)(pack_bf16(as * 0.08838834764831845f, 0.f) & 0xffffu);
}

DI void phase0(const Params& p) {
  const int tid = half_tid();
  constexpr int N_MOD = 384, N_WIN = 2816, N_WOUT = 1024, N_WPW = 64, N_WPOOL = 128, N_CV = 256, N_CK = 1024, N_DCTX = 64, N_DDEC = 1024, N_ROPE = 2, N_FF = 2048, N_SM = 24;
  constexpr int E0 = N_MOD, E1 = E0 + N_WIN, E2 = E1 + N_WOUT, E3 = E2 + N_WPW, E4 = E3 + N_WPOOL, E5 = E4 + N_CV, E6 = E5 + N_CK, E7 = E6 + N_DCTX,
                E8 = E7 + N_DDEC, E9 = E8 + N_ROPE, E10 = E9 + N_FF, E11 = E10 + N_SM;
  for (int itp = blockIdx.x; itp < E11 / 2; itp += gridDim.x) {
    const int it = itp * 2 + half_id();
    if (it < E0) {
      mod_item(p, it);
    } else if (it < E1) {
      const int t = it - E0, l = t / 1408, r = t % 1408, kt = r / 44, nt = r % 44;
      transpose_tile(p.w_in + (size_t)l * 2048 * 5632, 5632, (bf16_t*)(p.ws + OFF_WINT) + (size_t)l * 5632 * 2048, 2048, kt * 64, nt * 128, 5632);
    } else if (it < E2) {
      const int t = it - E1, l = t >> 9, r = t & 511, kt = r >> 4, nt = r & 15;
      transpose_tile(p.w_out + (size_t)l * 2048 * 2048, 2048, (bf16_t*)(p.ws + OFF_WOUTT) + (size_t)l * 2048 * 2048, 2048, kt * 64, nt * 128, 2048);
    } else if (it < E3) {
      const int t = it - E2, l = t >> 5, r = t & 31, kt = r >> 2, nt = r & 3;
      transpose_tile(p.w_conv_pw + (size_t)l * 512 * 512, 512, (bf16_t*)(p.ws + OFF_WPWT) + (size_t)l * 512 * 512, 512, kt * 64, nt * 128);
    } else if (it < E4) {
      const int t = it - E3, lp = t >> 5;
      const int e0 = (t & 31) * 2048 + tid * 8, n = e0 >> 8, k0 = e0 & 255;
      const int g = (lp & 1) * 2 + (n >> 7);
      u32x4 o = (u32x4){0u, 0u, 0u, 0u};
      if ((k0 >> 7) == (n >> 7)) {
        const float* w = p.w_pool + ((size_t)((lp >> 1) * 4 + g) * 128 + (k0 & 127)) * 128 + (n & 127);
#pragma unroll
        for (int e = 0; e < 4; ++e) o[e] = pack_bf16(w[(size_t)(2 * e) * 128], w[(size_t)(2 * e + 1) * 128]);
      }
      *(u32x4*)((bf16_t*)(p.ws + OFF_WPOOLT) + (size_t)lp * 65536 + e0) = o;
    } else if (it < E5) {
      const int t = it - E4, blh = t >> 2, kt = t & 3;
      transpose_tile(p.cache_v + (size_t)blh * 256 * 128, 128, (bf16_t*)(p.ws + OFF_VTC) + (size_t)blh * 128 * 256, 256, kt * 64, 0);
    } else if (it < E6) {
      const size_t e = (size_t)(it - E5) * 2048 + tid * 8;
      const f32x4 a = *(const f32x4*)(p.cache_k + e), b = *(const f32x4*)(p.cache_k + e + 4);
      u32x4 o; o[0] = pack_bf16(a[0], a[1]); o[1] = pack_bf16(a[2], a[3]); o[2] = pack_bf16(b[0], b[1]); o[3] = pack_bf16(b[2], b[3]);
      *(u32x4*)((bf16_t*)(p.ws + OFF_KC) + e) = o;
    } else if (it < E8) {
      const bool dec = it >= E7;
      const int e0 = (dec ? it - E7 : it - E6) * 2048 + tid * 8;
      const int S = dec ? 1024 : 256, sh = dec ? 11 : 9;
      const float nrm = dec ? 0.03125f : 0.0625f, invS = dec ? (1.f / 1024.f) : (1.f / 256.f);
      float v[8];
#pragma unroll
      for (int i = 0; i < 8; ++i) {
        const int e = e0 + i, t = e & (2 * S - 1);
        const int s = e >> sh;
        const int tt = t & (S - 1);
        const float rev = (float)((s * tt) & (S - 1)) * invS;
        v[i] = (t < S) ? __builtin_amdgcn_cosf(rev) * nrm : -__builtin_amdgcn_sinf(rev) * nrm;
      }
      u32x4 o; o[0] = pack_bf16(v[0], v[1]); o[1] = pack_bf16(v[2], v[3]); o[2] = pack_bf16(v[4], v[5]); o[3] = pack_bf16(v[6], v[7]);
      *(u32x4*)((bf16_t*)(p.ws + (dec ? OFF_DDEC : OFF_DCTX)) + (size_t)(e0 >> sh) * (dec ? LDD : LDC) + (e0 & (2 * S - 1))) = o;
    } else if (it < E9) {
      f32x2* rope = (f32x2*)(p.ws + OFF_ROPE);
#pragma unroll
      for (int i = 0; i < 4; ++i) {
        const int idx = tid + i * 256, pos = idx >> 4, f = idx & 15;
        const float inv = exp2f(-(float)f * (13.287712379549449f / 16.f));
        const float ang = (float)pos * inv;
        float rev = ang * 0.15915494309189535f;
        rev -= floorf(rev);
        f32x2 cs; cs.x = __builtin_amdgcn_cosf(rev); cs.y = __builtin_amdgcn_sinf(rev);
        rope[idx] = cs;
      }
    } else if (it < E10) {
      fourier_fold_item(p, it - E9);
    } else {
      const int j = it - E10;
      const float* src; int n, off;
      if (j >= 4 && j < 20) { src = p.conv_dw + (j - 4) * 1984; n = 1984; off = SM_DW + (j - 4) * 1984; }
      else switch (j) {
        case 0: src = p.norm_g; n = 4096; off = SM_NORMG; break;
        case 1: src = p.pool_scale; n = 1024; off = SM_POOLSC; break;
        case 2: src = p.diff_lambda; n = 512; off = SM_DLAM; break;
        case 3: src = p.subln_g; n = 256; off = SM_SUBLN; break;
        case 20: src = p.conv_dw_b; n = 1024; off = SM_DWB; break;
        case 21: src = p.conv_ln_g; n = 1024; off = SM_LNG; break;
        case 22: src = p.conv_ln_b; n = 1024; off = SM_LNB; break;
        default: src = p.final_g; n = 2048; off = SM_FINALG; break;
      }
      float* dst = (float*)(p.ws + OFF_SMALL) + off;
#pragma unroll
      for (int i = 0; i < 4; ++i) { const int e = (tid + i * 256) * 4; if (e < n) *(f32x4*)(dst + e) = *(const f32x4*)(src + e); }
    }
  }
}

DI const float* x_row_l0(const Params& p, int m) { return (m < NCTX) ? p.x_prompt + (size_t)m * DM : p.x_sample + (size_t)(m - NCTX) * DM; }
DI int cvec_of_row(int m) { return (m < NCTX) ? 0 : 1 + ((m - NCTX) >> 10); }

DI void norm_phase(const Params& p, int l) {
  const int tid_ = opaque_tid(); const int lane = tid_ & 63, wid = tid_ >> 6;
  const int rr = lane >> 5, q = lane & 31;
  bf16_t* H = (bf16_t*)(p.ws + OFF_H);
  const float* modv = (const float*)(p.ws + OFF_MODV);
  const float* g = SMALLP(p, SM_NORMG) + l * DM;
  for (int mp = blockIdx.x * 8 + wid; mp < NTOK / 2; mp += gridDim.x * 8) {
    const int m = mp * 2 + rr;
    const float* x = (l == 0) ? x_row_l0(p, m) : p.out + (size_t)m * DM;
    const float* mv = modv + (size_t)(l * 9 + cvec_of_row(m)) * 6144;
    f32x4 v[16];
    float ss = 0.f;
#pragma unroll
    for (int i = 0; i < 8; ++i) {
      const int c = i * 256 + q * 8;
      v[2 * i] = *(const f32x4*)(x + c); v[2 * i + 1] = *(const f32x4*)(x + c + 4);
#pragma unroll
      for (int e = 0; e < 4; ++e) ss += v[2 * i][e] * v[2 * i][e] + v[2 * i + 1][e] * v[2 * i + 1][e];
    }
#pragma unroll
    for (int o = 16; o >= 1; o >>= 1) ss += __shfl_xor(ss, o);
    const float rstd = rsqrtf(ss * (1.f / 2048.f) + EPS);
#pragma unroll
    for (int i = 0; i < 8; ++i) {
      const int c = i * 256 + q * 8;
      u32x4 o4;
#pragma unroll
      for (int hh = 0; hh < 2; ++hh) {
        const f32x4 gg = *(const f32x4*)(g + c + 4 * hh), sh = *(const f32x4*)(mv + c + 4 * hh), sc = *(const f32x4*)(mv + 2048 + c + 4 * hh);
        f32x4 h;
#pragma unroll
        for (int e = 0; e < 4; ++e) h[e] = v[2 * i + hh][e] * rstd * gg[e] * (1.f + sc[e]) + sh[e];
        o4[2 * hh] = pack_bf16(h[0], h[1]); o4[2 * hh + 1] = pack_bf16(h[2], h[3]);
      }
      *(u32x4*)(H + slab_idx(m, c, NTOK)) = o4;
    }
  }
}

DI void final_phase(const Params& p) {
  const int tid_ = opaque_tid(); const int lane = tid_ & 63, wid = tid_ >> 6;
  for (int m = blockIdx.x * 8 + wid; m < NTOK; m += gridDim.x * 8) {
    float* x = p.out + (size_t)m * DM;
    f32x4 v[8];
    float ss = 0.f;
#pragma unroll
    for (int i = 0; i < 8; ++i) { v[i] = *(const f32x4*)(x + (i * 64 + lane) * 4); ss += v[i][0] * v[i][0] + v[i][1] * v[i][1] + v[i][2] * v[i][2] + v[i][3] * v[i][3]; }
    ss = wave_sum(ss);
    const float rstd = rsqrtf(ss * (1.f / 2048.f) + EPS);
#pragma unroll
    for (int i = 0; i < 8; ++i) {
      const int c = (i * 64 + lane) * 4;
      const f32x4 gg = *(const f32x4*)(SMALLP(p, SM_FINALG) + c);
      f32x4 h;
#pragma unroll
      for (int e = 0; e < 4; ++e) h[e] = v[i][e] * rstd * gg[e];
      *(f32x4*)(x + c) = h;
    }
  }
}

DI void g1_tile(const Params& p, int l, int t) {
  const int pm = t & 63, pn = t >> 6;
  const int tid = opaque_tid(), lane = tid & 63, wid = tid >> 6, wr = wid >> 2, wc = wid & 3, fr = lane & 15, fq = lane >> 4;
  const bf16_t* A = (const bf16_t*)(p.ws + OFF_H) + (size_t)pm * 256 * 32;
  const bf16_t* B = (const bf16_t*)(p.ws + OFF_WINT) + (size_t)l * 5632 * 2048 + (size_t)pn * 256 * 32;
  bf16_t* P = (bf16_t*)(p.ws + OFF_P);
  const int m0 = pm * 256, n0 = pn * 256;
  const int nw = n0 + wc * 64;
  const bool dec = m0 >= NCTX;
  f32x4 acc[8][4];
  if (pn == 12 || pn == 13) {
    gemm_main<false, false>(A, 32, (size_t)NTOK * 32, B, 32, (size_t)5632 * 32, DM, acc);
    const int vc = nw - 3072, h = vc >> 7;
    bf16_t* vtn = (bf16_t*)(p.ws + OFF_VTN);
    int S, s0; size_t vbase; int b;
    if (!dec) { b = m0 >> 8; S = 256; s0 = 0; vbase = (size_t)b * 131072; }
    else { const int dm = m0 - NCTX; b = dm >> 10; S = 1024; s0 = dm & 1023; vbase = (size_t)32 * 131072 + (size_t)b * 524288; }
    float* ncv = p.out + 41943040ull + ((size_t)((b * 2 + l) * 4 + h)) * 32768;
#pragma unroll
    for (int mi = 0; mi < 8; ++mi)
#pragma unroll
      for (int ni = 0; ni < 4; ++ni) {
        const int s = s0 + wr * 128 + mi * 16 + 4 * fq, dv = (vc & 127) + ni * 16 + fr;
        *(u32x2*)(vtn + vbase + (size_t)(h * 128 + dv) * S + s) = pack4(acc[mi][ni]);
        if (!dec) {
#pragma unroll
          for (int j = 0; j < 4; ++j) ncv[(size_t)(s + j) * 128 + dv] = acc[mi][ni][j];
        }
      }
  } else {
    const int chunk = pn >> 1;
    if (dec && (chunk == 4 || chunk == 5)) {
      gemm_main<true, false>(A, 32, (size_t)NTOK * 32, B, 32, (size_t)5632 * 32, DM, acc);
      const f32x4* rope = (const f32x4*)(p.ws + OFF_ROPE);
#pragma unroll
      for (int mi = 0; mi < 8; ++mi) {
        const int s = (m0 - NCTX + wr * 128 + mi * 16 + fr) & 1023;
        const int prow = s >> 6, pcol = s & 63;
#pragma unroll
        for (int ax = 0; ax < 2; ++ax) {
          const int pos = ax ? pcol : prow;
          const f32x4 t0 = rope[pos * 8 + fq * 2], t1 = rope[pos * 8 + fq * 2 + 1];
          const float cs[4] = {t0[0], t0[2], t1[0], t1[2]}, sn[4] = {t0[1], t0[3], t1[1], t1[3]};
#pragma unroll
          for (int j = 0; j < 4; ++j) {
            const float x1 = acc[mi][ax * 2][j], x2 = acc[mi][ax * 2 + 1][j];
            acc[mi][ax * 2][j] = x1 * cs[j] - x2 * sn[j];
            acc[mi][ax * 2 + 1][j] = x2 * cs[j] + x1 * sn[j];
          }
        }
      }
      const int pc0 = nw + 4 * fq;
#pragma unroll
      for (int mi = 0; mi < 8; ++mi) {
        const int m = m0 + wr * 128 + mi * 16 + fr;
#pragma unroll
        for (int ni = 0; ni < 4; ++ni) *(u32x2*)(P + (size_t)m * LDP + pc0 + ni * 16) = pack4(acc[mi][ni]);
      }
    } else {
      gemm_main<true, true>(A, 32, (size_t)NTOK * 32, B, 32, (size_t)5632 * 32, DM, acc);
      const int pc0 = (nw < 3072 ? nw : nw - 512) + 8 * fq;
#pragma unroll
      for (int mi = 0; mi < 8; ++mi) {
        const int m = m0 + wr * 128 + mi * 16 + fr;
#pragma unroll
        for (int q = 0; q < 2; ++q) {
          u32x4 o; const u32x2 a = pack4(acc[mi][2 * q]), b = pack4(acc[mi][2 * q + 1]);
          o[0] = a.x; o[1] = a.y; o[2] = b.x; o[3] = b.y;
          *(u32x4*)(P + (size_t)m * LDP + pc0 + q * 32) = o;
        }
      }
      if (!dec && chunk == 5) {
        const int kc = nw - 2560, h = kc >> 7;
        const int b = m0 >> 8;
        float* nck = p.out + 33554432ull + ((size_t)((b * 2 + l) * 4 + h)) * 32768;
#pragma unroll
        for (int mi = 0; mi < 8; ++mi) {
          const int s = wr * 128 + mi * 16 + fr;
#pragma unroll
          for (int q = 0; q < 2; ++q) {
            float* dst = nck + (size_t)s * 128 + (kc & 127) + q * 32 + 8 * fq;
            *(f32x4*)dst = acc[mi][2 * q]; *(f32x4*)(dst + 4) = acc[mi][2 * q + 1];
          }
        }
      }
    }
  }
}

DI void g1_half_tile(const Params& p, int l, int ht) {
  const int t = 1280 + (ht >> 1), pm = t & 63, pn = t >> 6;
  const int tid = opaque_tid(), lane = tid & 63, wid = tid >> 6, wr = wid >> 2, wc = wid & 3, fr = lane & 15, fq = lane >> 4;
  const int m0 = pm * 256 + (ht & 1) * 128, nw = pn * 256 + wc * 64;
  const bf16_t* A = (const bf16_t*)(p.ws + OFF_H) + (size_t)m0 * 32;
  const bf16_t* B = (const bf16_t*)(p.ws + OFF_WINT) + (size_t)l * 5632 * 2048 + (size_t)pn * 256 * 32;
  bf16_t* P = (bf16_t*)(p.ws + OFF_P);
  f32x4 acc[4][4];
  gemm_main<true, true, 4>(A, 32, (size_t)NTOK * 32, B, 32, (size_t)5632 * 32, DM, acc);
  const int pc0 = (nw - 512) + 8 * fq;
#pragma unroll
  for (int mi = 0; mi < 4; ++mi) {
    const int m = m0 + wr * 64 + mi * 16 + fr;
#pragma unroll
    for (int q = 0; q < 2; ++q) {
      u32x4 o; const u32x2 a = pack4(acc[mi][2 * q]), b = pack4(acc[mi][2 * q + 1]);
      o[0] = a.x; o[1] = a.y; o[2] = b.x; o[3] = b.y;
      *(u32x4*)(P + (size_t)m * LDP + pc0 + q * 32) = o;
    }
  }
}

template <int MI = 8>
DI void gated_gemm_tile(const Params& p, const bf16_t* A, int lda, const bf16_t* B, int ldb, int K, int tok0, int ncol0, int gcol, int ycol, const float* colscale) {
  const int tid = opaque_tid(), lane = tid & 63, wid = tid >> 6, wr = wid >> 2, wc = wid & 3, fr = lane & 15, fq = lane >> 4;
  f32x4 acc[MI][4];
  gemm_main<true, true, MI>(A, lda, 32, B, ldb, 32, K, acc);
  const bf16_t* P = (const bf16_t*)(p.ws + OFF_P);
  bf16_t* Y = (bf16_t*)(p.ws + OFF_H);
#pragma unroll
  for (int q = 0; q < 2; ++q) {
    const int n = ncol0 + wc * 64 + q * 32 + 8 * fq;
    f32x4 cs0 = (f32x4){1.f, 1.f, 1.f, 1.f}, cs1 = cs0;
    if (colscale) { cs0 = *(const f32x4*)(colscale + n); cs1 = *(const f32x4*)(colscale + n + 4); }
#pragma unroll
    for (int mi = 0; mi < MI; ++mi) {
      const int tok = tok0 + wr * (MI * 16) + mi * 16 + fr;
      const u32x4 gw = *(const u32x4*)(P + (size_t)tok * LDP + gcol + n);
      const f32x4 a0 = acc[mi][2 * q], a1 = acc[mi][2 * q + 1];
      u32x4 o;
      o[0] = pack_bf16(a0[0] * cs0[0] * silu_f(bflo(gw[0])), a0[1] * cs0[1] * silu_f(bfhi(gw[0])));
      o[1] = pack_bf16(a0[2] * cs0[2] * silu_f(bflo(gw[1])), a0[3] * cs0[3] * silu_f(bfhi(gw[1])));
      o[2] = pack_bf16(a1[0] * cs1[0] * silu_f(bflo(gw[2])), a1[1] * cs1[1] * silu_f(bfhi(gw[2])));
      o[3] = pack_bf16(a1[2] * cs1[2] * silu_f(bflo(gw[3])), a1[3] * cs1[3] * silu_f(bfhi(gw[3])));
      *(u32x4*)(Y + slab_idx(tok, ycol + n, NTOK)) = o;
    }
  }
}

DI void z_tile(const Params& p, int l, int t) {
  const int pm = t & 63, pn = t >> 6;
  const int tid = opaque_tid(), lane = tid & 63, wid = tid >> 6, wr = wid >> 2, wc = wid & 3, fr = lane & 15, fq = lane >> 4;
  const bf16_t* A = (const bf16_t*)(p.ws + OFF_P) + (size_t)pm * 256 * LDP + PC_FX;
  const bf16_t* B = (const bf16_t*)(p.ws + OFF_WCST) + ((size_t)l * 1024 + pn * 256) * 512;
  f32x4 acc[8][4];
  gemm_main<false, false>(A, LDP, 32, B, 512, 32, 512, acc);
  bf16_t* ZT = (bf16_t*)(p.ws + OFF_ZT);
  const int m0 = pm * 256;
  int S, t0; size_t base;
  if (m0 < NCTX) { S = 256; t0 = 0; base = (size_t)(m0 >> 8) * 262144; }
  else { const int dm = m0 - NCTX; S = 1024; t0 = dm & 1023; base = 32ull * 262144 + (size_t)(dm >> 10) * 512 * LDZ; }
#pragma unroll
  for (int ni = 0; ni < 4; ++ni) {
    const int np = pn * 256 + wc * 64 + ni * 16 + fr, n = np & 511, half = np >> 9;
    bf16_t* row = ZT + base + (size_t)n * (S == 256 ? 512 : LDZ) + half * S + t0;
#pragma unroll
    for (int mi = 0; mi < 8; ++mi) *(u32x2*)(row + wr * 128 + mi * 16 + 4 * fq) = pack4(acc[mi][ni]);
  }
}

DI void out_tile(const Params& p, int l, int t) {
  const int pm = t & 63, pn = t >> 6;
  const int tid = opaque_tid(), lane = tid & 63, wid = tid >> 6, wr = wid >> 2, wc = wid & 3, fr = lane & 15, fq = lane >> 4;
  const bf16_t* A = (const bf16_t*)(p.ws + OFF_H) + (size_t)pm * 256 * 32;
  const bf16_t* B = (const bf16_t*)(p.ws + OFF_WOUTT) + (size_t)l * 2048 * 2048 + (size_t)pn * 256 * 32;
  f32x4 acc[8][4];
  gemm_main<true, true>(A, 32, (size_t)NTOK * 32, B, 32, (size_t)2048 * 32, DM, acc);
  const int m0 = pm * 256;
  const float* gate = (const float*)(p.ws + OFF_MODV) + (size_t)(l * 9 + cvec_of_row(m0)) * 6144 + 4096;
#pragma unroll
  for (int q = 0; q < 2; ++q) {
    const int n = pn * 256 + wc * 64 + q * 32 + 8 * fq;
    const f32x4 g0 = *(const f32x4*)(gate + n), g1 = *(const f32x4*)(gate + n + 4);
#pragma unroll
    for (int mi = 0; mi < 8; ++mi) {
      const int m = m0 + wr * 128 + mi * 16 + fr;
      const float* xin = ((l == 0) ? x_row_l0(p, m) : p.out + (size_t)m * DM) + n;
      const f32x4 x0 = *(const f32x4*)(xin), x1 = *(const f32x4*)(xin + 4);
      float* dst = p.out + (size_t)m * DM + n;
      *(f32x4*)dst = x0 + g0 * acc[mi][2 * q];
      *(f32x4*)(dst + 4) = x1 + g1 * acc[mi][2 * q + 1];
    }
  }
}

DI void seq_of_tok(int tok0, int& S, int& sbase) {
  if (tok0 < NCTX) { S = 256; sbase = tok0 & ~255; } else { S = 1024; sbase = NCTX + ((tok0 - NCTX) & ~1023); }
}

template <int W>
DI void pool_task(const bf16_t* base, int S, int sA, bf16_t* outp) {
  constexpr int HW = W / 2, NR = 7 + W;
  u32x4 rows[NR];
#pragma unroll
  for (int r = 0; r < NR; ++r) {
    const int s = sA - HW + r;
    const bool ok = (s >= 0) && (s < S);
    const u32x4 v = *(const u32x4*)(base + (size_t)min(max(s, 0), S - 1) * LDP);
#pragma unroll
    for (int e = 0; e < 4; ++e) rows[r][e] = ok ? v[e] : 0u;
  }
  float sum[8];
#pragma unroll
  for (int e = 0; e < 8; ++e) sum[e] = 0.f;
#pragma unroll
  for (int r = 0; r < W; ++r)
#pragma unroll
    for (int e = 0; e < 4; ++e) { sum[2 * e] += bflo(rows[r][e]); sum[2 * e + 1] += bfhi(rows[r][e]); }
#pragma unroll
  for (int k = 0; k < 8; ++k) {
    const int s = sA + k;
    const int lo = max(s - HW, 0), hi = min(s - HW + W, S);
    const float inv = 1.f / (float)(hi - lo);
    const u32x4 xv = rows[k + HW];
    u32x4 o4;
#pragma unroll
    for (int e = 0; e < 4; ++e) o4[e] = pack_bf16(sum[2 * e] * inv - bflo(xv[e]), sum[2 * e + 1] * inv - bfhi(xv[e]));
    *(u32x4*)(outp + (size_t)k * 512) = o4;
    if (k < 7) {
#pragma unroll
      for (int e = 0; e < 4; ++e) {
        sum[2 * e] += bflo(rows[k + W][e]) - bflo(rows[k][e]);
        sum[2 * e + 1] += bfhi(rows[k + W][e]) - bfhi(rows[k][e]);
      }
    }
  }
}

DI void pool_item(const Params& p, int t) {
  const int tid = half_tid(), tok0 = t * 32;
  int S, sbase; seq_of_tok(tok0, S, sbase);
  const int g = tid >> 6, run = (tid >> 4) & 3, c0 = g * 128 + (tid & 15) * 8;
  const int sA = tok0 - sbase + run * 8;
  const bf16_t* base = (const bf16_t*)(p.ws + OFF_P) + (size_t)sbase * LDP + PC_PX + c0;
  bf16_t* outp = (bf16_t*)(p.ws + OFF_POOLED) + (size_t)(sbase + sA) * 512 + c0;
  if (g == 0) pool_task<2>(base, S, sA, outp);
  else if (g == 1) pool_task<4>(base, S, sA, outp);
  else if (g == 2) pool_task<8>(base, S, sA, outp);
  else pool_task<16>(base, S, sA, outp);
}

DI void conv_item(const Params& p, int l, int t) {
  const int tid = half_tid(), lane = tid & 63, wid = tid >> 6, tok0 = t * 32;
  int S, sbase; seq_of_tok(tok0, S, sbase);
  const int s0 = tok0 - sbase;
  const bf16_t* P = (const bf16_t*)(p.ws + OFF_P);
  bf16_t* U = (bf16_t*)HSM;
  float* red = (float*)(HSM + 63488);
#pragma unroll 4
  for (int idx = tid; idx < 62 * 64; idx += 256) {
    const int rr = idx >> 6, ch = (idx & 63) * 8, s = s0 - 15 + rr;
    const bool ok = (s >= 0) && (s < S);
    const int sc = min(max(s, 0), S - 1);
    const bf16_t* row = P + (size_t)(sbase + sc) * LDP;
    const u32x4 a = *(const u32x4*)(row + PC_CA + ch), b = *(const u32x4*)(row + PC_CB + ch);
    u32x4 o;
#pragma unroll
    for (int e = 0; e < 4; ++e) { const unsigned v = pack_bf16(bflo(a[e]) * sigmoid_f(bflo(b[e])), bfhi(a[e]) * sigmoid_f(bfhi(b[e]))); o[e] = ok ? v : 0u; }
    *(u32x4*)(U + rr * 512 + ch) = o;
  }
  __syncthreads();
  const int c2 = tid * 2;
  float y0[32], y1[32];
  {
    const f32x2 bb = *(const f32x2*)(SMALLP(p, SM_DWB) + l * 512 + c2);
#pragma unroll
    for (int i = 0; i < 32; ++i) { y0[i] = bb.x; y1[i] = bb.y; }
  }
  const float* dw = SMALLP(p, SM_DW) + (size_t)l * 31 * 512 + c2;
  f32x2 wn = *(const f32x2*)dw;
#pragma unroll 1
  for (int j = 0; j < 31; ++j) {
    const f32x2 w = wn;
    if (j + 1 < 31) wn = *(const f32x2*)(dw + (j + 1) * 512);
    const unsigned wpk = pack_bf16(w.x, w.y), wlo = wpk & 0xffffu, whi = wpk & 0xffff0000u;
    const bf16_t* up = U + j * 512 + c2;
#pragma unroll
    for (int i = 0; i < 32; ++i) {
      const unsigned u = *(const unsigned*)(up + i * 512);
      y0[i] = dot2bf(u, wlo, y0[i]); y1[i] = dot2bf(u, whi, y1[i]);
    }
  }
#pragma unroll
  for (int i = 0; i < 32; ++i) {
    const float s1 = wave_sum_dpp(y0[i] + y1[i]);
    const float s2 = wave_sum_dpp(y0[i] * y0[i] + y1[i] * y1[i]);
    if (lane == 0) { red[(wid * 32 + i) * 2] = s1; red[(wid * 32 + i) * 2 + 1] = s2; }
  }
  __syncthreads();
  const f32x2 lg = *(const f32x2*)(SMALLP(p, SM_LNG) + l * 512 + c2), lb = *(const f32x2*)(SMALLP(p, SM_LNB) + l * 512 + c2);
  bf16_t* out = (bf16_t*)(p.ws + OFF_CONVACT);
#pragma unroll
  for (int i = 0; i < 32; ++i) {
    float s1 = 0.f, s2 = 0.f;
#pragma unroll
    for (int w = 0; w < 4; ++w) { s1 += red[(w * 32 + i) * 2]; s2 += red[(w * 32 + i) * 2 + 1]; }
    const float mean = s1 * (1.f / 512.f), var = s2 * (1.f / 512.f) - mean * mean, rstd = rsqrtf(var + EPS);
    const float a0 = silu_f((y0[i] - mean) * rstd * lg.x + lb.x), a1 = silu_f((y1[i] - mean) * rstd * lg.y + lb.y);
    *(unsigned*)(out + (size_t)(tok0 + i) * 512 + c2) = pack_bf16(a0, a1);
  }
}

DI void attn_item(const Params& p, int l, bool dec, int b, int h, int qt) {
  const int tid = half_tid(), lane = tid & 63, wid = tid >> 6, fr = lane & 15, fq = lane >> 4;
  const int S = dec ? 1024 : 256;
  const int tok0 = dec ? NCTX + b * 1024 : b * 256;
  const int nkt = dec ? 20 : 4, ncache = dec ? 4 : 0;
  const bf16_t* P = (const bf16_t*)(p.ws + OFF_P);
  const float lam_init = (l == 0) ? 0.2f : 0.35550906f;
  float lam;
  {
    const float* dl = SMALLP(p, SM_DLAM) + l * 256;
    const float a = wave_sum(dl[lane] * dl[64 + lane]), c = wave_sum(dl[128 + lane] * dl[192 + lane]);
    lam = __expf(a) - __expf(c) + lam_init;
  }
  const int q0 = qt * 64 + wid * 16;
  bf16x8 qf[2][2];
  {
    const bf16_t* qrow = P + (size_t)(tok0 + q0 + fr) * LDP + PC_Q + h * 128;
#pragma unroll
    for (int m = 0; m < 2; ++m)
#pragma unroll
      for (int ks = 0; ks < 2; ++ks) qf[m][ks] = *(const bf16x8*)(qrow + m * 64 + ks * 32 + fq * 8);
  }
  const size_t blh = (size_t)((b * 2 + l) * 4 + h);
  const bf16_t* kc = (const bf16_t*)(p.ws + OFF_KC) + blh * 32768;
  const bf16_t* vtc = (const bf16_t*)(p.ws + OFF_VTC) + blh * 32768;
  const bf16_t* kn = P + (size_t)tok0 * LDP + PC_K + h * 128;
  const bf16_t* vtn = (const bf16_t*)(p.ws + OFF_VTN) + (dec ? (size_t)32 * 131072 + (size_t)b * 524288 : (size_t)b * 131072) + (size_t)h * 128 * S;
  char* hb = HSM;
  const int kkey = lane >> 4, kpc = lane & 15;
  const int vrow = lane >> 3, vpc = lane & 7;
  auto issue_tile = [&](int kt, int buf) {
    char* kb = hb + buf * 32768 + lane * 16;
    const bf16_t* ksrc; size_t kstride; const bf16_t* vsrc; size_t vstride;
    if (kt < ncache) { ksrc = kc + (size_t)(kt * 64) * 128; kstride = 128; vsrc = vtc + kt * 64; vstride = 256; }
    else { const int kk = (kt - ncache) * 64; ksrc = kn + (size_t)kk * LDP; kstride = LDP; vsrc = vtn + kk; vstride = S; }
#pragma unroll
    for (int i = 0; i < 4; ++i) {
      const int pi = wid + 4 * i;
      const int key = pi * 4 + kkey;
      __builtin_amdgcn_global_load_lds((const unsigned*)(ksrc + (size_t)key * kstride + ((kpc ^ (key & 15)) * 8)), (LDSP)(kb + pi * 1024), 16, 0, 0);
    }
#pragma unroll
    for (int i = 0; i < 4; ++i) {
      const int pi = wid + 4 * i;
      const int dv = pi * 8 + vrow;
      __builtin_amdgcn_global_load_lds((const unsigned*)(vsrc + (size_t)dv * vstride + ((vpc ^ ((dv >> 1) & 7)) * 8)), (LDSP)(kb + 16384 + pi * 1024), 16, 0, 0);
    }
  };
  float m_run[2] = {-INFINITY, -INFINITY}, l_run[2] = {0.f, 0.f};
  f32x4 O[2][8];
#pragma unroll
  for (int m = 0; m < 2; ++m)
#pragma unroll
    for (int d = 0; d < 8; ++d) O[m][d] = (f32x4){0.f, 0.f, 0.f, 0.f};
  const float cexp = 0.125f * 1.4426950408889634f;
  const int vsw = (fr >> 1) & 7;
  issue_tile(0, 0);
#pragma unroll 1
  for (int kt = 0; kt < nkt; ++kt) {
    asm volatile("s_waitcnt vmcnt(0)" ::: "memory");
    __syncthreads();
    if (kt + 1 < nkt) issue_tile(kt + 1, (kt + 1) & 1);
    const char* Ks = hb + (kt & 1) * 32768;
    const char* Vs = Ks + 16384;
    bf16x8 pf[2][2];
#pragma unroll
    for (int m = 0; m < 2; ++m) {
      f32x4 s[4];
#pragma unroll
      for (int ksub = 0; ksub < 4; ++ksub) {
        f32x4 a = (f32x4){0.f, 0.f, 0.f, 0.f};
#pragma unroll
        for (int ks = 0; ks < 2; ++ks) {
          const bf16x8 kf = *(const bf16x8*)(Ks + (ksub * 16 + fr) * 256 + (((m * 8 + ks * 4 + fq) ^ fr) * 16));
          a = MFMA16(kf, qf[m][ks], a);
        }
        s[ksub] = a;
      }
      float mx = s[0][0];
#pragma unroll
      for (int ksub = 0; ksub < 4; ++ksub)
#pragma unroll
        for (int j = 0; j < 4; ++j) mx = fmaxf(mx, s[ksub][j]);
      mx = xrow_max(mx);
      const float mn = fmaxf(m_run[m], mx);
      const float alpha = __builtin_amdgcn_exp2f((m_run[m] - mn) * cexp);
      m_run[m] = mn;
      float ls = 0.f;
#pragma unroll
      for (int ksub = 0; ksub < 4; ++ksub)
#pragma unroll
        for (int j = 0; j < 4; ++j) { const float e = __builtin_amdgcn_exp2f((s[ksub][j] - mn) * cexp); s[ksub][j] = e; ls += e; }
      l_run[m] = l_run[m] * alpha + ls;
      if (__any(alpha != 1.f)) {
#pragma unroll
        for (int d = 0; d < 8; ++d) O[m][d] *= alpha;
      }
#pragma unroll
      for (int k2 = 0; k2 < 2; ++k2) {
        u32x4 w;
        w[0] = pack_bf16(s[2 * k2][0], s[2 * k2][1]); w[1] = pack_bf16(s[2 * k2][2], s[2 * k2][3]);
        w[2] = pack_bf16(s[2 * k2 + 1][0], s[2 * k2 + 1][1]); w[3] = pack_bf16(s[2 * k2 + 1][2], s[2 * k2 + 1][3]);
        pf[m][k2] = __builtin_bit_cast(bf16x8, w);
      }
      asm volatile("" ::: "memory");
    }
#pragma unroll
    for (int k2 = 0; k2 < 2; ++k2) {
      asm volatile("" ::: "memory");
#pragma unroll
      for (int d = 0; d < 8; ++d) {
        const char* vr = Vs + (d * 16 + fr) * 128 + (fq & 1) * 8;
        const int c1 = k2 * 4 + (fq >> 1);
        const s16x4 lo = *(const s16x4*)(vr + ((c1 ^ vsw) * 16)), hi = *(const s16x4*)(vr + (((c1 + 2) ^ vsw) * 16));
        const bf16x8 vf = __builtin_shufflevector(lo, hi, 0, 1, 2, 3, 4, 5, 6, 7);
        O[0][d] = MFMA16(vf, pf[0][k2], O[0][d]);
        O[1][d] = MFMA16(vf, pf[1][k2], O[1][d]);
      }
    }
  }
#pragma unroll
  for (int m = 0; m < 2; ++m) l_run[m] = xrow_sum(l_run[m]);
  const float inv1 = 1.f / l_run[0], inv2 = lam / l_run[1];
  float ss = 0.f;
#pragma unroll
  for (int d = 0; d < 8; ++d)
#pragma unroll
    for (int j = 0; j < 4; ++j) { const float o = O[0][d][j] * inv1 - O[1][d][j] * inv2; O[0][d][j] = o; ss += o * o; }
  ss = xrow_sum(ss);
  const float rstd = rsqrtf(ss * (1.f / 128.f) + EPS) * (1.f - lam_init);
  const int tok = tok0 + q0 + fr;
  bf16_t* Y = (bf16_t*)(p.ws + OFF_H);
#pragma unroll
  for (int d = 0; d < 8; ++d) {
    const int dv = d * 16 + 4 * fq;
    const f32x4 g4 = *(const f32x4*)(SMALLP(p, SM_SUBLN) + l * 128 + dv);
    const u32x2 gw = *(const u32x2*)(P + (size_t)tok * LDP + PC_AG + h * 128 + dv);
    f32x4 o;
    o[0] = O[0][d][0] * rstd * g4[0] * silu_f(bflo(gw.x));
    o[1] = O[0][d][1] * rstd * g4[1] * silu_f(bfhi(gw.x));
    o[2] = O[0][d][2] * rstd * g4[2] * silu_f(bflo(gw.y));
    o[3] = O[0][d][3] * rstd * g4[3] * silu_f(bfhi(gw.y));
    *(u32x2*)(Y + slab_idx(tok, 1024 + h * 128 + dv, NTOK)) = pack4(o);
  }
}

__global__ void __launch_bounds__(512, 2) fwd_megakernel(Params p) {
  cg::grid_group grid = cg::this_grid();
  unsigned* sync = (unsigned*)(p.ws + OFF_SYNC);
  unsigned* queues = (unsigned*)(p.ws + OFF_QUEUE);
  if (threadIdx.x == 0) { g_sh[1] = 0u; g_sh[2] = 0u; }
  __syncthreads();
  if (threadIdx.x == 0) (void)xb_add(&sync[XB_XCNT(xb_xcc_id())], 1u);
  if (p.never) grid.sync();
  phase0(p);
  grid_barrier(sync, 0);
  mod_reduce(p);
  grid_barrier(sync, 0);
  for (int l = 0; l < 2; ++l) {
    norm_phase(p, l);
    grid_barrier(sync, 0);
    for (int t = blockIdx.x; t < 1280; t += gridDim.x) g1_tile(p, l, t);
    for (int ht = blockIdx.x; ht < 256; ht += gridDim.x) g1_half_tile(p, l, ht);
    grid_barrier(sync, 0);
    {
      unsigned* q = queues + 64 * (l * 2);
      for (;;) {
        const int it = queue_next(q);
        if (it >= 1280) break;
        const int hf = half_id();
        if (it < 256) { const int a = it * 2 + hf; attn_item(p, l, true, a >> 6, (a >> 4) & 3, a & 15); }
        else if (it < 512) z_tile(p, l, it - 256);
        else if (it < 768) conv_item(p, l, (it - 512) * 2 + hf);
        else if (it < 1024) { const int a = (it - 768) * 2 + hf; attn_item(p, l, false, a >> 4, (a >> 2) & 3, a & 3); }
        else pool_item(p, (it - 1024) * 2 + hf);
      }
    }
    grid_barrier(sync, 0);
    {
      unsigned* q = queues + 64 * (1 + l * 2);
      for (;;) {
        const int it = queue_next(q);
        if (it >= 448) break;
        if (it < 128) {
          const int seq = it >> 4, mh = (it >> 1) & 7, nt = it & 1;
          gated_gemm_tile<4>(p, (const bf16_t*)(p.ws + OFF_DDEC) + (size_t)mh * 128 * LDD, LDD,
                             (const bf16_t*)(p.ws + OFF_ZT) + 32ull * 262144 + (size_t)seq * 512 * LDZ + (size_t)nt * 256 * LDZ, LDZ, 2048,
                             NCTX + seq * 1024 + mh * 128, nt * 256, PC_FG, 0, nullptr);
        } else if (it < 256) {
          const int t = it - 128, pm = t & 63, pn = t >> 6;
          gated_gemm_tile(p, (const bf16_t*)(p.ws + OFF_CONVACT) + (size_t)pm * 256 * 512, 512,
                          (const bf16_t*)(p.ws + OFF_WPWT) + ((size_t)l * 512 + pn * 256) * 512, 512, 512, pm * 256, pn * 256, PC_CG, 1536, nullptr);
        } else if (it < 320) {
          const int t = it - 256, seq = t >> 1, nt = t & 1;
          gated_gemm_tile(p, (const bf16_t*)(p.ws + OFF_DCTX), LDC, (const bf16_t*)(p.ws + OFF_ZT) + (size_t)seq * 262144 + (size_t)nt * 256 * 512, 512, 512,
                          seq * 256, nt * 256, PC_FG, 0, nullptr);
        } else {
          const int t = it - 320, pm = t & 63, pr = t >> 6;
          gated_gemm_tile(p, (const bf16_t*)(p.ws + OFF_POOLED) + (size_t)pm * 256 * 512 + pr * 256, 512,
                          (const bf16_t*)(p.ws + OFF_WPOOLT) + (size_t)(l * 2 + pr) * 65536, 256, 256, pm * 256, pr * 256, PC_PG, 512, SMALLP(p, SM_POOLSC) + l * 512);
        }
      }
    }
    grid_barrier(sync, 0);
    for (int t = blockIdx.x; t < 64 * 8; t += gridDim.x) out_tile(p, l, t);
    grid_barrier(sync, 0);
  }
  final_phase(p);
}

extern "C" void kernel_launch(void* const* d_in, const int* in_sizes, int n_in, void* d_out, int out_size, void* d_ws, size_t ws_size,
                              hipStream_t stream) {
  static int grid_blocks = 0;
  if (!grid_blocks) {
    int dev = 0, cus = 0, per_cu = 0;
    (void)hipGetDevice(&dev);
    (void)hipDeviceGetAttribute(&cus, hipDeviceAttributeMultiprocessorCount, dev);
    (void)hipFuncSetAttribute((const void*)fwd_megakernel, hipFuncAttributeMaxDynamicSharedMemorySize, (int)kDynLds);
    (void)hipOccupancyMaxActiveBlocksPerMultiprocessor(&per_cu, fwd_megakernel, 512, kDynLds);
    if (per_cu > 1) per_cu = 1;
    if (per_cu < 1) per_cu = 1;
    grid_blocks = cus * per_cu;
  }
  Params p{};
  const float** pp = (const float**)&p;
  for (int i = 0; i < 22; ++i) pp[i] = (const float*)d_in[i];
  p.out = (float*)d_out;
  p.ws = (unsigned char*)d_ws;
  (void)hipMemsetAsync(d_ws, 0, ZERO_BYTES, stream);
  void* args[] = {&p};
  hipError_t e = hipLaunchCooperativeKernel((void*)fwd_megakernel, dim3(grid_blocks), dim3(512), args, kDynLds, stream);
  if (e != hipSuccess) fprintf(stderr, "cooperative launch failed: %s (grid %d)\n", hipGetErrorString(e), grid_blocks);
}
```

```cpp
#include <hip/hip_runtime.h>
#include <hip/hip_cooperative_groups.h>
#include <stdint.h>
#include <cstdio>
namespace cg = cooperative_groups;

typedef unsigned short bf16_t;
typedef short bf16x8 __attribute__((ext_vector_type(8)));
typedef short s16x4 __attribute__((ext_vector_type(4)));
typedef float f32x4 __attribute__((ext_vector_type(4)));
typedef float f32x2 __attribute__((ext_vector_type(2)));
typedef unsigned u32x4 __attribute__((ext_vector_type(4)));
typedef unsigned u32x2 __attribute__((ext_vector_type(2)));
#define DI __device__ __forceinline__
#define LDSP __attribute__((address_space(3))) void*
#define MFMA16(a, b, c) __builtin_amdgcn_mfma_f32_16x16x32_bf16((a), (b), (c), 0, 0, 0)

constexpr int DM = 2048, NTOK = 16384, NCTX = 8192;
constexpr int LDP = 5120;
constexpr int PC_FX = 0, PC_FG = 512, PC_PX = 1024, PC_PG = 1536, PC_Q = 2048, PC_K = 2560, PC_AG = 3072, PC_CA = 3584, PC_CB = 4096, PC_CG = 4608;
constexpr float EPS = 1e-6f;
constexpr int LDD = 2112;
constexpr int LDZ = 2112;
constexpr int LDC = 576;

constexpr size_t OFF_SYNC = 0;
constexpr size_t OFF_QUEUE = 16384;
constexpr size_t OFF_MODV = 20480;
constexpr size_t SZ_MODV = 2ull * 9 * 6144 * 4;
constexpr size_t ZERO_BYTES = OFF_MODV + SZ_MODV;
constexpr size_t OFF_ROPE = ZERO_BYTES;
constexpr size_t OFF_P = OFF_ROPE + 8192;
constexpr size_t OFF_H = OFF_P + (size_t)NTOK * LDP * 2;
constexpr size_t OFF_ZT = OFF_H + (size_t)NTOK * DM * 2;
constexpr size_t OFF_VTN = OFF_ZT + (32ull * 262144 + 8ull * 512 * LDZ) * 2;
constexpr size_t OFF_POOLED = OFF_VTN + (size_t)NTOK * 512 * 2;
constexpr size_t OFF_CONVACT = OFF_POOLED + (size_t)NTOK * 512 * 2;
constexpr size_t OFF_WINT = OFF_CONVACT + (size_t)NTOK * 512 * 2;
constexpr size_t OFF_WOUTT = OFF_WINT + 2ull * 5632 * 2048 * 2;
constexpr size_t OFF_WCST = OFF_WOUTT + 2ull * 2048 * 2048 * 2;
constexpr size_t OFF_WPOOLT = OFF_WCST + 2ull * 1024 * 512 * 2;
constexpr size_t OFF_WPWT = OFF_WPOOLT + 2ull * 2 * 256 * 256 * 2;
constexpr size_t OFF_KC = OFF_WPWT + 2ull * 512 * 512 * 2;
constexpr size_t OFF_VTC = OFF_KC + 8ull * 2 * 4 * 256 * 128 * 2;
constexpr size_t OFF_DCTX = OFF_VTC + 8ull * 2 * 4 * 256 * 128 * 2;
constexpr size_t OFF_DDEC = OFF_DCTX + 256ull * LDC * 2;
constexpr size_t OFF_SMALL = OFF_DDEC + 1024ull * LDD * 2;
constexpr int SM_NORMG = 0, SM_POOLSC = 4096, SM_DLAM = 5120, SM_SUBLN = 5632, SM_DW = 5888, SM_DWB = 37632, SM_LNG = 38656, SM_LNB = 39680, SM_FINALG = 40704, SM_TOTAL = 42752;
constexpr size_t WS_TOTAL = OFF_SMALL + (size_t)SM_TOTAL * 4;
static_assert(WS_TOTAL <= 402653184ull, "workspace too large");

struct Params {
  const float *x_prompt, *x_sample, *cache_k, *cache_v, *c, *c_ctx, *norm_g, *w_mod, *b_mod, *w_in, *w_fourier, *w_pool,
      *pool_scale, *diff_lambda, *subln_g, *conv_dw, *conv_dw_b, *conv_ln_g, *conv_ln_b, *w_conv_pw, *w_out, *final_g;
  float* out;
  unsigned char* ws;
  unsigned long long never;
};

extern __shared__ __attribute__((aligned(16))) char g_smem[];
constexpr size_t kDynLds = 131072;
#define HSM (g_smem + (half_id() << 16))
__shared__ unsigned g_sh[4];

#define SMALLP(p, off) ((const float*)((p).ws + OFF_SMALL) + (off))
DI size_t slab_idx(int row, int col, int nrows) { return ((size_t)(col >> 5) * nrows + row) * 32 + (col & 31); }
DI float bf2f(unsigned u16) { return __uint_as_float(u16 << 16); }
DI float bflo(unsigned w) { return __uint_as_float(w << 16); }
DI float bfhi(unsigned w) { return __uint_as_float(w & 0xffff0000u); }
DI unsigned pack_bf16(float lo, float hi) { unsigned r; asm("v_cvt_pk_bf16_f32 %0, %1, %2" : "=v"(r) : "v"(lo), "v"(hi)); return r; }
DI float silu_f(float x) { return x * __builtin_amdgcn_rcpf(1.f + __expf(-x)); }
DI float sigmoid_f(float x) { return __builtin_amdgcn_rcpf(1.f + __expf(-x)); }
DI int opaque_tid() { int t = threadIdx.x; asm volatile("" : "+v"(t)); return t; }
DI int half_tid() { return opaque_tid() & 255; }
DI int half_id() { return opaque_tid() >> 8; }
DI float wave_sum(float v) {
#pragma unroll
  for (int o = 32; o >= 1; o >>= 1) v += __shfl_xor(v, o);
  return v;
}
typedef __bf16 bf2_t __attribute__((ext_vector_type(2)));
DI float dot2bf(unsigned a, unsigned b, float c) { return __builtin_amdgcn_fdot2_f32_bf16(__builtin_bit_cast(bf2_t, a), __builtin_bit_cast(bf2_t, b), c, false); }
DI float xrow_max(float v) {
  u32x2 r = __builtin_amdgcn_permlane16_swap(__float_as_uint(v), __float_as_uint(v), false, false);
  v = fmaxf(__uint_as_float(r[0]), __uint_as_float(r[1]));
  r = __builtin_amdgcn_permlane32_swap(__float_as_uint(v), __float_as_uint(v), false, false);
  return fmaxf(__uint_as_float(r[0]), __uint_as_float(r[1]));
}
DI float xrow_sum(float v) {
  u32x2 r = __builtin_amdgcn_permlane16_swap(__float_as_uint(v), __float_as_uint(v), false, false);
  v = __uint_as_float(r[0]) + __uint_as_float(r[1]);
  r = __builtin_amdgcn_permlane32_swap(__float_as_uint(v), __float_as_uint(v), false, false);
  return __uint_as_float(r[0]) + __uint_as_float(r[1]);
}
DI u32x2 pack4(f32x4 v) { u32x2 r; r.x = pack_bf16(v[0], v[1]); r.y = pack_bf16(v[2], v[3]); return r; }

#define XB_TMO      128
#define XB_XCNT(j)  (256  + 64 * (j))
#define XB_XSUB(j)  (1280 + 64 * (j))
#define XB_XGEN(j)  (2304 + 64 * (j))
#define XB_TOP      3328
#define XB_TOPGEN   3392
#define XB_SPIN_CAP (1u << 20)
DI unsigned xb_ld(unsigned* p) { return __hip_atomic_load(p, __ATOMIC_RELAXED, __HIP_MEMORY_SCOPE_AGENT); }
DI unsigned xb_add(unsigned* p, unsigned v) { return __hip_atomic_fetch_add(p, v, __ATOMIC_RELAXED, __HIP_MEMORY_SCOPE_AGENT); }
DI unsigned xb_xcc_id() { return (unsigned)__builtin_amdgcn_s_getreg((3 << 11) | 20) & 0xFu; }
#define XB_SPIN(cond, bar) do { unsigned _sp = 0; while (cond) { __builtin_amdgcn_s_sleep(1); \
    if ((++_sp & 255u) == 0u) { if (xb_ld(&(bar)[XB_TMO])) break; if (_sp > XB_SPIN_CAP) { atomicAdd(&(bar)[XB_TMO], 1u); break; } } } } while (0)
DI void xcd_barrier_complete(unsigned* bar, unsigned x, unsigned& nloc, unsigned& nx) {
  const unsigned G = gridDim.x;
  unsigned sum, cnt, mine, sp = 0u;
  for (;;) {
    sum = 0u; cnt = 0u; mine = 0u;
#pragma unroll
    for (unsigned j = 0; j < 16; ++j) { const unsigned c = xb_ld(&bar[XB_XCNT(j)]); sum += c; cnt += (c > 0u) ? 1u : 0u; mine = (j == x) ? c : mine; }
    if (sum == G) break;
    __builtin_amdgcn_s_sleep(1);
    if ((++sp & 255u) == 0u) { if (xb_ld(&bar[XB_TMO])) break; if (sp > XB_SPIN_CAP) { atomicAdd(&bar[XB_TMO], 1u); break; } }
  }
  nloc = mine > 0u ? mine : 1u; nx = cnt > 0u ? cnt : 1u;
}
DI void grid_barrier(unsigned* bar, unsigned) {
  asm volatile("s_waitcnt vmcnt(0)" ::: "memory");
  __syncthreads();
  if (threadIdx.x == 0) {
    __builtin_amdgcn_s_waitcnt(0);
    const unsigned x = xb_xcc_id();
    volatile unsigned* st = g_sh;
    unsigned nloc = st[1], nx = st[2];
    if (nloc == 0u) { xcd_barrier_complete(bar, x, nloc, nx); st[1] = nloc; st[2] = nx; }
    const unsigned old = xb_add(&bar[XB_XSUB(x)], 1u);
    const unsigned gen = old / nloc;
    if (old + 1u == (gen + 1u) * nloc) {
      __builtin_amdgcn_fence(__ATOMIC_RELEASE, "agent");
      asm volatile("s_waitcnt vmcnt(0)" ::: "memory");
      const unsigned og = xb_add(&bar[XB_TOP], 1u);
      const unsigned tg = og / nx;
      if (og + 1u == (tg + 1u) * nx) xb_add(&bar[XB_TOPGEN], 1u);
      else XB_SPIN(xb_ld(&bar[XB_TOPGEN]) == tg, bar);
      __builtin_amdgcn_fence(__ATOMIC_ACQUIRE, "agent");
      xb_add(&bar[XB_XGEN(x)], 1u);
      asm volatile("s_waitcnt vmcnt(0)" ::: "memory");
    } else {
      XB_SPIN(xb_ld(&bar[XB_XGEN(x)]) == gen, bar);
      __builtin_amdgcn_fence(__ATOMIC_ACQUIRE, "agent");
      asm volatile("s_waitcnt vmcnt(0)" ::: "memory");
    }
  }
  __syncthreads();
}

DI int queue_next(unsigned* q) {
  __syncthreads();
  if (threadIdx.x == 0) g_sh[0] = __hip_atomic_fetch_add(q, 1u, __ATOMIC_RELAXED, __HIP_MEMORY_SCOPE_AGENT);
  __syncthreads();
  return (int)g_sh[0];
}

template <int CTRL, int ROWMASK> DI float dpp_add(float v) {
  const int t = __builtin_amdgcn_update_dpp(0, __float_as_int(v), CTRL, ROWMASK, 0xf, false);
  return v + __int_as_float(t);
}
DI float wave_sum_dpp(float v) {
  v = dpp_add<0x111, 0xf>(v); v = dpp_add<0x112, 0xf>(v); v = dpp_add<0x114, 0xf>(v); v = dpp_add<0x118, 0xf>(v);
  v = dpp_add<0x142, 0xa>(v); v = dpp_add<0x143, 0xc>(v);
  return __int_as_float(__builtin_amdgcn_readlane(__float_as_int(v), 63));
}

template <bool TRANS, bool PERM, int MI = 8>
DI void gemm_main(const bf16_t* A, int lda, size_t ksA, const bf16_t* B, int ldb, size_t ksB, int K, f32x4 (&acc)[MI][4]) {
  const int tid = opaque_tid(), lane = tid & 63, wid = tid >> 6, wr = wid >> 2, wc = wid & 3, fr = lane & 15, fq = lane >> 4;
  const int lrow = tid >> 2, lch = tid & 3;
  const int lsw = (lch ^ (((lrow >> 3) & 1) << 1)) * 8;
  const bf16_t* ga = A + (size_t)lrow * lda + lsw;
  const int rho = lrow & 31;
  const int lrow_b = PERM ? ((lrow & ~31) | (8 * ((rho & 15) >> 2) + 4 * (rho >> 4) + (rho & 3))) : lrow;
  const bf16_t* gb = B + (size_t)lrow_b * ldb + lsw;
  const size_t sa = (size_t)128 * lda, sb = (size_t)128 * ldb;
#pragma unroll
  for (int mi = 0; mi < MI; ++mi)
#pragma unroll
    for (int ni = 0; ni < 4; ++ni) acc[mi][ni] = (f32x4){0.f, 0.f, 0.f, 0.f};
  char* lbase = g_smem + tid * 16;
#define GLDS_ISSUE(STG)                                                                                              \
  do {                                                                                                               \
    char* l_ = lbase + (STG) * 32768;                                                                                \
    __builtin_amdgcn_global_load_lds((const unsigned*)(ga), (LDSP)(l_), 16, 0, 0);                                   \
    if (MI == 8) __builtin_amdgcn_global_load_lds((const unsigned*)(ga + sa), (LDSP)(l_ + 8192), 16, 0, 0);          \
    __builtin_amdgcn_global_load_lds((const unsigned*)(gb), (LDSP)(l_ + 16384), 16, 0, 0);                           \
    __builtin_amdgcn_global_load_lds((const unsigned*)(gb + sb), (LDSP)(l_ + 24576), 16, 0, 0);                      \
    ga += ksA; gb += ksB;                                                                                            \
  } while (0)
  asm volatile("s_waitcnt vmcnt(0)" ::: "memory");
  __syncthreads();
  const int nk = K >> 5;
  GLDS_ISSUE(0);
  GLDS_ISSUE(1);
  GLDS_ISSUE(2);
  const int rsw = (fq ^ (((fr >> 3) & 1) << 1)) * 16;
  const int aofs = (wr * (MI * 16) + fr) * 64 + rsw;
  const int bofs = 16384 + (wc * 64 + fr) * 64 + rsw;
  if (MI == 8) asm volatile("s_waitcnt vmcnt(8)" ::: "memory"); else asm volatile("s_waitcnt vmcnt(6)" ::: "memory");
  __builtin_amdgcn_s_barrier();
  if (wid >= 4) __builtin_amdgcn_s_barrier();
  int scur = 0, snxt = 3;
  for (int kt = 0; kt < nk; ++kt) {
    const char* st = g_smem + scur * 32768;
    bf16x8 af[MI], bfr[4];
#pragma unroll
    for (int mi = 0; mi < MI; ++mi) af[mi] = *(const bf16x8*)(st + aofs + mi * 1024);
#pragma unroll
    for (int ni = 0; ni < 4; ++ni) bfr[ni] = *(const bf16x8*)(st + bofs + ni * 1024);
    if (kt + 3 < nk) { GLDS_ISSUE(snxt); if (MI == 8) asm volatile("s_waitcnt vmcnt(8) lgkmcnt(0)" ::: "memory"); else asm volatile("s_waitcnt vmcnt(6) lgkmcnt(0)" ::: "memory"); }
    else if (kt + 2 < nk) { if (MI == 8) asm volatile("s_waitcnt vmcnt(4) lgkmcnt(0)" ::: "memory"); else asm volatile("s_waitcnt vmcnt(3) lgkmcnt(0)" ::: "memory"); }
    else asm volatile("s_waitcnt vmcnt(0) lgkmcnt(0)" ::: "memory");
    __builtin_amdgcn_sched_barrier(0);
    __builtin_amdgcn_s_barrier();
    __builtin_amdgcn_sched_barrier(0);
#pragma unroll
    for (int mi = 0; mi < MI; ++mi)
#pragma unroll
      for (int ni = 0; ni < 4; ++ni)
        acc[mi][ni] = TRANS ? MFMA16(bfr[ni], af[mi], acc[mi][ni]) : MFMA16(af[mi], bfr[ni], acc[mi][ni]);
    __builtin_amdgcn_sched_barrier(0);
    __builtin_amdgcn_s_barrier();
    __builtin_amdgcn_sched_barrier(0);
    scur = (scur + 1) & 3;
    snxt = (snxt + 1) & 3;
  }
  if (wid < 4) __builtin_amdgcn_s_barrier();
#undef GLDS_ISSUE
}

DI void transpose_tile(const float* src, int ldn, bf16_t* dst, int ldk, int k0, int n0, int slab_rows = 0) {
  float* t = (float*)HSM;
  const int tid = half_tid();
  __syncthreads();
  f32x4 v[8];
#pragma unroll
  for (int i = 0; i < 8; ++i) {
    const int idx = tid + i * 256, r = idx >> 5, c4 = (idx & 31) * 4;
    v[i] = *(const f32x4*)(src + (size_t)(k0 + r) * ldn + n0 + c4);
  }
#pragma unroll
  for (int i = 0; i < 8; ++i) {
    const int idx = tid + i * 256, r = idx >> 5, c4 = (idx & 31) * 4;
    t[r * 129 + c4 + 0] = v[i][0]; t[r * 129 + c4 + 1] = v[i][1]; t[r * 129 + c4 + 2] = v[i][2]; t[r * 129 + c4 + 3] = v[i][3];
  }
  __syncthreads();
#pragma unroll
  for (int i = 0; i < 4; ++i) {
    const int idx = tid + i * 256, n = idx >> 3, kc = (idx & 7) * 8;
    u32x4 o;
    o[0] = pack_bf16(t[(kc + 0) * 129 + n], t[(kc + 1) * 129 + n]);
    o[1] = pack_bf16(t[(kc + 2) * 129 + n], t[(kc + 3) * 129 + n]);
    o[2] = pack_bf16(t[(kc + 4) * 129 + n], t[(kc + 5) * 129 + n]);
    o[3] = pack_bf16(t[(kc + 6) * 129 + n], t[(kc + 7) * 129 + n]);
    if (slab_rows) *(u32x4*)(dst + slab_idx(n0 + n, k0 + kc, slab_rows)) = o;
    else *(u32x4*)(dst + (size_t)(n0 + n) * ldk + k0 + kc) = o;
  }
}

DI void mod_item(const Params& p, int it) {
  const int tid = half_tid();
  const int l = it / 192, r = it % 192, kc = r / 6, cb = r % 6;
  float* sl = (float*)HSM;
  __syncthreads();
  for (int idx = tid; idx < 576; idx += 256) {
    const int j = idx >> 6, k = idx & 63;
    const float* src = (j == 0) ? p.c_ctx : p.c + (j - 1) * 2048;
    sl[idx] = silu_f(src[kc * 64 + k]);
  }
  __syncthreads();
  const int col = cb * 1024 + tid * 4;
  f32x4 acc[9];
#pragma unroll
  for (int j = 0; j < 9; ++j) acc[j] = (f32x4){0.f, 0.f, 0.f, 0.f};
  const float* w = p.w_mod + ((size_t)l * 2048 + kc * 64) * 6144 + col;
#pragma unroll 4
  for (int k = 0; k < 64; ++k) {
    const f32x4 wv = *(const f32x4*)(w + (size_t)k * 6144);
#pragma unroll
    for (int j = 0; j < 9; ++j) acc[j] += wv * sl[j * 64 + k];
  }
  float* part = p.out + (size_t)(kc * 18 + l * 9) * 6144 + col;
#pragma unroll
  for (int j = 0; j < 9; ++j) *(f32x4*)(part + (size_t)j * 6144) = acc[j];
}

DI void mod_reduce(const Params& p) {
  float* modv = (float*)(p.ws + OFF_MODV);
  for (int e = (blockIdx.x * 512 + opaque_tid()) * 4; e < 18 * 6144; e += gridDim.x * 512 * 4) {
    const int lj = e / 6144, col = e - lj * 6144, l = lj / 9;
    f32x4 a = *(const f32x4*)(p.b_mod + l * 6144 + col);
#pragma unroll 8
    for (int kc = 0; kc < 32; ++kc) a += *(const f32x4*)(p.out + (size_t)kc * 18 * 6144 + e);
    *(f32x4*)(modv + e) = a;
  }
}

DI void fourier_fold_item(const Params& p, int it) {
  const int tid = half_tid();
  const int l = it >> 10, r = it & 1023, k = r >> 1, nb = r & 1;
  const int g = k >> 7, c = k & 127, n = nb * 256 + tid;
  float* tab = (float*)HSM;
  __syncthreads();
  if (tid < 128) { const float rev = (float)tid * (1.f / 128.f); tab[tid] = __builtin_amdgcn_cosf(rev); tab[128 + tid] = __builtin_amdgcn_sinf(rev); }
  __syncthreads();
  const float* w = p.w_fourier + ((size_t)(l * 512 + g * 128)) * 512 + n;
  float ac = 0.f, as = 0.f;
#pragma unroll 16
  for (int j = 0; j < 128; ++j) { const float wv = w[(size_t)j * 512]; const int ti = (c * j) & 127; ac += tab[ti] * wv; as += tab[128 + ti] * wv; }
  bf16_t* dst = (bf16_t*)(p.ws + OFF_WCST);
  dst[((size_t)(l * 1024 + n)) * 512 + k] = (bf16_t)(pack_bf16(ac * 0.08838834764831845f, 0.f) & 0xffffu);
  dst[((size_t)(l * 1024 + 512 + n)) * 512 + k] = (bf16_t)(pack_bf16(as * 0.08838834764831845f, 0.f) & 0xffffu);
}

DI void phase0(const Params& p) {
  const int tid = half_tid();
  constexpr int N_MOD = 384, N_WIN = 2816, N_WOUT = 1024, N_WPW = 64, N_WPOOL = 128, N_CV = 256, N_CK = 1024, N_DCTX = 64, N_DDEC = 1024, N_ROPE = 2, N_FF = 2048, N_SM = 24;
  constexpr int E0 = N_MOD, E1 = E0 + N_WIN, E2 = E1 + N_WOUT, E3 = E2 + N_WPW, E4 = E3 + N_WPOOL, E5 = E4 + N_CV, E6 = E5 + N_CK, E7 = E6 + N_DCTX,
                E8 = E7 + N_DDEC, E9 = E8 + N_ROPE, E10 = E9 + N_FF, E11 = E10 + N_SM;
  for (int itp = blockIdx.x; itp < E11 / 2; itp += gridDim.x) {
    const int it = itp * 2 + half_id();
    if (it < E0) {
      mod_item(p, it);
    } else if (it < E1) {
      const int t = it - E0, l = t / 1408, r = t % 1408, kt = r / 44, nt = r % 44;
      transpose_tile(p.w_in + (size_t)l * 2048 * 5632, 5632, (bf16_t*)(p.ws + OFF_WINT) + (size_t)l * 5632 * 2048, 2048, kt * 64, nt * 128, 5632);
    } else if (it < E2) {
      const int t = it - E1, l = t >> 9, r = t & 511, kt = r >> 4, nt = r & 15;
      transpose_tile(p.w_out + (size_t)l * 2048 * 2048, 2048, (bf16_t*)(p.ws + OFF_WOUTT) + (size_t)l * 2048 * 2048, 2048, kt * 64, nt * 128, 2048);
    } else if (it < E3) {
      const int t = it - E2, l = t >> 5, r = t & 31, kt = r >> 2, nt = r & 3;
      transpose_tile(p.w_conv_pw + (size_t)l * 512 * 512, 512, (bf16_t*)(p.ws + OFF_WPWT) + (size_t)l * 512 * 512, 512, kt * 64, nt * 128);
    } else if (it < E4) {
      const int t = it - E3, lp = t >> 5;
      const int e0 = (t & 31) * 2048 + tid * 8, n = e0 >> 8, k0 = e0 & 255;
      const int g = (lp & 1) * 2 + (n >> 7);
      u32x4 o = (u32x4){0u, 0u, 0u, 0u};
      if ((k0 >> 7) == (n >> 7)) {
        const float* w = p.w_pool + ((size_t)((lp >> 1) * 4 + g) * 128 + (k0 & 127)) * 128 + (n & 127);
#pragma unroll
        for (int e = 0; e < 4; ++e) o[e] = pack_bf16(w[(size_t)(2 * e) * 128], w[(size_t)(2 * e + 1) * 128]);
      }
      *(u32x4*)((bf16_t*)(p.ws + OFF_WPOOLT) + (size_t)lp * 65536 + e0) = o;
    } else if (it < E5) {
      const int t = it - E4, blh = t >> 2, kt = t & 3;
      transpose_tile(p.cache_v + (size_t)blh * 256 * 128, 128, (bf16_t*)(p.ws + OFF_VTC) + (size_t)blh * 128 * 256, 256, kt * 64, 0);
    } else if (it < E6) {
      const size_t e = (size_t)(it - E5) * 2048 + tid * 8;
      const f32x4 a = *(const f32x4*)(p.cache_k + e), b = *(const f32x4*)(p.cache_k + e + 4);
      u32x4 o; o[0] = pack_bf16(a[0], a[1]); o[1] = pack_bf16(a[2], a[3]); o[2] = pack_bf16(b[0], b[1]); o[3] = pack_bf16(b[2], b[3]);
      *(u32x4*)((bf16_t*)(p.ws + OFF_KC) + e) = o;
    } else if (it < E8) {
      const bool dec = it >= E7;
      const int e0 = (dec ? it - E7 : it - E6) * 2048 + tid * 8;
      const int S = dec ? 1024 : 256, sh = dec ? 11 : 9;
      const float nrm = dec ? 0.03125f : 0.0625f, invS = dec ? (1.f / 1024.f) : (1.f / 256.f);
      float v[8];
#pragma unroll
      for (int i = 0; i < 8; ++i) {
        const int e = e0 + i, t = e & (2 * S - 1);
        const int s = e >> sh;
        const int tt = t & (S - 1);
        const float rev = (float)((s * tt) & (S - 1)) * invS;
        v[i] = (t < S) ? __builtin_amdgcn_cosf(rev) * nrm : -__builtin_amdgcn_sinf(rev) * nrm;
      }
      u32x4 o; o[0] = pack_bf16(v[0], v[1]); o[1] = pack_bf16(v[2], v[3]); o[2] = pack_bf16(v[4], v[5]); o[3] = pack_bf16(v[6], v[7]);
      *(u32x4*)((bf16_t*)(p.ws + (dec ? OFF_DDEC : OFF_DCTX)) + (size_t)(e0 >> sh) * (dec ? LDD : LDC) + (e0 & (2 * S - 1))) = o;
    } else if (it < E9) {
      f32x2* rope = (f32x2*)(p.ws + OFF_ROPE);
#pragma unroll
      for (int i = 0; i < 4; ++i) {
        const int idx = tid + i * 256, pos = idx >> 4, f = idx & 15;
        const float inv = exp2f(-(float)f * (13.287712379549449f / 16.f));
        const float ang = (float)pos * inv;
        float rev = ang * 0.15915494309189535f;
        rev -= floorf(rev);
        f32x2 cs; cs.x = __builtin_amdgcn_cosf(rev); cs.y = __builtin_amdgcn_sinf(rev);
        rope[idx] = cs;
      }
    } else if (it < E10) {
      fourier_fold_item(p, it - E9);
    } else {
      const int j = it - E10;
      const float* src; int n, off;
      if (j >= 4 && j < 20) { src = p.conv_dw + (j - 4) * 1984; n = 1984; off = SM_DW + (j - 4) * 1984; }
      else switch (j) {
        case 0: src = p.norm_g; n = 4096; off = SM_NORMG; break;
        case 1: src = p.pool_scale; n = 1024; off = SM_POOLSC; break;
        case 2: src = p.diff_lambda; n = 512; off = SM_DLAM; break;
        case 3: src = p.subln_g; n = 256; off = SM_SUBLN; break;
        case 20: src = p.conv_dw_b; n = 1024; off = SM_DWB; break;
        case 21: src = p.conv_ln_g; n = 1024; off = SM_LNG; break;
        case 22: src = p.conv_ln_b; n = 1024; off = SM_LNB; break;
        default: src = p.final_g; n = 2048; off = SM_FINALG; break;
      }
      float* dst = (float*)(p.ws + OFF_SMALL) + off;
#pragma unroll
      for (int i = 0; i < 4; ++i) { const int e = (tid + i * 256) * 4; if (e < n) *(f32x4*)(dst + e) = *(const f32x4*)(src + e); }
    }
  }
}

DI const float* x_row_l0(const Params& p, int m) { return (m < NCTX) ? p.x_prompt + (size_t)m * DM : p.x_sample + (size_t)(m - NCTX) * DM; }
DI int cvec_of_row(int m) { return (m < NCTX) ? 0 : 1 + ((m - NCTX) >> 10); }

DI void norm_phase(const Params& p, int l) {
  const int tid_ = opaque_tid(); const int lane = tid_ & 63, wid = tid_ >> 6;
  const int rr = lane >> 5, q = lane & 31;
  bf16_t* H = (bf16_t*)(p.ws + OFF_H);
  const float* modv = (const float*)(p.ws + OFF_MODV);
  const float* g = SMALLP(p, SM_NORMG) + l * DM;
  const int step = gridDim.x * 8;
  int mp = blockIdx.x * 8 + wid;
  f32x4 v[16], vn[16];
  auto load_pair = [&](int mpair, f32x4 (&d)[16]) {
    const int m = mpair * 2 + rr;
    const float* x = (l == 0) ? x_row_l0(p, m) : p.out + (size_t)m * DM;
#pragma unroll
    for (int i = 0; i < 8; ++i) { const int c = i * 256 + q * 8; d[2 * i] = *(const f32x4*)(x + c); d[2 * i + 1] = *(const f32x4*)(x + c + 4); }
  };
  if (mp < NTOK / 2) load_pair(mp, v);
  for (; mp < NTOK / 2; mp += step) {
    const bool more = (mp + step < NTOK / 2);
    if (more) load_pair(mp + step, vn);
    const int m = mp * 2 + rr;
    const float* mv = modv + (size_t)(l * 9 + cvec_of_row(m)) * 6144;
    float ss = 0.f;
#pragma unroll
    for (int i = 0; i < 16; ++i)
#pragma unroll
      for (int e = 0; e < 4; ++e) ss += v[i][e] * v[i][e];
#pragma unroll
    for (int o = 16; o >= 1; o >>= 1) ss += __shfl_xor(ss, o);
    const float rstd = rsqrtf(ss * (1.f / 2048.f) + EPS);
#pragma unroll
    for (int i = 0; i < 8; ++i) {
      const int c = i * 256 + q * 8;
      u32x4 o4;
#pragma unroll
      for (int hh = 0; hh < 2; ++hh) {
        const f32x4 gg = *(const f32x4*)(g + c + 4 * hh), sh = *(const f32x4*)(mv + c + 4 * hh), sc = *(const f32x4*)(mv + 2048 + c + 4 * hh);
        f32x4 h;
#pragma unroll
        for (int e = 0; e < 4; ++e) h[e] = v[2 * i + hh][e] * rstd * gg[e] * (1.f + sc[e]) + sh[e];
        o4[2 * hh] = pack_bf16(h[0], h[1]); o4[2 * hh + 1] = pack_bf16(h[2], h[3]);
      }
      *(u32x4*)(H + slab_idx(m, c, NTOK)) = o4;
    }
    if (more) {
#pragma unroll
      for (int i = 0; i < 16; ++i) v[i] = vn[i];
    }
  }
}

DI void final_phase(const Params& p) {
  const int tid_ = opaque_tid(); const int lane = tid_ & 63, wid = tid_ >> 6;
  const int step = gridDim.x * 8;
  int m = blockIdx.x * 8 + wid;
  f32x4 v[8], vn[8];
  if (m < NTOK) {
#pragma unroll
    for (int i = 0; i < 8; ++i) v[i] = *(const f32x4*)(p.out + (size_t)m * DM + (i * 64 + lane) * 4);
  }
  for (; m < NTOK; m += step) {
    const bool more = (m + step < NTOK);
    if (more) {
#pragma unroll
      for (int i = 0; i < 8; ++i) vn[i] = *(const f32x4*)(p.out + (size_t)(m + step) * DM + (i * 64 + lane) * 4);
    }
    float* x = p.out + (size_t)m * DM;
    float ss = 0.f;
#pragma unroll
    for (int i = 0; i < 8; ++i) ss += v[i][0] * v[i][0] + v[i][1] * v[i][1] + v[i][2] * v[i][2] + v[i][3] * v[i][3];
    ss = wave_sum(ss);
    const float rstd = rsqrtf(ss * (1.f / 2048.f) + EPS);
#pragma unroll
    for (int i = 0; i < 8; ++i) {
      const int c = (i * 64 + lane) * 4;
      const f32x4 gg = *(const f32x4*)(SMALLP(p, SM_FINALG) + c);
      f32x4 h;
#pragma unroll
      for (int e = 0; e < 4; ++e) h[e] = v[i][e] * rstd * gg[e];
      *(f32x4*)(x + c) = h;
    }
    if (more) {
#pragma unroll
      for (int i = 0; i < 8; ++i) v[i] = vn[i];
    }
  }
}

DI void g1_tile(const Params& p, int l, int t) {
  const int pm = t & 63, pn = t >> 6;
  const int tid = opaque_tid(), lane = tid & 63, wid = tid >> 6, wr = wid >> 2, wc = wid & 3, fr = lane & 15, fq = lane >> 4;
  const bf16_t* A = (const bf16_t*)(p.ws + OFF_H) + (size_t)pm * 256 * 32;
  const bf16_t* B = (const bf16_t*)(p.ws + OFF_WINT) + (size_t)l * 5632 * 2048 + (size_t)pn * 256 * 32;
  bf16_t* P = (bf16_t*)(p.ws + OFF_P);
  const int m0 = pm * 256, n0 = pn * 256;
  const int nw = n0 + wc * 64;
  const bool dec = m0 >= NCTX;
  f32x4 acc[8][4];
  if (pn == 12 || pn == 13) {
    gemm_main<false, false>(A, 32, (size_t)NTOK * 32, B, 32, (size_t)5632 * 32, DM, acc);
    const int vc = nw - 3072, h = vc >> 7;
    bf16_t* vtn = (bf16_t*)(p.ws + OFF_VTN);
    int S, s0; size_t vbase; int b;
    if (!dec) { b = m0 >> 8; S = 256; s0 = 0; vbase = (size_t)b * 131072; }
    else { const int dm = m0 - NCTX; b = dm >> 10; S = 1024; s0 = dm & 1023; vbase = (size_t)32 * 131072 + (size_t)b * 524288; }
    float* ncv = p.out + 41943040ull + ((size_t)((b * 2 + l) * 4 + h)) * 32768;
#pragma unroll
    for (int mi = 0; mi < 8; ++mi)
#pragma unroll
      for (int ni = 0; ni < 4; ++ni) {
        const int s = s0 + wr * 128 + mi * 16 + 4 * fq, dv = (vc & 127) + ni * 16 + fr;
        *(u32x2*)(vtn + vbase + (size_t)(h * 128 + dv) * S + s) = pack4(acc[mi][ni]);
        if (!dec) {
#pragma unroll
          for (int j = 0; j < 4; ++j) ncv[(size_t)(s + j) * 128 + dv] = acc[mi][ni][j];
        }
      }
  } else {
    const int chunk = pn >> 1;
    if (dec && (chunk == 4 || chunk == 5)) {
      gemm_main<true, false>(A, 32, (size_t)NTOK * 32, B, 32, (size_t)5632 * 32, DM, acc);
      const f32x4* rope = (const f32x4*)(p.ws + OFF_ROPE);
#pragma unroll
      for (int mi = 0; mi < 8; ++mi) {
        const int s = (m0 - NCTX + wr * 128 + mi * 16 + fr) & 1023;
        const int prow = s >> 6, pcol = s & 63;
#pragma unroll
        for (int ax = 0; ax < 2; ++ax) {
          const int pos = ax ? pcol : prow;
          const f32x4 t0 = rope[pos * 8 + fq * 2], t1 = rope[pos * 8 + fq * 2 + 1];
          const float cs[4] = {t0[0], t0[2], t1[0], t1[2]}, sn[4] = {t0[1], t0[3], t1[1], t1[3]};
#pragma unroll
          for (int j = 0; j < 4; ++j) {
            const float x1 = acc[mi][ax * 2][j], x2 = acc[mi][ax * 2 + 1][j];
            acc[mi][ax * 2][j] = x1 * cs[j] - x2 * sn[j];
            acc[mi][ax * 2 + 1][j] = x2 * cs[j] + x1 * sn[j];
          }
        }
      }
      const int pc0 = nw + 4 * fq;
#pragma unroll
      for (int mi = 0; mi < 8; ++mi) {
        const int m = m0 + wr * 128 + mi * 16 + fr;
#pragma unroll
        for (int ni = 0; ni < 4; ++ni) *(u32x2*)(P + (size_t)m * LDP + pc0 + ni * 16) = pack4(acc[mi][ni]);
      }
    } else {
      gemm_main<true, true>(A, 32, (size_t)NTOK * 32, B, 32, (size_t)5632 * 32, DM, acc);
      const int pc0 = (nw < 3072 ? nw : nw - 512) + 8 * fq;
#pragma unroll
      for (int mi = 0; mi < 8; ++mi) {
        const int m = m0 + wr * 128 + mi * 16 + fr;
#pragma unroll
        for (int q = 0; q < 2; ++q) {
          u32x4 o; const u32x2 a = pack4(acc[mi][2 * q]), b = pack4(acc[mi][2 * q + 1]);
          o[0] = a.x; o[1] = a.y; o[2] = b.x; o[3] = b.y;
          *(u32x4*)(P + (size_t)m * LDP + pc0 + q * 32) = o;
        }
      }
      if (!dec && chunk == 5) {
        const int kc = nw - 2560, h = kc >> 7;
        const int b = m0 >> 8;
        float* nck = p.out + 33554432ull + ((size_t)((b * 2 + l) * 4 + h)) * 32768;
#pragma unroll
        for (int mi = 0; mi < 8; ++mi) {
          const int s = wr * 128 + mi * 16 + fr;
#pragma unroll
          for (int q = 0; q < 2; ++q) {
            float* dst = nck + (size_t)s * 128 + (kc & 127) + q * 32 + 8 * fq;
            *(f32x4*)dst = acc[mi][2 * q]; *(f32x4*)(dst + 4) = acc[mi][2 * q + 1];
          }
        }
      }
    }
  }
}

DI void g1_half_tile(const Params& p, int l, int ht) {
  const int t = 1280 + (ht >> 1), pm = t & 63, pn = t >> 6;
  const int tid = opaque_tid(), lane = tid & 63, wid = tid >> 6, wr = wid >> 2, wc = wid & 3, fr = lane & 15, fq = lane >> 4;
  const int m0 = pm * 256 + (ht & 1) * 128, nw = pn * 256 + wc * 64;
  const bf16_t* A = (const bf16_t*)(p.ws + OFF_H) + (size_t)m0 * 32;
  const bf16_t* B = (const bf16_t*)(p.ws + OFF_WINT) + (size_t)l * 5632 * 2048 + (size_t)pn * 256 * 32;
  bf16_t* P = (bf16_t*)(p.ws + OFF_P);
  f32x4 acc[4][4];
  gemm_main<true, true, 4>(A, 32, (size_t)NTOK * 32, B, 32, (size_t)5632 * 32, DM, acc);
  const int pc0 = (nw - 512) + 8 * fq;
#pragma unroll
  for (int mi = 0; mi < 4; ++mi) {
    const int m = m0 + wr * 64 + mi * 16 + fr;
#pragma unroll
    for (int q = 0; q < 2; ++q) {
      u32x4 o; const u32x2 a = pack4(acc[mi][2 * q]), b = pack4(acc[mi][2 * q + 1]);
      o[0] = a.x; o[1] = a.y; o[2] = b.x; o[3] = b.y;
      *(u32x4*)(P + (size_t)m * LDP + pc0 + q * 32) = o;
    }
  }
}

template <int MI = 8>
DI void gated_gemm_tile(const Params& p, const bf16_t* A, int lda, const bf16_t* B, int ldb, int K, int tok0, int ncol0, int gcol, int ycol, const float* colscale) {
  const int tid = opaque_tid(), lane = tid & 63, wid = tid >> 6, wr = wid >> 2, wc = wid & 3, fr = lane & 15, fq = lane >> 4;
  f32x4 acc[MI][4];
  gemm_main<true, true, MI>(A, lda, 32, B, ldb, 32, K, acc);
  const bf16_t* P = (const bf16_t*)(p.ws + OFF_P);
  bf16_t* Y = (bf16_t*)(p.ws + OFF_H);
#pragma unroll
  for (int q = 0; q < 2; ++q) {
    const int n = ncol0 + wc * 64 + q * 32 + 8 * fq;
    f32x4 cs0 = (f32x4){1.f, 1.f, 1.f, 1.f}, cs1 = cs0;
    if (colscale) { cs0 = *(const f32x4*)(colscale + n); cs1 = *(const f32x4*)(colscale + n + 4); }
#pragma unroll
    for (int mi = 0; mi < MI; ++mi) {
      const int tok = tok0 + wr * (MI * 16) + mi * 16 + fr;
      const u32x4 gw = *(const u32x4*)(P + (size_t)tok * LDP + gcol + n);
      const f32x4 a0 = acc[mi][2 * q], a1 = acc[mi][2 * q + 1];
      u32x4 o;
      o[0] = pack_bf16(a0[0] * cs0[0] * silu_f(bflo(gw[0])), a0[1] * cs0[1] * silu_f(bfhi(gw[0])));
      o[1] = pack_bf16(a0[2] * cs0[2] * silu_f(bflo(gw[1])), a0[3] * cs0[3] * silu_f(bfhi(gw[1])));
      o[2] = pack_bf16(a1[0] * cs1[0] * silu_f(bflo(gw[2])), a1[1] * cs1[1] * silu_f(bfhi(gw[2])));
      o[3] = pack_bf16(a1[2] * cs1[2] * silu_f(bflo(gw[3])), a1[3] * cs1[3] * silu_f(bfhi(gw[3])));
      *(u32x4*)(Y + slab_idx(tok, ycol + n, NTOK)) = o;
    }
  }
}

DI void z_tile(const Params& p, int l, int t) {
  const int pm = t & 63, pn = t >> 6;
  const int tid = opaque_tid(), lane = tid & 63, wid = tid >> 6, wr = wid >> 2, wc = wid & 3, fr = lane & 15, fq = lane >> 4;
  const bf16_t* A = (const bf16_t*)(p.ws + OFF_P) + (size_t)pm * 256 * LDP + PC_FX;
  const bf16_t* B = (const bf16_t*)(p.ws + OFF_WCST) + ((size_t)l * 1024 + pn * 256) * 512;
  f32x4 acc[8][4];
  gemm_main<false, false>(A, LDP, 32, B, 512, 32, 512, acc);
  bf16_t* ZT = (bf16_t*)(p.ws + OFF_ZT);
  const int m0 = pm * 256;
  int S, t0; size_t base;
  if (m0 < NCTX) { S = 256; t0 = 0; base = (size_t)(m0 >> 8) * 262144; }
  else { const int dm = m0 - NCTX; S = 1024; t0 = dm & 1023; base = 32ull * 262144 + (size_t)(dm >> 10) * 512 * LDZ; }
#pragma unroll
  for (int ni = 0; ni < 4; ++ni) {
    const int np = pn * 256 + wc * 64 + ni * 16 + fr, n = np & 511, half = np >> 9;
    bf16_t* row = ZT + base + (size_t)n * (S == 256 ? 512 : LDZ) + half * S + t0;
#pragma unroll
    for (int mi = 0; mi < 8; ++mi) *(u32x2*)(row + wr * 128 + mi * 16 + 4 * fq) = pack4(acc[mi][ni]);
  }
}

DI void out_tile(const Params& p, int l, int t) {
  const int pm = t & 63, pn = t >> 6;
  const int tid = opaque_tid(), lane = tid & 63, wid = tid >> 6, wr = wid >> 2, wc = wid & 3, fr = lane & 15, fq = lane >> 4;
  const bf16_t* A = (const bf16_t*)(p.ws + OFF_H) + (size_t)pm * 256 * 32;
  const bf16_t* B = (const bf16_t*)(p.ws + OFF_WOUTT) + (size_t)l * 2048 * 2048 + (size_t)pn * 256 * 32;
  f32x4 acc[8][4];
  gemm_main<true, true>(A, 32, (size_t)NTOK * 32, B, 32, (size_t)2048 * 32, DM, acc);
  const int m0 = pm * 256;
  const float* gate = (const float*)(p.ws + OFF_MODV) + (size_t)(l * 9 + cvec_of_row(m0)) * 6144 + 4096;
#pragma unroll
  for (int q = 0; q < 2; ++q) {
    const int n = pn * 256 + wc * 64 + q * 32 + 8 * fq;
    const f32x4 g0 = *(const f32x4*)(gate + n), g1 = *(const f32x4*)(gate + n + 4);
#pragma unroll
    for (int mi = 0; mi < 8; ++mi) {
      const int m = m0 + wr * 128 + mi * 16 + fr;
      const float* xin = ((l == 0) ? x_row_l0(p, m) : p.out + (size_t)m * DM) + n;
      const f32x4 x0 = *(const f32x4*)(xin), x1 = *(const f32x4*)(xin + 4);
      float* dst = p.out + (size_t)m * DM + n;
      *(f32x4*)dst = x0 + g0 * acc[mi][2 * q];
      *(f32x4*)(dst + 4) = x1 + g1 * acc[mi][2 * q + 1];
    }
  }
}

DI void seq_of_tok(int tok0, int& S, int& sbase) {
  if (tok0 < NCTX) { S = 256; sbase = tok0 & ~255; } else { S = 1024; sbase = NCTX + ((tok0 - NCTX) & ~1023); }
}

template <int W>
DI void pool_task(const bf16_t* base, int S, int sA, bf16_t* outp) {
  constexpr int HW = W / 2, NR = 7 + W;
  u32x4 rows[NR];
#pragma unroll
  for (int r = 0; r < NR; ++r) {
    const int s = sA - HW + r;
    const bool ok = (s >= 0) && (s < S);
    const u32x4 v = *(const u32x4*)(base + (size_t)min(max(s, 0), S - 1) * LDP);
#pragma unroll
    for (int e = 0; e < 4; ++e) rows[r][e] = ok ? v[e] : 0u;
  }
  float sum[8];
#pragma unroll
  for (int e = 0; e < 8; ++e) sum[e] = 0.f;
#pragma unroll
  for (int r = 0; r < W; ++r)
#pragma unroll
    for (int e = 0; e < 4; ++e) { sum[2 * e] += bflo(rows[r][e]); sum[2 * e + 1] += bfhi(rows[r][e]); }
#pragma unroll
  for (int k = 0; k < 8; ++k) {
    const int s = sA + k;
    const int lo = max(s - HW, 0), hi = min(s - HW + W, S);
    const float inv = 1.f / (float)(hi - lo);
    const u32x4 xv = rows[k + HW];
    u32x4 o4;
#pragma unroll
    for (int e = 0; e < 4; ++e) o4[e] = pack_bf16(sum[2 * e] * inv - bflo(xv[e]), sum[2 * e + 1] * inv - bfhi(xv[e]));
    *(u32x4*)(outp + (size_t)k * 512) = o4;
    if (k < 7) {
#pragma unroll
      for (int e = 0; e < 4; ++e) {
        sum[2 * e] += bflo(rows[k + W][e]) - bflo(rows[k][e]);
        sum[2 * e + 1] += bfhi(rows[k + W][e]) - bfhi(rows[k][e]);
      }
    }
  }
}

DI void pool_item(const Params& p, int t) {
  const int tid = half_tid(), tok0 = t * 32;
  int S, sbase; seq_of_tok(tok0, S, sbase);
  const int g = tid >> 6, run = (tid >> 4) & 3, c0 = g * 128 + (tid & 15) * 8;
  const int sA = tok0 - sbase + run * 8;
  const bf16_t* base = (const bf16_t*)(p.ws + OFF_P) + (size_t)sbase * LDP + PC_PX + c0;
  bf16_t* outp = (bf16_t*)(p.ws + OFF_POOLED) + (size_t)(sbase + sA) * 512 + c0;
  if (g == 0) pool_task<2>(base, S, sA, outp);
  else if (g == 1) pool_task<4>(base, S, sA, outp);
  else if (g == 2) pool_task<8>(base, S, sA, outp);
  else pool_task<16>(base, S, sA, outp);
}

DI void conv_item(const Params& p, int l, int t) {
  const int tid = half_tid(), lane = tid & 63, wid = tid >> 6, tok0 = t * 32;
  int S, sbase; seq_of_tok(tok0, S, sbase);
  const int s0 = tok0 - sbase;
  const bf16_t* P = (const bf16_t*)(p.ws + OFF_P);
  bf16_t* U = (bf16_t*)HSM;
  float* red = (float*)(HSM + 63488);
#pragma unroll 4
  for (int idx = tid; idx < 62 * 64; idx += 256) {
    const int rr = idx >> 6, ch = (idx & 63) * 8, s = s0 - 15 + rr;
    const bool ok = (s >= 0) && (s < S);
    const int sc = min(max(s, 0), S - 1);
    const bf16_t* row = P + (size_t)(sbase + sc) * LDP;
    const u32x4 a = *(const u32x4*)(row + PC_CA + ch), b = *(const u32x4*)(row + PC_CB + ch);
    u32x4 o;
#pragma unroll
    for (int e = 0; e < 4; ++e) { const unsigned v = pack_bf16(bflo(a[e]) * sigmoid_f(bflo(b[e])), bfhi(a[e]) * sigmoid_f(bfhi(b[e]))); o[e] = ok ? v : 0u; }
    *(u32x4*)(U + rr * 512 + ch) = o;
  }
  __syncthreads();
  const int c2 = tid * 2;
  float y0[32], y1[32];
  {
    const f32x2 bb = *(const f32x2*)(SMALLP(p, SM_DWB) + l * 512 + c2);
#pragma unroll
    for (int i = 0; i < 32; ++i) { y0[i] = bb.x; y1[i] = bb.y; }
  }
  const float* dw = SMALLP(p, SM_DW) + (size_t)l * 31 * 512 + c2;
  f32x2 wn = *(const f32x2*)dw;
#pragma unroll 1
  for (int j = 0; j < 31; ++j) {
    const f32x2 w = wn;
    if (j + 1 < 31) wn = *(const f32x2*)(dw + (j + 1) * 512);
    const unsigned wpk = pack_bf16(w.x, w.y), wlo = wpk & 0xffffu, whi = wpk & 0xffff0000u;
    const bf16_t* up = U + j * 512 + c2;
#pragma unroll
    for (int i = 0; i < 32; ++i) {
      const unsigned u = *(const unsigned*)(up + i * 512);
      y0[i] = dot2bf(u, wlo, y0[i]); y1[i] = dot2bf(u, whi, y1[i]);
    }
  }
#pragma unroll
  for (int i = 0; i < 32; ++i) {
    const float s1 = wave_sum_dpp(y0[i] + y1[i]);
    const float s2 = wave_sum_dpp(y0[i] * y0[i] + y1[i] * y1[i]);
    if (lane == 0) { red[(wid * 32 + i) * 2] = s1; red[(wid * 32 + i) * 2 + 1] = s2; }
  }
  __syncthreads();
  const f32x2 lg = *(const f32x2*)(SMALLP(p, SM_LNG) + l * 512 + c2), lb = *(const f32x2*)(SMALLP(p, SM_LNB) + l * 512 + c2);
  bf16_t* out = (bf16_t*)(p.ws + OFF_CONVACT);
#pragma unroll
  for (int i = 0; i < 32; ++i) {
    float s1 = 0.f, s2 = 0.f;
#pragma unroll
    for (int w = 0; w < 4; ++w) { s1 += red[(w * 32 + i) * 2]; s2 += red[(w * 32 + i) * 2 + 1]; }
    const float mean = s1 * (1.f / 512.f), var = s2 * (1.f / 512.f) - mean * mean, rstd = rsqrtf(var + EPS);
    const float a0 = silu_f((y0[i] - mean) * rstd * lg.x + lb.x), a1 = silu_f((y1[i] - mean) * rstd * lg.y + lb.y);
    *(unsigned*)(out + (size_t)(tok0 + i) * 512 + c2) = pack_bf16(a0, a1);
  }
}

DI void attn_item(const Params& p, int l, bool dec, int b, int h, int qt) {
  const int tid = half_tid(), lane = tid & 63, wid = tid >> 6, fr = lane & 15, fq = lane >> 4;
  const int S = dec ? 1024 : 256;
  const int tok0 = dec ? NCTX + b * 1024 : b * 256;
  const int nkt = dec ? 20 : 4, ncache = dec ? 4 : 0;
  const bf16_t* P = (const bf16_t*)(p.ws + OFF_P);
  const float lam_init = (l == 0) ? 0.2f : 0.35550906f;
  float lam;
  {
    const float* dl = SMALLP(p, SM_DLAM) + l * 256;
    const float a = wave_sum(dl[lane] * dl[64 + lane]), c = wave_sum(dl[128 + lane] * dl[192 + lane]);
    lam = __expf(a) - __expf(c) + lam_init;
  }
  const int q0 = qt * 64 + wid * 16;
  bf16x8 qf[2][2];
  {
    const bf16_t* qrow = P + (size_t)(tok0 + q0 + fr) * LDP + PC_Q + h * 128;
#pragma unroll
    for (int m = 0; m < 2; ++m)
#pragma unroll
      for (int ks = 0; ks < 2; ++ks) qf[m][ks] = *(const bf16x8*)(qrow + m * 64 + ks * 32 + fq * 8);
  }
  const size_t blh = (size_t)((b * 2 + l) * 4 + h);
  const bf16_t* kc = (const bf16_t*)(p.ws + OFF_KC) + blh * 32768;
  const bf16_t* vtc = (const bf16_t*)(p.ws + OFF_VTC) + blh * 32768;
  const bf16_t* kn = P + (size_t)tok0 * LDP + PC_K + h * 128;
  const bf16_t* vtn = (const bf16_t*)(p.ws + OFF_VTN) + (dec ? (size_t)32 * 131072 + (size_t)b * 524288 : (size_t)b * 131072) + (size_t)h * 128 * S;
  char* hb = HSM;
  const int kkey = lane >> 4, kpc = lane & 15;
  const int vrow = lane >> 3, vpc = lane & 7;
  auto issue_tile = [&](int kt, int buf) {
    char* kb = hb + buf * 32768 + lane * 16;
    const bf16_t* ksrc; size_t kstride; const bf16_t* vsrc; size_t vstride;
    if (kt < ncache) { ksrc = kc + (size_t)(kt * 64) * 128; kstride = 128; vsrc = vtc + kt * 64; vstride = 256; }
    else { const int kk = (kt - ncache) * 64; ksrc = kn + (size_t)kk * LDP; kstride = LDP; vsrc = vtn + kk; vstride = S; }
#pragma unroll
    for (int i = 0; i < 4; ++i) {
      const int pi = wid + 4 * i;
      const int key = pi * 4 + kkey;
      __builtin_amdgcn_global_load_lds((const unsigned*)(ksrc + (size_t)key * kstride + ((kpc ^ (key & 15)) * 8)), (LDSP)(kb + pi * 1024), 16, 0, 0);
    }
#pragma unroll
    for (int i = 0; i < 4; ++i) {
      const int pi = wid + 4 * i;
      const int dv = pi * 8 + vrow;
      __builtin_amdgcn_global_load_lds((const unsigned*)(vsrc + (size_t)dv * vstride + ((vpc ^ ((dv >> 1) & 7)) * 8)), (LDSP)(kb + 16384 + pi * 1024), 16, 0, 0);
    }
  };
  float m_run[2] = {-INFINITY, -INFINITY}, l_run[2] = {0.f, 0.f};
  f32x4 O[2][8];
#pragma unroll
  for (int m = 0; m < 2; ++m)
#pragma unroll
    for (int d = 0; d < 8; ++d) O[m][d] = (f32x4){0.f, 0.f, 0.f, 0.f};
  const float cexp = 0.125f * 1.4426950408889634f;
  const int vsw = (fr >> 1) & 7;
  issue_tile(0, 0);
#pragma unroll 1
  for (int kt = 0; kt < nkt; ++kt) {
    asm volatile("s_waitcnt vmcnt(0)" ::: "memory");
    __syncthreads();
    if (kt + 1 < nkt) issue_tile(kt + 1, (kt + 1) & 1);
    const char* Ks = hb + (kt & 1) * 32768;
    const char* Vs = Ks + 16384;
    bf16x8 pf[2][2];
#pragma unroll
    for (int m = 0; m < 2; ++m) {
      f32x4 s[4];
#pragma unroll
      for (int ksub = 0; ksub < 4; ++ksub) {
        f32x4 a = (f32x4){0.f, 0.f, 0.f, 0.f};
#pragma unroll
        for (int ks = 0; ks < 2; ++ks) {
          const bf16x8 kf = *(const bf16x8*)(Ks + (ksub * 16 + fr) * 256 + (((m * 8 + ks * 4 + fq) ^ fr) * 16));
          a = MFMA16(kf, qf[m][ks], a);
        }
        s[ksub] = a;
      }
      float mx = s[0][0];
#pragma unroll
      for (int ksub = 0; ksub < 4; ++ksub)
#pragma unroll
        for (int j = 0; j < 4; ++j) mx = fmaxf(mx, s[ksub][j]);
      mx = xrow_max(mx);
      const float mn = fmaxf(m_run[m], mx);
      const float alpha = __builtin_amdgcn_exp2f((m_run[m] - mn) * cexp);
      m_run[m] = mn;
      float ls = 0.f;
#pragma unroll
      for (int ksub = 0; ksub < 4; ++ksub)
#pragma unroll
        for (int j = 0; j < 4; ++j) { const float e = __builtin_amdgcn_exp2f((s[ksub][j] - mn) * cexp); s[ksub][j] = e; ls += e; }
      l_run[m] = l_run[m] * alpha + ls;
      if (__any(alpha != 1.f)) {
#pragma unroll
        for (int d = 0; d < 8; ++d) O[m][d] *= alpha;
      }
#pragma unroll
      for (int k2 = 0; k2 < 2; ++k2) {
        u32x4 w;
        w[0] = pack_bf16(s[2 * k2][0], s[2 * k2][1]); w[1] = pack_bf16(s[2 * k2][2], s[2 * k2][3]);
        w[2] = pack_bf16(s[2 * k2 + 1][0], s[2 * k2 + 1][1]); w[3] = pack_bf16(s[2 * k2 + 1][2], s[2 * k2 + 1][3]);
        pf[m][k2] = __builtin_bit_cast(bf16x8, w);
      }
      asm volatile("" ::: "memory");
    }
#pragma unroll
    for (int k2 = 0; k2 < 2; ++k2) {
      asm volatile("" ::: "memory");
#pragma unroll
      for (int d = 0; d < 8; ++d) {
        const char* vr = Vs + (d * 16 + fr) * 128 + (fq & 1) * 8;
        const int c1 = k2 * 4 + (fq >> 1);
        const s16x4 lo = *(const s16x4*)(vr + ((c1 ^ vsw) * 16)), hi = *(const s16x4*)(vr + (((c1 + 2) ^ vsw) * 16));
        const bf16x8 vf = __builtin_shufflevector(lo, hi, 0, 1, 2, 3, 4, 5, 6, 7);
        O[0][d] = MFMA16(vf, pf[0][k2], O[0][d]);
        O[1][d] = MFMA16(vf, pf[1][k2], O[1][d]);
      }
    }
  }
#pragma unroll
  for (int m = 0; m < 2; ++m) l_run[m] = xrow_sum(l_run[m]);
  const float inv1 = 1.f / l_run[0], inv2 = lam / l_run[1];
  float ss = 0.f;
#pragma unroll
  for (int d = 0; d < 8; ++d)
#pragma unroll
    for (int j = 0; j < 4; ++j) { const float o = O[0][d][j] * inv1 - O[1][d][j] * inv2; O[0][d][j] = o; ss += o * o; }
  ss = xrow_sum(ss);
  const float rstd = rsqrtf(ss * (1.f / 128.f) + EPS) * (1.f - lam_init);
  const int tok = tok0 + q0 + fr;
  bf16_t* Y = (bf16_t*)(p.ws + OFF_H);
#pragma unroll
  for (int d = 0; d < 8; ++d) {
    const int dv = d * 16 + 4 * fq;
    const f32x4 g4 = *(const f32x4*)(SMALLP(p, SM_SUBLN) + l * 128 + dv);
    const u32x2 gw = *(const u32x2*)(P + (size_t)tok * LDP + PC_AG + h * 128 + dv);
    f32x4 o;
    o[0] = O[0][d][0] * rstd * g4[0] * silu_f(bflo(gw.x));
    o[1] = O[0][d][1] * rstd * g4[1] * silu_f(bfhi(gw.x));
    o[2] = O[0][d][2] * rstd * g4[2] * silu_f(bflo(gw.y));
    o[3] = O[0][d][3] * rstd * g4[3] * silu_f(bfhi(gw.y));
    *(u32x2*)(Y + slab_idx(tok, 1024 + h * 128 + dv, NTOK)) = pack4(o);
  }
}

__global__ void __launch_bounds__(512, 2) fwd_megakernel(Params p) {
  cg::grid_group grid = cg::this_grid();
  unsigned* sync = (unsigned*)(p.ws + OFF_SYNC);
  unsigned* queues = (unsigned*)(p.ws + OFF_QUEUE);
  if (threadIdx.x == 0) { g_sh[1] = 0u; g_sh[2] = 0u; }
  __syncthreads();
  if (threadIdx.x == 0) (void)xb_add(&sync[XB_XCNT(xb_xcc_id())], 1u);
  if (p.never) grid.sync();
  phase0(p);
  grid_barrier(sync, 0);
  mod_reduce(p);
  grid_barrier(sync, 0);
  for (int l = 0; l < 2; ++l) {
    norm_phase(p, l);
    grid_barrier(sync, 0);
    for (int t = blockIdx.x; t < 1280; t += gridDim.x) g1_tile(p, l, t);
    for (int ht = blockIdx.x; ht < 256; ht += gridDim.x) g1_half_tile(p, l, ht);
    grid_barrier(sync, 0);
    {
      unsigned* q = queues + 64 * (l * 2);
      for (;;) {
        const int it = queue_next(q);
        if (it >= 1280) break;
        const int hf = half_id();
        if (it < 256) { const int a = it * 2 + hf; attn_item(p, l, true, a >> 6, (a >> 4) & 3, a & 15); }
        else if (it < 512) z_tile(p, l, it - 256);
        else if (it < 768) conv_item(p, l, (it - 512) * 2 + hf);
        else if (it < 1024) { const int a = (it - 768) * 2 + hf; attn_item(p, l, false, a >> 4, (a >> 2) & 3, a & 3); }
        else pool_item(p, (it - 1024) * 2 + hf);
      }
    }
    grid_barrier(sync, 0);
    {
      unsigned* q = queues + 64 * (1 + l * 2);
      for (;;) {
        const int it = queue_next(q);
        if (it >= 448) break;
        if (it < 128) {
          const int seq = it >> 4, mh = (it >> 1) & 7, nt = it & 1;
          gated_gemm_tile<4>(p, (const bf16_t*)(p.ws + OFF_DDEC) + (size_t)mh * 128 * LDD, LDD,
                             (const bf16_t*)(p.ws + OFF_ZT) + 32ull * 262144 + (size_t)seq * 512 * LDZ + (size_t)nt * 256 * LDZ, LDZ, 2048,
                             NCTX + seq * 1024 + mh * 128, nt * 256, PC_FG, 0, nullptr);
        } else if (it < 256) {
          const int t = it - 128, pm = t & 63, pn = t >> 6;
          gated_gemm_tile(p, (const bf16_t*)(p.ws + OFF_CONVACT) + (size_t)pm * 256 * 512, 512,
                          (const bf16_t*)(p.ws + OFF_WPWT) + ((size_t)l * 512 + pn * 256) * 512, 512, 512, pm * 256, pn * 256, PC_CG, 1536, nullptr);
        } else if (it < 320) {
          const int t = it - 256, seq = t >> 1, nt = t & 1;
          gated_gemm_tile(p, (const bf16_t*)(p.ws + OFF_DCTX), LDC, (const bf16_t*)(p.ws + OFF_ZT) + (size_t)seq * 262144 + (size_t)nt * 256 * 512, 512, 512,
                          seq * 256, nt * 256, PC_FG, 0, nullptr);
        } else {
          const int t = it - 320, pm = t & 63, pr = t >> 6;
          gated_gemm_tile(p, (const bf16_t*)(p.ws + OFF_POOLED) + (size_t)pm * 256 * 512 + pr * 256, 512,
                          (const bf16_t*)(p.ws + OFF_WPOOLT) + (size_t)(l * 2 + pr) * 65536, 256, 256, pm * 256, pr * 256, PC_PG, 512, SMALLP(p, SM_POOLSC) + l * 512);
        }
      }
    }
    grid_barrier(sync, 0);
    for (int t = blockIdx.x; t < 64 * 8; t += gridDim.x) out_tile(p, l, t);
    grid_barrier(sync, 0);
  }
  final_phase(p);
}

extern "C" void kernel_launch(void* const* d_in, const int* in_sizes, int n_in, void* d_out, int out_size, void* d_ws, size_t ws_size,
                              hipStream_t stream) {
  static int grid_blocks = 0;
  if (!grid_blocks) {
    int dev = 0, cus = 0, per_cu = 0;
    (void)hipGetDevice(&dev);
    (void)hipDeviceGetAttribute(&cus, hipDeviceAttributeMultiprocessorCount, dev);
    (void)hipFuncSetAttribute((const void*)fwd_megakernel, hipFuncAttributeMaxDynamicSharedMemorySize, (int)kDynLds);
    (void)hipOccupancyMaxActiveBlocksPerMultiprocessor(&per_cu, fwd_megakernel, 512, kDynLds);
    if (per_cu > 1) per_cu = 1;
    if (per_cu < 1) per_cu = 1;
    grid_blocks = cus * per_cu;
  }
  Params p{};
  const float** pp = (const float**)&p;
  for (int i = 0; i < 22; ++i) pp[i] = (const float*)d_in[i];
  p.out = (float*)d_out;
  p.ws = (unsigned char*)d_ws;
  (void)hipMemsetAsync(d_ws, 0, ZERO_BYTES, stream);
  void* args[] = {&p};
  hipError_t e = hipLaunchCooperativeKernel((void*)fwd_megakernel, dim3(grid_blocks), dim3(512), args, kDynLds, stream);
  if (e != hipSuccess) fprintf(stderr, "cooperative launch failed: %s (grid %d)\n", hipGetErrorString(e), grid_blocks);
}
```

```cpp
#include <hip/hip_runtime.h>
#include <hip/hip_cooperative_groups.h>
#include <stdint.h>
#include <cstdio>
namespace cg = cooperative_groups;

typedef unsigned short bf16_t;
typedef short bf16x8 __attribute__((ext_vector_type(8)));
typedef short s16x4 __attribute__((ext_vector_type(4)));
typedef float f32x4 __attribute__((ext_vector_type(4)));
typedef float f32x2 __attribute__((ext_vector_type(2)));
typedef unsigned u32x4 __attribute__((ext_vector_type(4)));
typedef unsigned u32x2 __attribute__((ext_vector_type(2)));
#define DI __device__ __forceinline__
#define LDSP __attribute__((address_space(3))) void*
#define MFMA16(a, b, c) __builtin_amdgcn_mfma_f32_16x16x32_bf16((a), (b), (c), 0, 0, 0)

constexpr int DM = 2048, NTOK = 16384, NCTX = 8192;
constexpr int LDP = 5120;
constexpr int PC_FX = 0, PC_FG = 512, PC_PX = 1024, PC_PG = 1536, PC_Q = 2048, PC_K = 2560, PC_AG = 3072, PC_CA = 3584, PC_CB = 4096, PC_CG = 4608;
constexpr float EPS = 1e-6f;
constexpr int LDD = 2112;
constexpr int LDZ = 2112;
constexpr int LDC = 576;

constexpr size_t OFF_SYNC = 0;
constexpr size_t OFF_QUEUE = 16384;
constexpr size_t OFF_MODV = 20480;
constexpr size_t SZ_MODV = 2ull * 9 * 6144 * 4;
constexpr size_t ZERO_BYTES = OFF_MODV + SZ_MODV;
constexpr size_t OFF_ROPE = ZERO_BYTES;
constexpr size_t OFF_P = OFF_ROPE + 8192;
constexpr size_t OFF_H = OFF_P + (size_t)NTOK * LDP * 2;
constexpr size_t OFF_ZT = OFF_H + (size_t)NTOK * DM * 2;
constexpr size_t OFF_VTN = OFF_ZT + (32ull * 262144 + 8ull * 512 * LDZ) * 2;
constexpr size_t OFF_POOLED = OFF_VTN + (size_t)NTOK * 512 * 2;
constexpr size_t OFF_CONVACT = OFF_POOLED + (size_t)NTOK * 512 * 2;
constexpr size_t OFF_WINT = OFF_CONVACT + (size_t)NTOK * 512 * 2;
constexpr size_t OFF_WOUTT = OFF_WINT + 2ull * 5632 * 2048 * 2;
constexpr size_t OFF_WCST = OFF_WOUTT + 2ull * 2048 * 2048 * 2;
constexpr size_t OFF_WPOOLT = OFF_WCST + 2ull * 1024 * 512 * 2;
constexpr size_t OFF_WPWT = OFF_WPOOLT + 2ull * 2 * 256 * 256 * 2;
constexpr size_t OFF_KC = OFF_WPWT + 2ull * 512 * 512 * 2;
constexpr size_t OFF_VTC = OFF_KC + 8ull * 2 * 4 * 256 * 128 * 2;
constexpr size_t OFF_DCTX = OFF_VTC + 8ull * 2 * 4 * 256 * 128 * 2;
constexpr size_t OFF_DDEC = OFF_DCTX + 256ull * LDC * 2;
constexpr size_t OFF_SMALL = OFF_DDEC + 1024ull * LDD * 2;
constexpr int SM_NORMG = 0, SM_POOLSC = 4096, SM_DLAM = 5120, SM_SUBLN = 5632, SM_DW = 5888, SM_DWB = 37632, SM_LNG = 38656, SM_LNB = 39680, SM_FINALG = 40704, SM_TOTAL = 42752;
constexpr size_t WS_TOTAL = OFF_SMALL + (size_t)SM_TOTAL * 4;
static_assert(WS_TOTAL <= 402653184ull, "workspace too large");

struct Params {
  const float *x_prompt, *x_sample, *cache_k, *cache_v, *c, *c_ctx, *norm_g, *w_mod, *b_mod, *w_in, *w_fourier, *w_pool,
      *pool_scale, *diff_lambda, *subln_g, *conv_dw, *conv_dw_b, *conv_ln_g, *conv_ln_b, *w_conv_pw, *w_out, *final_g;
  float* out;
  unsigned char* ws;
  unsigned long long never;
};

extern __shared__ __attribute__((aligned(16))) char g_smem[];
constexpr size_t kDynLds = 131072;
#define HSM (g_smem + (half_id() << 16))
__shared__ unsigned g_sh[4];

#define SMALLP(p, off) ((const float*)((p).ws + OFF_SMALL) + (off))
DI size_t slab_idx(int row, int col, int nrows) { return ((size_t)(col >> 5) * nrows + row) * 32 + (col & 31); }
DI float bf2f(unsigned u16) { return __uint_as_float(u16 << 16); }
DI float bflo(unsigned w) { return __uint_as_float(w << 16); }
DI float bfhi(unsigned w) { return __uint_as_float(w & 0xffff0000u); }
typedef __bf16 bf16v2_t __attribute__((ext_vector_type(2)));
DI unsigned pack_bf16(float lo, float hi) {
  const f32x2 v = {lo, hi};
  return __builtin_bit_cast(unsigned, __builtin_convertvector(v, bf16v2_t));
}
DI float silu_f(float x) { return x * __builtin_amdgcn_rcpf(1.f + __expf(-x)); }
DI float sigmoid_f(float x) { return __builtin_amdgcn_rcpf(1.f + __expf(-x)); }
DI int opaque_tid() { int t = threadIdx.x; asm volatile("" : "+v"(t)); return t; }
DI int half_tid() { return opaque_tid() & 255; }
DI int half_id() { return opaque_tid() >> 8; }
DI float wave_sum(float v) {
#pragma unroll
  for (int o = 32; o >= 1; o >>= 1) v += __shfl_xor(v, o);
  return v;
}
typedef __bf16 bf2_t __attribute__((ext_vector_type(2)));
DI float dot2bf(unsigned a, unsigned b, float c) { return __builtin_amdgcn_fdot2_f32_bf16(__builtin_bit_cast(bf2_t, a), __builtin_bit_cast(bf2_t, b), c, false); }
DI float xrow_max(float v) {
  u32x2 r = __builtin_amdgcn_permlane16_swap(__float_as_uint(v), __float_as_uint(v), false, false);
  v = fmaxf(__uint_as_float(r[0]), __uint_as_float(r[1]));
  r = __builtin_amdgcn_permlane32_swap(__float_as_uint(v), __float_as_uint(v), false, false);
  return fmaxf(__uint_as_float(r[0]), __uint_as_float(r[1]));
}
DI float xrow_sum(float v) {
  u32x2 r = __builtin_amdgcn_permlane16_swap(__float_as_uint(v), __float_as_uint(v), false, false);
  v = __uint_as_float(r[0]) + __uint_as_float(r[1]);
  r = __builtin_amdgcn_permlane32_swap(__float_as_uint(v), __float_as_uint(v), false, false);
  return __uint_as_float(r[0]) + __uint_as_float(r[1]);
}
DI u32x2 pack4(f32x4 v) { u32x2 r; r.x = pack_bf16(v[0], v[1]); r.y = pack_bf16(v[2], v[3]); return r; }

#define XB_TMO      128
#define XB_XCNT(j)  (256  + 64 * (j))
#define XB_XSUB(j)  (1280 + 64 * (j))
#define XB_XGEN(j)  (2304 + 64 * (j))
#define XB_TOP      3328
#define XB_TOPGEN   3392
#define XB_SPIN_CAP (1u << 20)
DI unsigned xb_ld(unsigned* p) { return __hip_atomic_load(p, __ATOMIC_RELAXED, __HIP_MEMORY_SCOPE_AGENT); }
DI unsigned xb_add(unsigned* p, unsigned v) { return __hip_atomic_fetch_add(p, v, __ATOMIC_RELAXED, __HIP_MEMORY_SCOPE_AGENT); }
DI unsigned xb_xcc_id() { return (unsigned)__builtin_amdgcn_s_getreg((3 << 11) | 20) & 0xFu; }
#define XB_SPIN(cond, bar) do { unsigned _sp = 0; while (cond) { __builtin_amdgcn_s_sleep(1); \
    if ((++_sp & 255u) == 0u) { if (xb_ld(&(bar)[XB_TMO])) break; if (_sp > XB_SPIN_CAP) { atomicAdd(&(bar)[XB_TMO], 1u); break; } } } } while (0)
DI void xcd_barrier_complete(unsigned* bar, unsigned x, unsigned& nloc, unsigned& nx) {
  const unsigned G = gridDim.x;
  unsigned sum, cnt, mine, sp = 0u;
  for (;;) {
    sum = 0u; cnt = 0u; mine = 0u;
#pragma unroll
    for (unsigned j = 0; j < 16; ++j) { const unsigned c = xb_ld(&bar[XB_XCNT(j)]); sum += c; cnt += (c > 0u) ? 1u : 0u; mine = (j == x) ? c : mine; }
    if (sum == G) break;
    __builtin_amdgcn_s_sleep(1);
    if ((++sp & 255u) == 0u) { if (xb_ld(&bar[XB_TMO])) break; if (sp > XB_SPIN_CAP) { atomicAdd(&bar[XB_TMO], 1u); break; } }
  }
  nloc = mine > 0u ? mine : 1u; nx = cnt > 0u ? cnt : 1u;
}
DI void grid_barrier(unsigned* bar, unsigned) {
  asm volatile("s_waitcnt vmcnt(0)" ::: "memory");
  __syncthreads();
  if (threadIdx.x == 0) {
    __builtin_amdgcn_s_waitcnt(0);
    const unsigned x = xb_xcc_id();
    volatile unsigned* st = g_sh;
    unsigned nloc = st[1], nx = st[2];
    if (nloc == 0u) { xcd_barrier_complete(bar, x, nloc, nx); st[1] = nloc; st[2] = nx; }
    const unsigned old = xb_add(&bar[XB_XSUB(x)], 1u);
    const unsigned gen = old / nloc;
    if (old + 1u == (gen + 1u) * nloc) {
      __builtin_amdgcn_fence(__ATOMIC_RELEASE, "agent");
      asm volatile("s_waitcnt vmcnt(0)" ::: "memory");
      const unsigned og = xb_add(&bar[XB_TOP], 1u);
      const unsigned tg = og / nx;
      if (og + 1u == (tg + 1u) * nx) xb_add(&bar[XB_TOPGEN], 1u);
      else XB_SPIN(xb_ld(&bar[XB_TOPGEN]) == tg, bar);
      __builtin_amdgcn_fence(__ATOMIC_ACQUIRE, "agent");
      xb_add(&bar[XB_XGEN(x)], 1u);
      asm volatile("s_waitcnt vmcnt(0)" ::: "memory");
    } else {
      XB_SPIN(xb_ld(&bar[XB_XGEN(x)]) == gen, bar);
      __builtin_amdgcn_fence(__ATOMIC_ACQUIRE, "agent");
      asm volatile("s_waitcnt vmcnt(0)" ::: "memory");
    }
  }
  __syncthreads();
}

DI int queue_next(unsigned* q) {
  __syncthreads();
  if (threadIdx.x == 0) g_sh[0] = __hip_atomic_fetch_add(q, 1u, __ATOMIC_RELAXED, __HIP_MEMORY_SCOPE_AGENT);
  __syncthreads();
  return (int)g_sh[0];
}

template <int CTRL, int ROWMASK> DI float dpp_add(float v) {
  const int t = __builtin_amdgcn_update_dpp(0, __float_as_int(v), CTRL, ROWMASK, 0xf, false);
  return v + __int_as_float(t);
}
DI float wave_sum_dpp(float v) {
  v = dpp_add<0x111, 0xf>(v); v = dpp_add<0x112, 0xf>(v); v = dpp_add<0x114, 0xf>(v); v = dpp_add<0x118, 0xf>(v);
  v = dpp_add<0x142, 0xa>(v); v = dpp_add<0x143, 0xc>(v);
  return __int_as_float(__builtin_amdgcn_readlane(__float_as_int(v), 63));
}

template <bool TRANS, bool PERM, int MI = 8>
DI void gemm_main(const bf16_t* A, int lda, size_t ksA, const bf16_t* B, int ldb, size_t ksB, int K, f32x4 (&acc)[MI][4]) {
  const int tid = opaque_tid(), lane = tid & 63, wid = tid >> 6, wr = wid >> 2, wc = wid & 3, fr = lane & 15, fq = lane >> 4;
  const int lrow = tid >> 2, lch = tid & 3;
  const int lsw = (lch ^ (((lrow >> 3) & 1) << 1)) * 8;
  const bf16_t* ga = A + (size_t)lrow * lda + lsw;
  const int rho = lrow & 31;
  const int lrow_b = PERM ? ((lrow & ~31) | (8 * ((rho & 15) >> 2) + 4 * (rho >> 4) + (rho & 3))) : lrow;
  const bf16_t* gb = B + (size_t)lrow_b * ldb + lsw;
  const size_t sa = (size_t)128 * lda, sb = (size_t)128 * ldb;
#pragma unroll
  for (int mi = 0; mi < MI; ++mi)
#pragma unroll
    for (int ni = 0; ni < 4; ++ni) acc[mi][ni] = (f32x4){0.f, 0.f, 0.f, 0.f};
  char* lbase = g_smem + tid * 16;
#define GLDS_ISSUE(STG)                                                                                              \
  do {                                                                                                               \
    char* l_ = lbase + (STG) * 32768;                                                                                \
    __builtin_amdgcn_global_load_lds((const unsigned*)(ga), (LDSP)(l_), 16, 0, 0);                                   \
    if (MI == 8) __builtin_amdgcn_global_load_lds((const unsigned*)(ga + sa), (LDSP)(l_ + 8192), 16, 0, 0);          \
    __builtin_amdgcn_global_load_lds((const unsigned*)(gb), (LDSP)(l_ + 16384), 16, 0, 0);                           \
    __builtin_amdgcn_global_load_lds((const unsigned*)(gb + sb), (LDSP)(l_ + 24576), 16, 0, 0);                      \
    ga += ksA; gb += ksB;                                                                                            \
  } while (0)
  asm volatile("s_waitcnt vmcnt(0)" ::: "memory");
  __syncthreads();
  const int nk = K >> 5;
  GLDS_ISSUE(0);
  GLDS_ISSUE(1);
  GLDS_ISSUE(2);
  const int rsw = (fq ^ (((fr >> 3) & 1) << 1)) * 16;
  const int aofs = (wr * (MI * 16) + fr) * 64 + rsw;
  const int bofs = 16384 + (wc * 64 + fr) * 64 + rsw;
  if (MI == 8) asm volatile("s_waitcnt vmcnt(8)" ::: "memory"); else asm volatile("s_waitcnt vmcnt(6)" ::: "memory");
  __builtin_amdgcn_s_barrier();
  if (wid >= 4) __builtin_amdgcn_s_barrier();
  int scur = 0, snxt = 3;
  for (int kt = 0; kt < nk; ++kt) {
    const char* st = g_smem + scur * 32768;
    bf16x8 af[MI], bfr[4];
#pragma unroll
    for (int mi = 0; mi < MI; ++mi) af[mi] = *(const bf16x8*)(st + aofs + mi * 1024);
#pragma unroll
    for (int ni = 0; ni < 4; ++ni) bfr[ni] = *(const bf16x8*)(st + bofs + ni * 1024);
    if (kt + 3 < nk) { GLDS_ISSUE(snxt); if (MI == 8) asm volatile("s_waitcnt vmcnt(8) lgkmcnt(0)" ::: "memory"); else asm volatile("s_waitcnt vmcnt(6) lgkmcnt(0)" ::: "memory"); }
    else if (kt + 2 < nk) { if (MI == 8) asm volatile("s_waitcnt vmcnt(4) lgkmcnt(0)" ::: "memory"); else asm volatile("s_waitcnt vmcnt(3) lgkmcnt(0)" ::: "memory"); }
    else asm volatile("s_waitcnt vmcnt(0) lgkmcnt(0)" ::: "memory");
    __builtin_amdgcn_sched_barrier(0);
    __builtin_amdgcn_s_barrier();
    __builtin_amdgcn_sched_barrier(0);
#pragma unroll
    for (int mi = 0; mi < MI; ++mi)
#pragma unroll
      for (int ni = 0; ni < 4; ++ni)
        acc[mi][ni] = TRANS ? MFMA16(bfr[ni], af[mi], acc[mi][ni]) : MFMA16(af[mi], bfr[ni], acc[mi][ni]);
    __builtin_amdgcn_sched_barrier(0);
    __builtin_amdgcn_s_barrier();
    __builtin_amdgcn_sched_barrier(0);
    scur = (scur + 1) & 3;
    snxt = (snxt + 1) & 3;
  }
  if (wid < 4) __builtin_amdgcn_s_barrier();
#undef GLDS_ISSUE
}

DI void transpose_tile(const float* src, int ldn, bf16_t* dst, int ldk, int k0, int n0, int slab_rows = 0) {
  float* t = (float*)HSM;
  const int tid = half_tid();
  __syncthreads();
  f32x4 v[8];
#pragma unroll
  for (int i = 0; i < 8; ++i) {
    const int idx = tid + i * 256, r = idx >> 5, c4 = (idx & 31) * 4;
    v[i] = *(const f32x4*)(src + (size_t)(k0 + r) * ldn + n0 + c4);
  }
#pragma unroll
  for (int i = 0; i < 8; ++i) {
    const int idx = tid + i * 256, r = idx >> 5, c4 = (idx & 31) * 4;
    t[r * 129 + c4 + 0] = v[i][0]; t[r * 129 + c4 + 1] = v[i][1]; t[r * 129 + c4 + 2] = v[i][2]; t[r * 129 + c4 + 3] = v[i][3];
  }
  __syncthreads();
#pragma unroll
  for (int i = 0; i < 4; ++i) {
    const int idx = tid + i * 256, n = idx >> 3, kc = (idx & 7) * 8;
    u32x4 o;
    o[0] = pack_bf16(t[(kc + 0) * 129 + n], t[(kc + 1) * 129 + n]);
    o[1] = pack_bf16(t[(kc + 2) * 129 + n], t[(kc + 3) * 129 + n]);
    o[2] = pack_bf16(t[(kc + 4) * 129 + n], t[(kc + 5) * 129 + n]);
    o[3] = pack_bf16(t[(kc + 6) * 129 + n], t[(kc + 7) * 129 + n]);
    if (slab_rows) *(u32x4*)(dst + slab_idx(n0 + n, k0 + kc, slab_rows)) = o;
    else *(u32x4*)(dst + (size_t)(n0 + n) * ldk + k0 + kc) = o;
  }
}

DI void mod_item(const Params& p, int it) {
  const int tid = half_tid();
  const int l = it / 192, r = it % 192, kc = r / 6, cb = r % 6;
  float* sl = (float*)HSM;
  __syncthreads();
  for (int idx = tid; idx < 576; idx += 256) {
    const int j = idx >> 6, k = idx & 63;
    const float* src = (j == 0) ? p.c_ctx : p.c + (j - 1) * 2048;
    sl[idx] = silu_f(src[kc * 64 + k]);
  }
  __syncthreads();
  const int col = cb * 1024 + tid * 4;
  f32x4 acc[9];
#pragma unroll
  for (int j = 0; j < 9; ++j) acc[j] = (f32x4){0.f, 0.f, 0.f, 0.f};
  const float* w = p.w_mod + ((size_t)l * 2048 + kc * 64) * 6144 + col;
#pragma unroll 4
  for (int k = 0; k < 64; ++k) {
    const f32x4 wv = *(const f32x4*)(w + (size_t)k * 6144);
#pragma unroll
    for (int j = 0; j < 9; ++j) acc[j] += wv * sl[j * 64 + k];
  }
  float* part = p.out + (size_t)(kc * 18 + l * 9) * 6144 + col;
#pragma unroll
  for (int j = 0; j < 9; ++j) *(f32x4*)(part + (size_t)j * 6144) = acc[j];
}

DI void mod_reduce(const Params& p) {
  float* modv = (float*)(p.ws + OFF_MODV);
  for (int e = (blockIdx.x * 512 + opaque_tid()) * 4; e < 18 * 6144; e += gridDim.x * 512 * 4) {
    const int lj = e / 6144, col = e - lj * 6144, l = lj / 9;
    f32x4 a = *(const f32x4*)(p.b_mod + l * 6144 + col);
#pragma unroll 8
    for (int kc = 0; kc < 32; ++kc) a += *(const f32x4*)(p.out + (size_t)kc * 18 * 6144 + e);
    *(f32x4*)(modv + e) = a;
  }
}

DI void fourier_fold_item(const Params& p, int it) {
  const int tid = half_tid();
  const int l = it >> 10, r = it & 1023, k = r >> 1, nb = r & 1;
  const int g = k >> 7, c = k & 127, n = nb * 256 + tid;
  float* tab = (float*)HSM;
  __syncthreads();
  if (tid < 128) { const float rev = (float)tid * (1.f / 128.f); tab[tid] = __builtin_amdgcn_cosf(rev); tab[128 + tid] = __builtin_amdgcn_sinf(rev); }
  __syncthreads();
  const float* w = p.w_fourier + ((size_t)(l * 512 + g * 128)) * 512 + n;
  float ac = 0.f, as = 0.f;
#pragma unroll 16
  for (int j = 0; j < 128; ++j) { const float wv = w[(size_t)j * 512]; const int ti = (c * j) & 127; ac += tab[ti] * wv; as += tab[128 + ti] * wv; }
  bf16_t* dst = (bf16_t*)(p.ws + OFF_WCST);
  dst[((size_t)(l * 1024 + n)) * 512 + k] = (bf16_t)(pack_bf16(ac * 0.08838834764831845f, 0.f) & 0xffffu);
  dst[((size_t)(l * 1024 + 512 + n)) * 512 + k] = (bf16_t)(pack_bf16(as * 0.08838834764831845f, 0.f) & 0xffffu);
}

DI void phase0(const Params& p) {
  const int tid = half_tid();
  constexpr int N_MOD = 384, N_WIN = 2816, N_WOUT = 1024, N_WPW = 64, N_WPOOL = 128, N_CV = 256, N_CK = 1024, N_DCTX = 64, N_DDEC = 1024, N_ROPE = 2, N_FF = 2048, N_SM = 24;
  constexpr int E0 = N_MOD, E1 = E0 + N_WIN, E2 = E1 + N_WOUT, E3 = E2 + N_WPW, E4 = E3 + N_WPOOL, E5 = E4 + N_CV, E6 = E5 + N_CK, E7 = E6 + N_DCTX,
                E8 = E7 + N_DDEC, E9 = E8 + N_ROPE, E10 = E9 + N_FF, E11 = E10 + N_SM;
  for (int itp = blockIdx.x; itp < E11 / 2; itp += gridDim.x) {
    const int it = itp * 2 + half_id();
    if (it < E0) {
      mod_item(p, it);
    } else if (it < E1) {
      const int t = it - E0, l = t / 1408, r = t % 1408, kt = r / 44, nt = r % 44;
      transpose_tile(p.w_in + (size_t)l * 2048 * 5632, 5632, (bf16_t*)(p.ws + OFF_WINT) + (size_t)l * 5632 * 2048, 2048, kt * 64, nt * 128, 5632);
    } else if (it < E2) {
      const int t = it - E1, l = t >> 9, r = t & 511, kt = r >> 4, nt = r & 15;
      transpose_tile(p.w_out + (size_t)l * 2048 * 2048, 2048, (bf16_t*)(p.ws + OFF_WOUTT) + (size_t)l * 2048 * 2048, 2048, kt * 64, nt * 128, 2048);
    } else if (it < E3) {
      const int t = it - E2, l = t >> 5, r = t & 31, kt = r >> 2, nt = r & 3;
      transpose_tile(p.w_conv_pw + (size_t)l * 512 * 512, 512, (bf16_t*)(p.ws + OFF_WPWT) + (size_t)l * 512 * 512, 512, kt * 64, nt * 128);
    } else if (it < E4) {
      const int t = it - E3, lp = t >> 5;
      const int e0 = (t & 31) * 2048 + tid * 8, n = e0 >> 8, k0 = e0 & 255;
      const int g = (lp & 1) * 2 + (n >> 7);
      u32x4 o = (u32x4){0u, 0u, 0u, 0u};
      if ((k0 >> 7) == (n >> 7)) {
        const float* w = p.w_pool + ((size_t)((lp >> 1) * 4 + g) * 128 + (k0 & 127)) * 128 + (n & 127);
#pragma unroll
        for (int e = 0; e < 4; ++e) o[e] = pack_bf16(w[(size_t)(2 * e) * 128], w[(size_t)(2 * e + 1) * 128]);
      }
      *(u32x4*)((bf16_t*)(p.ws + OFF_WPOOLT) + (size_t)lp * 65536 + e0) = o;
    } else if (it < E5) {
      const int t = it - E4, blh = t >> 2, kt = t & 3;
      transpose_tile(p.cache_v + (size_t)blh * 256 * 128, 128, (bf16_t*)(p.ws + OFF_VTC) + (size_t)blh * 128 * 256, 256, kt * 64, 0);
    } else if (it < E6) {
      const size_t e = (size_t)(it - E5) * 2048 + tid * 8;
      const f32x4 a = *(const f32x4*)(p.cache_k + e), b = *(const f32x4*)(p.cache_k + e + 4);
      u32x4 o; o[0] = pack_bf16(a[0], a[1]); o[1] = pack_bf16(a[2], a[3]); o[2] = pack_bf16(b[0], b[1]); o[3] = pack_bf16(b[2], b[3]);
      *(u32x4*)((bf16_t*)(p.ws + OFF_KC) + e) = o;
    } else if (it < E8) {
      const bool dec = it >= E7;
      const int e0 = (dec ? it - E7 : it - E6) * 2048 + tid * 8;
      const int S = dec ? 1024 : 256, sh = dec ? 11 : 9;
      const float nrm = dec ? 0.03125f : 0.0625f, invS = dec ? (1.f / 1024.f) : (1.f / 256.f);
      float v[8];
#pragma unroll
      for (int i = 0; i < 8; ++i) {
        const int e = e0 + i, t = e & (2 * S - 1);
        const int s = e >> sh;
        const int tt = t & (S - 1);
        const float rev = (float)((s * tt) & (S - 1)) * invS;
        v[i] = (t < S) ? __builtin_amdgcn_cosf(rev) * nrm : -__builtin_amdgcn_sinf(rev) * nrm;
      }
      u32x4 o; o[0] = pack_bf16(v[0], v[1]); o[1] = pack_bf16(v[2], v[3]); o[2] = pack_bf16(v[4], v[5]); o[3] = pack_bf16(v[6], v[7]);
      *(u32x4*)((bf16_t*)(p.ws + (dec ? OFF_DDEC : OFF_DCTX)) + (size_t)(e0 >> sh) * (dec ? LDD : LDC) + (e0 & (2 * S - 1))) = o;
    } else if (it < E9) {
      f32x2* rope = (f32x2*)(p.ws + OFF_ROPE);
#pragma unroll
      for (int i = 0; i < 4; ++i) {
        const int idx = tid + i * 256, pos = idx >> 4, f = idx & 15;
        const float inv = exp2f(-(float)f * (13.287712379549449f / 16.f));
        const float ang = (float)pos * inv;
        float rev = ang * 0.15915494309189535f;
        rev -= floorf(rev);
        f32x2 cs; cs.x = __builtin_amdgcn_cosf(rev); cs.y = __builtin_amdgcn_sinf(rev);
        rope[idx] = cs;
      }
    } else if (it < E10) {
      fourier_fold_item(p, it - E9);
    } else {
      const int j = it - E10;
      const float* src; int n, off;
      if (j >= 4 && j < 20) { src = p.conv_dw + (j - 4) * 1984; n = 1984; off = SM_DW + (j - 4) * 1984; }
      else switch (j) {
        case 0: src = p.norm_g; n = 4096; off = SM_NORMG; break;
        case 1: src = p.pool_scale; n = 1024; off = SM_POOLSC; break;
        case 2: src = p.diff_lambda; n = 512; off = SM_DLAM; break;
        case 3: src = p.subln_g; n = 256; off = SM_SUBLN; break;
        case 20: src = p.conv_dw_b; n = 1024; off = SM_DWB; break;
        case 21: src = p.conv_ln_g; n = 1024; off = SM_LNG; break;
        case 22: src = p.conv_ln_b; n = 1024; off = SM_LNB; break;
        default: src = p.final_g; n = 2048; off = SM_FINALG; break;
      }
      float* dst = (float*)(p.ws + OFF_SMALL) + off;
#pragma unroll
      for (int i = 0; i < 4; ++i) { const int e = (tid + i * 256) * 4; if (e < n) *(f32x4*)(dst + e) = *(const f32x4*)(src + e); }
    }
  }
}

DI const float* x_row_l0(const Params& p, int m) { return (m < NCTX) ? p.x_prompt + (size_t)m * DM : p.x_sample + (size_t)(m - NCTX) * DM; }
DI int cvec_of_row(int m) { return (m < NCTX) ? 0 : 1 + ((m - NCTX) >> 10); }

DI void norm_phase(const Params& p, int l) {
  const int tid_ = opaque_tid(); const int lane = tid_ & 63, wid = tid_ >> 6;
  const int rr = lane >> 5, q = lane & 31;
  bf16_t* H = (bf16_t*)(p.ws + OFF_H);
  const float* modv = (const float*)(p.ws + OFF_MODV);
  const float* g = SMALLP(p, SM_NORMG) + l * DM;
  const int step = gridDim.x * 8;
  int mp = blockIdx.x * 8 + wid;
  f32x4 v[16], vn[16];
  auto load_pair = [&](int mpair, f32x4 (&d)[16]) {
    const int m = mpair * 2 + rr;
    const float* x = (l == 0) ? x_row_l0(p, m) : p.out + (size_t)m * DM;
#pragma unroll
    for (int i = 0; i < 8; ++i) { const int c = i * 256 + q * 8; d[2 * i] = *(const f32x4*)(x + c); d[2 * i + 1] = *(const f32x4*)(x + c + 4); }
  };
  if (mp < NTOK / 2) load_pair(mp, v);
  for (; mp < NTOK / 2; mp += step) {
    const bool more = (mp + step < NTOK / 2);
    if (more) load_pair(mp + step, vn);
    const int m = mp * 2 + rr;
    const float* mv = modv + (size_t)(l * 9 + cvec_of_row(m)) * 6144;
    float ss = 0.f;
#pragma unroll
    for (int i = 0; i < 16; ++i)
#pragma unroll
      for (int e = 0; e < 4; ++e) ss += v[i][e] * v[i][e];
#pragma unroll
    for (int o = 16; o >= 1; o >>= 1) ss += __shfl_xor(ss, o);
    const float rstd = rsqrtf(ss * (1.f / 2048.f) + EPS);
#pragma unroll
    for (int i = 0; i < 8; ++i) {
      const int c = i * 256 + q * 8;
      u32x4 o4;
#pragma unroll
      for (int hh = 0; hh < 2; ++hh) {
        const f32x4 gg = *(const f32x4*)(g + c + 4 * hh), sh = *(const f32x4*)(mv + c + 4 * hh), sc = *(const f32x4*)(mv + 2048 + c + 4 * hh);
        f32x4 h;
#pragma unroll
        for (int e = 0; e < 4; ++e) h[e] = v[2 * i + hh][e] * rstd * gg[e] * (1.f + sc[e]) + sh[e];
        o4[2 * hh] = pack_bf16(h[0], h[1]); o4[2 * hh + 1] = pack_bf16(h[2], h[3]);
      }
      *(u32x4*)(H + slab_idx(m, c, NTOK)) = o4;
    }
    if (more) {
#pragma unroll
      for (int i = 0; i < 16; ++i) v[i] = vn[i];
    }
  }
}

DI void final_phase(const Params& p) {
  const int tid_ = opaque_tid(); const int lane = tid_ & 63, wid = tid_ >> 6;
  const int step = gridDim.x * 8;
  int m = blockIdx.x * 8 + wid;
  f32x4 v[8], vn[8];
  if (m < NTOK) {
#pragma unroll
    for (int i = 0; i < 8; ++i) v[i] = *(const f32x4*)(p.out + (size_t)m * DM + (i * 64 + lane) * 4);
  }
  for (; m < NTOK; m += step) {
    const bool more = (m + step < NTOK);
    if (more) {
#pragma unroll
      for (int i = 0; i < 8; ++i) vn[i] = *(const f32x4*)(p.out + (size_t)(m + step) * DM + (i * 64 + lane) * 4);
    }
    float* x = p.out + (size_t)m * DM;
    float ss = 0.f;
#pragma unroll
    for (int i = 0; i < 8; ++i) ss += v[i][0] * v[i][0] + v[i][1] * v[i][1] + v[i][2] * v[i][2] + v[i][3] * v[i][3];
    ss = wave_sum(ss);
    const float rstd = rsqrtf(ss * (1.f / 2048.f) + EPS);
#pragma unroll
    for (int i = 0; i < 8; ++i) {
      const int c = (i * 64 + lane) * 4;
      const f32x4 gg = *(const f32x4*)(SMALLP(p, SM_FINALG) + c);
      f32x4 h;
#pragma unroll
      for (int e = 0; e < 4; ++e) h[e] = v[i][e] * rstd * gg[e];
      *(f32x4*)(x + c) = h;
    }
    if (more) {
#pragma unroll
      for (int i = 0; i < 8; ++i) v[i] = vn[i];
    }
  }
}

DI void g1_tile(const Params& p, int l, int t) {
  const int pm = t & 63, pn = t >> 6;
  const int tid = opaque_tid(), lane = tid & 63, wid = tid >> 6, wr = wid >> 2, wc = wid & 3, fr = lane & 15, fq = lane >> 4;
  const bf16_t* A = (const bf16_t*)(p.ws + OFF_H) + (size_t)pm * 256 * 32;
  const bf16_t* B = (const bf16_t*)(p.ws + OFF_WINT) + (size_t)l * 5632 * 2048 + (size_t)pn * 256 * 32;
  bf16_t* P = (bf16_t*)(p.ws + OFF_P);
  const int m0 = pm * 256, n0 = pn * 256;
  const int nw = n0 + wc * 64;
  const bool dec = m0 >= NCTX;
  f32x4 acc[8][4];
  if (pn == 12 || pn == 13) {
    gemm_main<false, false>(A, 32, (size_t)NTOK * 32, B, 32, (size_t)5632 * 32, DM, acc);
    const int vc = nw - 3072, h = vc >> 7;
    bf16_t* vtn = (bf16_t*)(p.ws + OFF_VTN);
    int S, s0; size_t vbase; int b;
    if (!dec) { b = m0 >> 8; S = 256; s0 = 0; vbase = (size_t)b * 131072; }
    else { const int dm = m0 - NCTX; b = dm >> 10; S = 1024; s0 = dm & 1023; vbase = (size_t)32 * 131072 + (size_t)b * 524288; }
    float* ncv = p.out + 41943040ull + ((size_t)((b * 2 + l) * 4 + h)) * 32768;
#pragma unroll
    for (int mi = 0; mi < 8; ++mi)
#pragma unroll
      for (int ni = 0; ni < 4; ++ni) {
        const int s = s0 + wr * 128 + mi * 16 + 4 * fq, dv = (vc & 127) + ni * 16 + fr;
        *(u32x2*)(vtn + vbase + (size_t)(h * 128 + dv) * S + s) = pack4(acc[mi][ni]);
        if (!dec) {
#pragma unroll
          for (int j = 0; j < 4; ++j) ncv[(size_t)(s + j) * 128 + dv] = acc[mi][ni][j];
        }
      }
  } else {
    const int chunk = pn >> 1;
    if (dec && (chunk == 4 || chunk == 5)) {
      gemm_main<true, false>(A, 32, (size_t)NTOK * 32, B, 32, (size_t)5632 * 32, DM, acc);
      const f32x4* rope = (const f32x4*)(p.ws + OFF_ROPE);
#pragma unroll
      for (int mi = 0; mi < 8; ++mi) {
        const int s = (m0 - NCTX + wr * 128 + mi * 16 + fr) & 1023;
        const int prow = s >> 6, pcol = s & 63;
#pragma unroll
        for (int ax = 0; ax < 2; ++ax) {
          const int pos = ax ? pcol : prow;
          const f32x4 t0 = rope[pos * 8 + fq * 2], t1 = rope[pos * 8 + fq * 2 + 1];
          const float cs[4] = {t0[0], t0[2], t1[0], t1[2]}, sn[4] = {t0[1], t0[3], t1[1], t1[3]};
#pragma unroll
          for (int j = 0; j < 4; ++j) {
            const float x1 = acc[mi][ax * 2][j], x2 = acc[mi][ax * 2 + 1][j];
            acc[mi][ax * 2][j] = x1 * cs[j] - x2 * sn[j];
            acc[mi][ax * 2 + 1][j] = x2 * cs[j] + x1 * sn[j];
          }
        }
      }
      const int pc0 = nw + 4 * fq;
#pragma unroll
      for (int mi = 0; mi < 8; ++mi) {
        const int m = m0 + wr * 128 + mi * 16 + fr;
#pragma unroll
        for (int ni = 0; ni < 4; ++ni) *(u32x2*)(P + (size_t)m * LDP + pc0 + ni * 16) = pack4(acc[mi][ni]);
      }
    } else {
      gemm_main<true, true>(A, 32, (size_t)NTOK * 32, B, 32, (size_t)5632 * 32, DM, acc);
      const int pc0 = (nw < 3072 ? nw : nw - 512) + 8 * fq;
#pragma unroll
      for (int mi = 0; mi < 8; ++mi) {
        const int m = m0 + wr * 128 + mi * 16 + fr;
#pragma unroll
        for (int q = 0; q < 2; ++q) {
          u32x4 o; const u32x2 a = pack4(acc[mi][2 * q]), b = pack4(acc[mi][2 * q + 1]);
          o[0] = a.x; o[1] = a.y; o[2] = b.x; o[3] = b.y;
          *(u32x4*)(P + (size_t)m * LDP + pc0 + q * 32) = o;
        }
      }
      if (!dec && chunk == 5) {
        const int kc = nw - 2560, h = kc >> 7;
        const int b = m0 >> 8;
        float* nck = p.out + 33554432ull + ((size_t)((b * 2 + l) * 4 + h)) * 32768;
#pragma unroll
        for (int mi = 0; mi < 8; ++mi) {
          const int s = wr * 128 + mi * 16 + fr;
#pragma unroll
          for (int q = 0; q < 2; ++q) {
            float* dst = nck + (size_t)s * 128 + (kc & 127) + q * 32 + 8 * fq;
            *(f32x4*)dst = acc[mi][2 * q]; *(f32x4*)(dst + 4) = acc[mi][2 * q + 1];
          }
        }
      }
    }
  }
}

DI void g1_half_tile(const Params& p, int l, int ht) {
  const int t = 1280 + (ht >> 1), pm = t & 63, pn = t >> 6;
  const int tid = opaque_tid(), lane = tid & 63, wid = tid >> 6, wr = wid >> 2, wc = wid & 3, fr = lane & 15, fq = lane >> 4;
  const int m0 = pm * 256 + (ht & 1) * 128, nw = pn * 256 + wc * 64;
  const bf16_t* A = (const bf16_t*)(p.ws + OFF_H) + (size_t)m0 * 32;
  const bf16_t* B = (const bf16_t*)(p.ws + OFF_WINT) + (size_t)l * 5632 * 2048 + (size_t)pn * 256 * 32;
  bf16_t* P = (bf16_t*)(p.ws + OFF_P);
  f32x4 acc[4][4];
  gemm_main<true, true, 4>(A, 32, (size_t)NTOK * 32, B, 32, (size_t)5632 * 32, DM, acc);
  const int pc0 = (nw - 512) + 8 * fq;
#pragma unroll
  for (int mi = 0; mi < 4; ++mi) {
    const int m = m0 + wr * 64 + mi * 16 + fr;
#pragma unroll
    for (int q = 0; q < 2; ++q) {
      u32x4 o; const u32x2 a = pack4(acc[mi][2 * q]), b = pack4(acc[mi][2 * q + 1]);
      o[0] = a.x; o[1] = a.y; o[2] = b.x; o[3] = b.y;
      *(u32x4*)(P + (size_t)m * LDP + pc0 + q * 32) = o;
    }
  }
}

template <int MI = 8>
DI void gated_gemm_tile(const Params& p, const bf16_t* A, int lda, const bf16_t* B, int ldb, int K, int tok0, int ncol0, int gcol, int ycol, const float* colscale) {
  const int tid = opaque_tid(), lane = tid & 63, wid = tid >> 6, wr = wid >> 2, wc = wid & 3, fr = lane & 15, fq = lane >> 4;
  f32x4 acc[MI][4];
  gemm_main<true, true, MI>(A, lda, 32, B, ldb, 32, K, acc);
  const bf16_t* P = (const bf16_t*)(p.ws + OFF_P);
  bf16_t* Y = (bf16_t*)(p.ws + OFF_H);
#pragma unroll
  for (int q = 0; q < 2; ++q) {
    const int n = ncol0 + wc * 64 + q * 32 + 8 * fq;
    f32x4 cs0 = (f32x4){1.f, 1.f, 1.f, 1.f}, cs1 = cs0;
    if (colscale) { cs0 = *(const f32x4*)(colscale + n); cs1 = *(const f32x4*)(colscale + n + 4); }
#pragma unroll
    for (int mi = 0; mi < MI; ++mi) {
      const int tok = tok0 + wr * (MI * 16) + mi * 16 + fr;
      const u32x4 gw = *(const u32x4*)(P + (size_t)tok * LDP + gcol + n);
      const f32x4 a0 = acc[mi][2 * q], a1 = acc[mi][2 * q + 1];
      u32x4 o;
      o[0] = pack_bf16(a0[0] * cs0[0] * silu_f(bflo(gw[0])), a0[1] * cs0[1] * silu_f(bfhi(gw[0])));
      o[1] = pack_bf16(a0[2] * cs0[2] * silu_f(bflo(gw[1])), a0[3] * cs0[3] * silu_f(bfhi(gw[1])));
      o[2] = pack_bf16(a1[0] * cs1[0] * silu_f(bflo(gw[2])), a1[1] * cs1[1] * silu_f(bfhi(gw[2])));
      o[3] = pack_bf16(a1[2] * cs1[2] * silu_f(bflo(gw[3])), a1[3] * cs1[3] * silu_f(bfhi(gw[3])));
      *(u32x4*)(Y + slab_idx(tok, ycol + n, NTOK)) = o;
    }
  }
}

DI void z_tile(const Params& p, int l, int t) {
  const int pm = t & 63, pn = t >> 6;
  const int tid = opaque_tid(), lane = tid & 63, wid = tid >> 6, wr = wid >> 2, wc = wid & 3, fr = lane & 15, fq = lane >> 4;
  const bf16_t* A = (const bf16_t*)(p.ws + OFF_P) + (size_t)pm * 256 * LDP + PC_FX;
  const bf16_t* B = (const bf16_t*)(p.ws + OFF_WCST) + ((size_t)l * 1024 + pn * 256) * 512;
  f32x4 acc[8][4];
  gemm_main<false, false>(A, LDP, 32, B, 512, 32, 512, acc);
  bf16_t* ZT = (bf16_t*)(p.ws + OFF_ZT);
  const int m0 = pm * 256;
  int S, t0; size_t base;
  if (m0 < NCTX) { S = 256; t0 = 0; base = (size_t)(m0 >> 8) * 262144; }
  else { const int dm = m0 - NCTX; S = 1024; t0 = dm & 1023; base = 32ull * 262144 + (size_t)(dm >> 10) * 512 * LDZ; }
#pragma unroll
  for (int ni = 0; ni < 4; ++ni) {
    const int np = pn * 256 + wc * 64 + ni * 16 + fr, n = np & 511, half = np >> 9;
    bf16_t* row = ZT + base + (size_t)n * (S == 256 ? 512 : LDZ) + half * S + t0;
#pragma unroll
    for (int mi = 0; mi < 8; ++mi) *(u32x2*)(row + wr * 128 + mi * 16 + 4 * fq) = pack4(acc[mi][ni]);
  }
}

DI void out_tile(const Params& p, int l, int t) {
  const int pm = t & 63, pn = t >> 6;
  const int tid = opaque_tid(), lane = tid & 63, wid = tid >> 6, wr = wid >> 2, wc = wid & 3, fr = lane & 15, fq = lane >> 4;
  const bf16_t* A = (const bf16_t*)(p.ws + OFF_H) + (size_t)pm * 256 * 32;
  const bf16_t* B = (const bf16_t*)(p.ws + OFF_WOUTT) + (size_t)l * 2048 * 2048 + (size_t)pn * 256 * 32;
  f32x4 acc[8][4];
  gemm_main<true, true>(A, 32, (size_t)NTOK * 32, B, 32, (size_t)2048 * 32, DM, acc);
  const int m0 = pm * 256;
  const float* gate = (const float*)(p.ws + OFF_MODV) + (size_t)(l * 9 + cvec_of_row(m0)) * 6144 + 4096;
#pragma unroll
  for (int q = 0; q < 2; ++q) {
    const int n = pn * 256 + wc * 64 + q * 32 + 8 * fq;
    const f32x4 g0 = *(const f32x4*)(gate + n), g1 = *(const f32x4*)(gate + n + 4);
#pragma unroll
    for (int mi = 0; mi < 8; ++mi) {
      const int m = m0 + wr * 128 + mi * 16 + fr;
      const float* xin = ((l == 0) ? x_row_l0(p, m) : p.out + (size_t)m * DM) + n;
      const f32x4 x0 = *(const f32x4*)(xin), x1 = *(const f32x4*)(xin + 4);
      float* dst = p.out + (size_t)m * DM + n;
      *(f32x4*)dst = x0 + g0 * acc[mi][2 * q];
      *(f32x4*)(dst + 4) = x1 + g1 * acc[mi][2 * q + 1];
    }
  }
}

DI void seq_of_tok(int tok0, int& S, int& sbase) {
  if (tok0 < NCTX) { S = 256; sbase = tok0 & ~255; } else { S = 1024; sbase = NCTX + ((tok0 - NCTX) & ~1023); }
}

template <int W>
DI void pool_task(const bf16_t* base, int S, int sA, bf16_t* outp) {
  constexpr int HW = W / 2, NR = 7 + W;
  u32x4 rows[NR];
#pragma unroll
  for (int r = 0; r < NR; ++r) {
    const int s = sA - HW + r;
    const bool ok = (s >= 0) && (s < S);
    const u32x4 v = *(const u32x4*)(base + (size_t)min(max(s, 0), S - 1) * LDP);
#pragma unroll
    for (int e = 0; e < 4; ++e) rows[r][e] = ok ? v[e] : 0u;
  }
  float sum[8];
#pragma unroll
  for (int e = 0; e < 8; ++e) sum[e] = 0.f;
#pragma unroll
  for (int r = 0; r < W; ++r)
#pragma unroll
    for (int e = 0; e < 4; ++e) { sum[2 * e] += bflo(rows[r][e]); sum[2 * e + 1] += bfhi(rows[r][e]); }
#pragma unroll
  for (int k = 0; k < 8; ++k) {
    const int s = sA + k;
    const int lo = max(s - HW, 0), hi = min(s - HW + W, S);
    const float inv = 1.f / (float)(hi - lo);
    const u32x4 xv = rows[k + HW];
    u32x4 o4;
#pragma unroll
    for (int e = 0; e < 4; ++e) o4[e] = pack_bf16(sum[2 * e] * inv - bflo(xv[e]), sum[2 * e + 1] * inv - bfhi(xv[e]));
    *(u32x4*)(outp + (size_t)k * 512) = o4;
    if (k < 7) {
#pragma unroll
      for (int e = 0; e < 4; ++e) {
        sum[2 * e] += bflo(rows[k + W][e]) - bflo(rows[k][e]);
        sum[2 * e + 1] += bfhi(rows[k + W][e]) - bfhi(rows[k][e]);
      }
    }
  }
}

DI void pool_item(const Params& p, int t) {
  const int tid = half_tid(), tok0 = t * 32;
  int S, sbase; seq_of_tok(tok0, S, sbase);
  const int g = tid >> 6, run = (tid >> 4) & 3, c0 = g * 128 + (tid & 15) * 8;
  const int sA = tok0 - sbase + run * 8;
  const bf16_t* base = (const bf16_t*)(p.ws + OFF_P) + (size_t)sbase * LDP + PC_PX + c0;
  bf16_t* outp = (bf16_t*)(p.ws + OFF_POOLED) + (size_t)(sbase + sA) * 512 + c0;
  if (g == 0) pool_task<2>(base, S, sA, outp);
  else if (g == 1) pool_task<4>(base, S, sA, outp);
  else if (g == 2) pool_task<8>(base, S, sA, outp);
  else pool_task<16>(base, S, sA, outp);
}

DI void conv_item(const Params& p, int l, int t) {
  const int tid = half_tid(), lane = tid & 63, wid = tid >> 6, tok0 = t * 32;
  int S, sbase; seq_of_tok(tok0, S, sbase);
  const int s0 = tok0 - sbase;
  const bf16_t* P = (const bf16_t*)(p.ws + OFF_P);
  bf16_t* U = (bf16_t*)HSM;
  float* red = (float*)(HSM + 63488);
#pragma unroll 4
  for (int idx = tid; idx < 62 * 64; idx += 256) {
    const int rr = idx >> 6, ch = (idx & 63) * 8, s = s0 - 15 + rr;
    const bool ok = (s >= 0) && (s < S);
    const int sc = min(max(s, 0), S - 1);
    const bf16_t* row = P + (size_t)(sbase + sc) * LDP;
    const u32x4 a = *(const u32x4*)(row + PC_CA + ch), b = *(const u32x4*)(row + PC_CB + ch);
    u32x4 o;
#pragma unroll
    for (int e = 0; e < 4; ++e) { const unsigned v = pack_bf16(bflo(a[e]) * sigmoid_f(bflo(b[e])), bfhi(a[e]) * sigmoid_f(bfhi(b[e]))); o[e] = ok ? v : 0u; }
    *(u32x4*)(U + rr * 512 + ch) = o;
  }
  __syncthreads();
  const int c2 = tid * 2;
  float y0[32], y1[32];
  {
    const f32x2 bb = *(const f32x2*)(SMALLP(p, SM_DWB) + l * 512 + c2);
#pragma unroll
    for (int i = 0; i < 32; ++i) { y0[i] = bb.x; y1[i] = bb.y; }
  }
  const float* dw = SMALLP(p, SM_DW) + (size_t)l * 31 * 512 + c2;
  f32x2 wn = *(const f32x2*)dw;
#pragma unroll 1
  for (int j = 0; j < 31; ++j) {
    const f32x2 w = wn;
    if (j + 1 < 31) wn = *(const f32x2*)(dw + (j + 1) * 512);
    const unsigned wpk = pack_bf16(w.x, w.y), wlo = wpk & 0xffffu, whi = wpk & 0xffff0000u;
    const bf16_t* up = U + j * 512 + c2;
#pragma unroll
    for (int i = 0; i < 32; ++i) {
      const unsigned u = *(const unsigned*)(up + i * 512);
      y0[i] = dot2bf(u, wlo, y0[i]); y1[i] = dot2bf(u, whi, y1[i]);
    }
  }
#pragma unroll
  for (int i = 0; i < 32; ++i) {
    const float s1 = wave_sum_dpp(y0[i] + y1[i]);
    const float s2 = wave_sum_dpp(y0[i] * y0[i] + y1[i] * y1[i]);
    if (lane == 0) { red[(wid * 32 + i) * 2] = s1; red[(wid * 32 + i) * 2 + 1] = s2; }
  }
  __syncthreads();
  const f32x2 lg = *(const f32x2*)(SMALLP(p, SM_LNG) + l * 512 + c2), lb = *(const f32x2*)(SMALLP(p, SM_LNB) + l * 512 + c2);
  bf16_t* out = (bf16_t*)(p.ws + OFF_CONVACT);
#pragma unroll
  for (int i = 0; i < 32; ++i) {
    float s1 = 0.f, s2 = 0.f;
#pragma unroll
    for (int w = 0; w < 4; ++w) { s1 += red[(w * 32 + i) * 2]; s2 += red[(w * 32 + i) * 2 + 1]; }
    const float mean = s1 * (1.f / 512.f), var = s2 * (1.f / 512.f) - mean * mean, rstd = rsqrtf(var + EPS);
    const float a0 = silu_f((y0[i] - mean) * rstd * lg.x + lb.x), a1 = silu_f((y1[i] - mean) * rstd * lg.y + lb.y);
    *(unsigned*)(out + (size_t)(tok0 + i) * 512 + c2) = pack_bf16(a0, a1);
  }
}

DI void attn_item(const Params& p, int l, bool dec, int b, int h, int qt) {
  const int tid = half_tid(), lane = tid & 63, wid = tid >> 6, fr = lane & 15, fq = lane >> 4;
  const int S = dec ? 1024 : 256;
  const int tok0 = dec ? NCTX + b * 1024 : b * 256;
  const int nkt = dec ? 20 : 4, ncache = dec ? 4 : 0;
  const bf16_t* P = (const bf16_t*)(p.ws + OFF_P);
  const float lam_init = (l == 0) ? 0.2f : 0.35550906f;
  float lam;
  {
    const float* dl = SMALLP(p, SM_DLAM) + l * 256;
    const float a = wave_sum(dl[lane] * dl[64 + lane]), c = wave_sum(dl[128 + lane] * dl[192 + lane]);
    lam = __expf(a) - __expf(c) + lam_init;
  }
  const int q0 = qt * 64 + wid * 16;
  bf16x8 qf[2][2];
  {
    const bf16_t* qrow = P + (size_t)(tok0 + q0 + fr) * LDP + PC_Q + h * 128;
#pragma unroll
    for (int m = 0; m < 2; ++m)
#pragma unroll
      for (int ks = 0; ks < 2; ++ks) qf[m][ks] = *(const bf16x8*)(qrow + m * 64 + ks * 32 + fq * 8);
  }
  const size_t blh = (size_t)((b * 2 + l) * 4 + h);
  const bf16_t* kc = (const bf16_t*)(p.ws + OFF_KC) + blh * 32768;
  const bf16_t* vtc = (const bf16_t*)(p.ws + OFF_VTC) + blh * 32768;
  const bf16_t* kn = P + (size_t)tok0 * LDP + PC_K + h * 128;
  const bf16_t* vtn = (const bf16_t*)(p.ws + OFF_VTN) + (dec ? (size_t)32 * 131072 + (size_t)b * 524288 : (size_t)b * 131072) + (size_t)h * 128 * S;
  char* hb = HSM;
  const int kkey = lane >> 4, kpc = lane & 15;
  const int vrow = lane >> 3, vpc = lane & 7;
  auto issue_tile = [&](int kt, int buf) {
    char* kb = hb + buf * 32768 + lane * 16;
    const bf16_t* ksrc; size_t kstride; const bf16_t* vsrc; size_t vstride;
    if (kt < ncache) { ksrc = kc + (size_t)(kt * 64) * 128; kstride = 128; vsrc = vtc + kt * 64; vstride = 256; }
    else { const int kk = (kt - ncache) * 64; ksrc = kn + (size_t)kk * LDP; kstride = LDP; vsrc = vtn + kk; vstride = S; }
#pragma unroll
    for (int i = 0; i < 4; ++i) {
      const int pi = wid + 4 * i;
      const int key = pi * 4 + kkey;
      __builtin_amdgcn_global_load_lds((const unsigned*)(ksrc + (size_t)key * kstride + ((kpc ^ (key & 15)) * 8)), (LDSP)(kb + pi * 1024), 16, 0, 0);
    }
#pragma unroll
    for (int i = 0; i < 4; ++i) {
      const int pi = wid + 4 * i;
      const int dv = pi * 8 + vrow;
      __builtin_amdgcn_global_load_lds((const unsigned*)(vsrc + (size_t)dv * vstride + ((vpc ^ ((dv >> 1) & 7)) * 8)), (LDSP)(kb + 16384 + pi * 1024), 16, 0, 0);
    }
  };
  float m_run[2] = {-INFINITY, -INFINITY}, l_run[2] = {0.f, 0.f};
  f32x4 O[2][8];
#pragma unroll
  for (int m = 0; m < 2; ++m)
#pragma unroll
    for (int d = 0; d < 8; ++d) O[m][d] = (f32x4){0.f, 0.f, 0.f, 0.f};
  const float cexp = 0.125f * 1.4426950408889634f;
  const int vsw = (fr >> 1) & 7;
  issue_tile(0, 0);
#pragma unroll 1
  for (int kt = 0; kt < nkt; ++kt) {
    asm volatile("s_waitcnt vmcnt(0)" ::: "memory");
    __syncthreads();
    if (kt + 1 < nkt) issue_tile(kt + 1, (kt + 1) & 1);
    const char* Ks = hb + (kt & 1) * 32768;
    const char* Vs = Ks + 16384;
    bf16x8 pf[2][2];
#pragma unroll
    for (int m = 0; m < 2; ++m) {
      f32x4 s[4];
#pragma unroll
      for (int ksub = 0; ksub < 4; ++ksub) {
        f32x4 a = (f32x4){0.f, 0.f, 0.f, 0.f};
#pragma unroll
        for (int ks = 0; ks < 2; ++ks) {
          const bf16x8 kf = *(const bf16x8*)(Ks + (ksub * 16 + fr) * 256 + (((m * 8 + ks * 4 + fq) ^ fr) * 16));
          a = MFMA16(kf, qf[m][ks], a);
        }
        s[ksub] = a;
      }
      float mx = s[0][0];
#pragma unroll
      for (int ksub = 0; ksub < 4; ++ksub)
#pragma unroll
        for (int j = 0; j < 4; ++j) mx = fmaxf(mx, s[ksub][j]);
      mx = xrow_max(mx);
      const float mn = fmaxf(m_run[m], mx);
      const float alpha = __builtin_amdgcn_exp2f((m_run[m] - mn) * cexp);
      m_run[m] = mn;
      float ls = 0.f;
#pragma unroll
      for (int ksub = 0; ksub < 4; ++ksub)
#pragma unroll
        for (int j = 0; j < 4; ++j) { const float e = __builtin_amdgcn_exp2f((s[ksub][j] - mn) * cexp); s[ksub][j] = e; ls += e; }
      l_run[m] = l_run[m] * alpha + ls;
      if (__any(alpha != 1.f)) {
#pragma unroll
        for (int d = 0; d < 8; ++d) O[m][d] *= alpha;
      }
#pragma unroll
      for (int k2 = 0; k2 < 2; ++k2) {
        u32x4 w;
        w[0] = pack_bf16(s[2 * k2][0], s[2 * k2][1]); w[1] = pack_bf16(s[2 * k2][2], s[2 * k2][3]);
        w[2] = pack_bf16(s[2 * k2 + 1][0], s[2 * k2 + 1][1]); w[3] = pack_bf16(s[2 * k2 + 1][2], s[2 * k2 + 1][3]);
        pf[m][k2] = __builtin_bit_cast(bf16x8, w);
      }
      asm volatile("" ::: "memory");
    }
#pragma unroll
    for (int k2 = 0; k2 < 2; ++k2) {
      asm volatile("" ::: "memory");
#pragma unroll
      for (int d = 0; d < 8; ++d) {
        const char* vr = Vs + (d * 16 + fr) * 128 + (fq & 1) * 8;
        const int c1 = k2 * 4 + (fq >> 1);
        const s16x4 lo = *(const s16x4*)(vr + ((c1 ^ vsw) * 16)), hi = *(const s16x4*)(vr + (((c1 + 2) ^ vsw) * 16));
        const bf16x8 vf = __builtin_shufflevector(lo, hi, 0, 1, 2, 3, 4, 5, 6, 7);
        O[0][d] = MFMA16(vf, pf[0][k2], O[0][d]);
        O[1][d] = MFMA16(vf, pf[1][k2], O[1][d]);
      }
    }
  }
#pragma unroll
  for (int m = 0; m < 2; ++m) l_run[m] = xrow_sum(l_run[m]);
  const float inv1 = 1.f / l_run[0], inv2 = lam / l_run[1];
  float ss = 0.f;
#pragma unroll
  for (int d = 0; d < 8; ++d)
#pragma unroll
    for (int j = 0; j < 4; ++j) { const float o = O[0][d][j] * inv1 - O[1][d][j] * inv2; O[0][d][j] = o; ss += o * o; }
  ss = xrow_sum(ss);
  const float rstd = rsqrtf(ss * (1.f / 128.f) + EPS) * (1.f - lam_init);
  const int tok = tok0 + q0 + fr;
  bf16_t* Y = (bf16_t*)(p.ws + OFF_H);
#pragma unroll
  for (int d = 0; d < 8; ++d) {
    const int dv = d * 16 + 4 * fq;
    const f32x4 g4 = *(const f32x4*)(SMALLP(p, SM_SUBLN) + l * 128 + dv);
    const u32x2 gw = *(const u32x2*)(P + (size_t)tok * LDP + PC_AG + h * 128 + dv);
    f32x4 o;
    o[0] = O[0][d][0] * rstd * g4[0] * silu_f(bflo(gw.x));
    o[1] = O[0][d][1] * rstd * g4[1] * silu_f(bfhi(gw.x));
    o[2] = O[0][d][2] * rstd * g4[2] * silu_f(bflo(gw.y));
    o[3] = O[0][d][3] * rstd * g4[3] * silu_f(bfhi(gw.y));
    *(u32x2*)(Y + slab_idx(tok, 1024 + h * 128 + dv, NTOK)) = pack4(o);
  }
}

__global__ void __launch_bounds__(512, 2) fwd_megakernel(Params p) {
  cg::grid_group grid = cg::this_grid();
  unsigned* sync = (unsigned*)(p.ws + OFF_SYNC);
  unsigned* queues = (unsigned*)(p.ws + OFF_QUEUE);
  if (threadIdx.x == 0) { g_sh[1] = 0u; g_sh[2] = 0u; }
  __syncthreads();
  if (threadIdx.x == 0) (void)xb_add(&sync[XB_XCNT(xb_xcc_id())], 1u);
  if (p.never) grid.sync();
  phase0(p);
  grid_barrier(sync, 0);
  mod_reduce(p);
  grid_barrier(sync, 0);
  for (int l = 0; l < 2; ++l) {
    norm_phase(p, l);
    grid_barrier(sync, 0);
    for (int t = blockIdx.x; t < 1280; t += gridDim.x) g1_tile(p, l, t);
    for (int ht = blockIdx.x; ht < 256; ht += gridDim.x) g1_half_tile(p, l, ht);
    grid_barrier(sync, 0);
    {
      unsigned* q = queues + 64 * (l * 2);
      for (;;) {
        const int it = queue_next(q);
        if (it >= 1280) break;
        const int hf = half_id();
        if (it < 256) { const int a = it * 2 + hf; attn_item(p, l, true, a >> 6, (a >> 4) & 3, a & 15); }
        else if (it < 512) z_tile(p, l, it - 256);
        else if (it < 768) conv_item(p, l, (it - 512) * 2 + hf);
        else if (it < 1024) { const int a = (it - 768) * 2 + hf; attn_item(p, l, false, a >> 4, (a >> 2) & 3, a & 3); }
        else pool_item(p, (it - 1024) * 2 + hf);
      }
    }
    grid_barrier(sync, 0);
    {
      unsigned* q = queues + 64 * (1 + l * 2);
      for (;;) {
        const int it = queue_next(q);
        if (it >= 448) break;
        if (it < 128) {
          const int seq = it >> 4, mh = (it >> 1) & 7, nt = it & 1;
          gated_gemm_tile<4>(p, (const bf16_t*)(p.ws + OFF_DDEC) + (size_t)mh * 128 * LDD, LDD,
                             (const bf16_t*)(p.ws + OFF_ZT) + 32ull * 262144 + (size_t)seq * 512 * LDZ + (size_t)nt * 256 * LDZ, LDZ, 2048,
                             NCTX + seq * 1024 + mh * 128, nt * 256, PC_FG, 0, nullptr);
        } else if (it < 256) {
          const int t = it - 128, pm = t & 63, pn = t >> 6;
          gated_gemm_tile(p, (const bf16_t*)(p.ws + OFF_CONVACT) + (size_t)pm * 256 * 512, 512,
                          (const bf16_t*)(p.ws + OFF_WPWT) + ((size_t)l * 512 + pn * 256) * 512, 512, 512, pm * 256, pn * 256, PC_CG, 1536, nullptr);
        } else if (it < 320) {
          const int t = it - 256, seq = t >> 1, nt = t & 1;
          gated_gemm_tile(p, (const bf16_t*)(p.ws + OFF_DCTX), LDC, (const bf16_t*)(p.ws + OFF_ZT) + (size_t)seq * 262144 + (size_t)nt * 256 * 512, 512, 512,
                          seq * 256, nt * 256, PC_FG, 0, nullptr);
        } else {
          const int t = it - 320, pm = t & 63, pr = t >> 6;
          gated_gemm_tile(p, (const bf16_t*)(p.ws + OFF_POOLED) + (size_t)pm * 256 * 512 + pr * 256, 512,
                          (const bf16_t*)(p.ws + OFF_WPOOLT) + (size_t)(l * 2 + pr) * 65536, 256, 256, pm * 256, pr * 256, PC_PG, 512, SMALLP(p, SM_POOLSC) + l * 512);
        }
      }
    }
    grid_barrier(sync, 0);
    for (int t = blockIdx.x; t < 64 * 8; t += gridDim.x) out_tile(p, l, t);
    grid_barrier(sync, 0);
  }
  final_phase(p);
}

extern "C" void kernel_launch(void* const* d_in, const int* in_sizes, int n_in, void* d_out, int out_size, void* d_ws, size_t ws_size,
                              hipStream_t stream) {
  static int grid_blocks = 0;
  if (!grid_blocks) {
    int dev = 0, cus = 0, per_cu = 0;
    (void)hipGetDevice(&dev);
    (void)hipDeviceGetAttribute(&cus, hipDeviceAttributeMultiprocessorCount, dev);
    (void)hipFuncSetAttribute((const void*)fwd_megakernel, hipFuncAttributeMaxDynamicSharedMemorySize, (int)kDynLds);
    (void)hipOccupancyMaxActiveBlocksPerMultiprocessor(&per_cu, fwd_megakernel, 512, kDynLds);
    if (per_cu > 1) per_cu = 1;
    if (per_cu < 1) per_cu = 1;
    grid_blocks = cus * per_cu;
  }
  Params p{};
  const float** pp = (const float**)&p;
  for (int i = 0; i < 22; ++i) pp[i] = (const float*)d_in[i];
  p.out = (float*)d_out;
  p.ws = (unsigned char*)d_ws;
  (void)hipMemsetAsync(d_ws, 0, ZERO_BYTES, stream);
  void* args[] = {&p};
  hipError_t e = hipLaunchCooperativeKernel((void*)fwd_megakernel, dim3(grid_blocks), dim3(512), args, kDynLds, stream);
  if (e != hipSuccess) fprintf(stderr, "cooperative launch failed: %s (grid %d)\n", hipGetErrorString(e), grid_blocks);
}
```

```cpp
#include <hip/hip_runtime.h>
#include <hip/hip_cooperative_groups.h>
#include <stdint.h>
#include <cstdio>
namespace cg = cooperative_groups;

typedef unsigned short bf16_t;
typedef short bf16x8 __attribute__((ext_vector_type(8)));
typedef short s16x4 __attribute__((ext_vector_type(4)));
typedef float f32x4 __attribute__((ext_vector_type(4)));
typedef float f32x2 __attribute__((ext_vector_type(2)));
typedef unsigned u32x4 __attribute__((ext_vector_type(4)));
typedef unsigned u32x2 __attribute__((ext_vector_type(2)));
#define DI __device__ __forceinline__
#define LDSP __attribute__((address_space(3))) void*
#define MFMA16(a, b, c) __builtin_amdgcn_mfma_f32_16x16x32_bf16((a), (b), (c), 0, 0, 0)

constexpr int DM = 2048, NTOK = 16384, NCTX = 8192;
constexpr int LDP = 5120;
constexpr int PC_FX = 0, PC_FG = 512, PC_PX = 1024, PC_PG = 1536, PC_Q = 2048, PC_K = 2560, PC_AG = 3072, PC_CA = 3584, PC_CB = 4096, PC_CG = 4608;
constexpr float EPS = 1e-6f;
constexpr int LDD = 2112;
constexpr int LDZ = 2112;
constexpr int LDC = 576;

constexpr size_t OFF_SYNC = 0;
constexpr size_t OFF_QUEUE = 16384;
constexpr size_t OFF_MODV = 20480;
constexpr size_t SZ_MODV = 2ull * 9 * 6144 * 4;
constexpr size_t ZERO_BYTES = OFF_MODV + SZ_MODV;
constexpr size_t OFF_ROPE = ZERO_BYTES;
constexpr size_t OFF_P = OFF_ROPE + 8192;
constexpr size_t OFF_H = OFF_P + (size_t)NTOK * LDP * 2;
constexpr size_t OFF_ZT = OFF_H + (size_t)NTOK * DM * 2;
constexpr size_t OFF_VTN = OFF_ZT + (32ull * 262144 + 8ull * 512 * LDZ) * 2;
constexpr size_t OFF_POOLED = OFF_VTN + (size_t)NTOK * 512 * 2;
constexpr size_t OFF_CONVACT = OFF_POOLED + (size_t)NTOK * 512 * 2;
constexpr size_t OFF_WINT = OFF_CONVACT + (size_t)NTOK * 512 * 2;
constexpr size_t OFF_WOUTT = OFF_WINT + 2ull * 5632 * 2048 * 2;
constexpr size_t OFF_WCST = OFF_WOUTT + 2ull * 2048 * 2048 * 2;
constexpr size_t OFF_WPOOLT = OFF_WCST + 2ull * 1024 * 512 * 2;
constexpr size_t OFF_WPWT = OFF_WPOOLT + 2ull * 2 * 256 * 256 * 2;
constexpr size_t OFF_KC = OFF_WPWT + 2ull * 512 * 512 * 2;
constexpr size_t OFF_VTC = OFF_KC + 8ull * 2 * 4 * 256 * 128 * 2;
constexpr size_t OFF_DCTX = OFF_VTC + 8ull * 2 * 4 * 256 * 128 * 2;
constexpr size_t OFF_DDEC = OFF_DCTX + 256ull * LDC * 2;
constexpr size_t OFF_SMALL = OFF_DDEC + 1024ull * LDD * 2;
constexpr int SM_NORMG = 0, SM_POOLSC = 4096, SM_DLAM = 5120, SM_SUBLN = 5632, SM_DW = 5888, SM_DWB = 37632, SM_LNG = 38656, SM_LNB = 39680, SM_FINALG = 40704, SM_TOTAL = 42752;
constexpr size_t WS_TOTAL = OFF_SMALL + (size_t)SM_TOTAL * 4;
static_assert(WS_TOTAL <= 402653184ull, "workspace too large");

struct Params {
  const float *x_prompt, *x_sample, *cache_k, *cache_v, *c, *c_ctx, *norm_g, *w_mod, *b_mod, *w_in, *w_fourier, *w_pool,
      *pool_scale, *diff_lambda, *subln_g, *conv_dw, *conv_dw_b, *conv_ln_g, *conv_ln_b, *w_conv_pw, *w_out, *final_g;
  float* out;
  unsigned char* ws;
  unsigned long long never;
};

extern __shared__ __attribute__((aligned(16))) char g_smem[];
constexpr size_t kDynLds = 131072;
#define HSM (g_smem + (half_id() << 16))
__shared__ unsigned g_sh[4];

#define SMALLP(p, off) ((const float*)((p).ws + OFF_SMALL) + (off))
DI size_t slab_idx(int row, int col, int nrows) { return ((size_t)(col >> 5) * nrows + row) * 32 + (col & 31); }
DI float bf2f(unsigned u16) { return __uint_as_float(u16 << 16); }
DI float bflo(unsigned w) { return __uint_as_float(w << 16); }
DI float bfhi(unsigned w) { return __uint_as_float(w & 0xffff0000u); }
typedef __bf16 bf16v2_t __attribute__((ext_vector_type(2)));
DI unsigned pack_bf16(float lo, float hi) {
  const f32x2 v = {lo, hi};
  return __builtin_bit_cast(unsigned, __builtin_convertvector(v, bf16v2_t));
}
DI float silu_f(float x) { return x * __builtin_amdgcn_rcpf(1.f + __expf(-x)); }
DI float sigmoid_f(float x) { return __builtin_amdgcn_rcpf(1.f + __expf(-x)); }
DI int opaque_tid() { int t = threadIdx.x; asm volatile("" : "+v"(t)); return t; }
DI int half_tid() { return opaque_tid() & 255; }
DI int half_id() { return opaque_tid() >> 8; }
DI float wave_sum(float v) {
#pragma unroll
  for (int o = 32; o >= 1; o >>= 1) v += __shfl_xor(v, o);
  return v;
}
typedef __bf16 bf2_t __attribute__((ext_vector_type(2)));
DI float dot2bf(unsigned a, unsigned b, float c) { return __builtin_amdgcn_fdot2_f32_bf16(__builtin_bit_cast(bf2_t, a), __builtin_bit_cast(bf2_t, b), c, false); }
DI float xrow_max(float v) {
  u32x2 r = __builtin_amdgcn_permlane16_swap(__float_as_uint(v), __float_as_uint(v), false, false);
  v = fmaxf(__uint_as_float(r[0]), __uint_as_float(r[1]));
  r = __builtin_amdgcn_permlane32_swap(__float_as_uint(v), __float_as_uint(v), false, false);
  return fmaxf(__uint_as_float(r[0]), __uint_as_float(r[1]));
}
DI float xrow_sum(float v) {
  u32x2 r = __builtin_amdgcn_permlane16_swap(__float_as_uint(v), __float_as_uint(v), false, false);
  v = __uint_as_float(r[0]) + __uint_as_float(r[1]);
  r = __builtin_amdgcn_permlane32_swap(__float_as_uint(v), __float_as_uint(v), false, false);
  return __uint_as_float(r[0]) + __uint_as_float(r[1]);
}
DI u32x2 pack4(f32x4 v) { u32x2 r; r.x = pack_bf16(v[0], v[1]); r.y = pack_bf16(v[2], v[3]); return r; }

#define XB_TMO      128
#define XB_XCNT(j)  (256  + 64 * (j))
#define XB_XSUB(j)  (1280 + 64 * (j))
#define XB_XGEN(j)  (2304 + 64 * (j))
#define XB_TOP      3328
#define XB_TOPGEN   3392
#define XB_SPIN_CAP (1u << 20)
DI unsigned xb_ld(unsigned* p) { return __hip_atomic_load(p, __ATOMIC_RELAXED, __HIP_MEMORY_SCOPE_AGENT); }
DI unsigned xb_add(unsigned* p, unsigned v) { return __hip_atomic_fetch_add(p, v, __ATOMIC_RELAXED, __HIP_MEMORY_SCOPE_AGENT); }
DI unsigned xb_xcc_id() { return (unsigned)__builtin_amdgcn_s_getreg((3 << 11) | 20) & 0xFu; }
#define XB_SPIN(cond, bar) do { unsigned _sp = 0; while (cond) { __builtin_amdgcn_s_sleep(1); \
    if ((++_sp & 255u) == 0u) { if (xb_ld(&(bar)[XB_TMO])) break; if (_sp > XB_SPIN_CAP) { atomicAdd(&(bar)[XB_TMO], 1u); break; } } } } while (0)
DI void xcd_barrier_complete(unsigned* bar, unsigned x, unsigned& nloc, unsigned& nx) {
  const unsigned G = gridDim.x;
  unsigned sum, cnt, mine, sp = 0u;
  for (;;) {
    sum = 0u; cnt = 0u; mine = 0u;
#pragma unroll
    for (unsigned j = 0; j < 16; ++j) { const unsigned c = xb_ld(&bar[XB_XCNT(j)]); sum += c; cnt += (c > 0u) ? 1u : 0u; mine = (j == x) ? c : mine; }
    if (sum == G) break;
    __builtin_amdgcn_s_sleep(1);
    if ((++sp & 255u) == 0u) { if (xb_ld(&bar[XB_TMO])) break; if (sp > XB_SPIN_CAP) { atomicAdd(&bar[XB_TMO], 1u); break; } }
  }
  nloc = mine > 0u ? mine : 1u; nx = cnt > 0u ? cnt : 1u;
}
DI void grid_barrier(unsigned* bar, unsigned) {
  asm volatile("s_waitcnt vmcnt(0)" ::: "memory");
  __syncthreads();
  if (threadIdx.x == 0) {
    __builtin_amdgcn_s_waitcnt(0);
    const unsigned x = xb_xcc_id();
    volatile unsigned* st = g_sh;
    unsigned nloc = st[1], nx = st[2];
    if (nloc == 0u) { xcd_barrier_complete(bar, x, nloc, nx); st[1] = nloc; st[2] = nx; }
    const unsigned old = xb_add(&bar[XB_XSUB(x)], 1u);
    const unsigned gen = old / nloc;
    if (old + 1u == (gen + 1u) * nloc) {
      __builtin_amdgcn_fence(__ATOMIC_RELEASE, "agent");
      asm volatile("s_waitcnt vmcnt(0)" ::: "memory");
      const unsigned og = xb_add(&bar[XB_TOP], 1u);
      const unsigned tg = og / nx;
      if (og + 1u == (tg + 1u) * nx) xb_add(&bar[XB_TOPGEN], 1u);
      else XB_SPIN(xb_ld(&bar[XB_TOPGEN]) == tg, bar);
      __builtin_amdgcn_fence(__ATOMIC_ACQUIRE, "agent");
      xb_add(&bar[XB_XGEN(x)], 1u);
      asm volatile("s_waitcnt vmcnt(0)" ::: "memory");
    } else {
      XB_SPIN(xb_ld(&bar[XB_XGEN(x)]) == gen, bar);
      __builtin_amdgcn_fence(__ATOMIC_ACQUIRE, "agent");
      asm volatile("s_waitcnt vmcnt(0)" ::: "memory");
    }
  }
  __syncthreads();
}

DI int queue_next(unsigned* q) {
  __syncthreads();
  if (threadIdx.x == 0) g_sh[0] = __hip_atomic_fetch_add(q, 1u, __ATOMIC_RELAXED, __HIP_MEMORY_SCOPE_AGENT);
  __syncthreads();
  return (int)g_sh[0];
}

template <int CTRL, int ROWMASK> DI float dpp_add(float v) {
  const int t = __builtin_amdgcn_update_dpp(0, __float_as_int(v), CTRL, ROWMASK, 0xf, false);
  return v + __int_as_float(t);
}
DI float wave_sum_dpp(float v) {
  v = dpp_add<0x111, 0xf>(v); v = dpp_add<0x112, 0xf>(v); v = dpp_add<0x114, 0xf>(v); v = dpp_add<0x118, 0xf>(v);
  v = dpp_add<0x142, 0xa>(v); v = dpp_add<0x143, 0xc>(v);
  return __int_as_float(__builtin_amdgcn_readlane(__float_as_int(v), 63));
}

template <bool TRANS, bool PERM, int MI = 8>
DI void gemm_main(const bf16_t* A, int lda, size_t ksA, const bf16_t* B, int ldb, size_t ksB, int K, f32x4 (&acc)[MI][4]) {
  const int tid = opaque_tid(), lane = tid & 63, wid = tid >> 6, wr = wid >> 2, wc = wid & 3, fr = lane & 15, fq = lane >> 4;
  const int lrow = tid >> 2, lch = tid & 3;
  const int lsw = (lch ^ (((lrow >> 3) & 1) << 1)) * 8;
  const bf16_t* ga = A + (size_t)lrow * lda + lsw;
  const int rho = lrow & 31;
  const int lrow_b = PERM ? ((lrow & ~31) | (8 * ((rho & 15) >> 2) + 4 * (rho >> 4) + (rho & 3))) : lrow;
  const bf16_t* gb = B + (size_t)lrow_b * ldb + lsw;
  const size_t sa = (size_t)128 * lda, sb = (size_t)128 * ldb;
#pragma unroll
  for (int mi = 0; mi < MI; ++mi)
#pragma unroll
    for (int ni = 0; ni < 4; ++ni) acc[mi][ni] = (f32x4){0.f, 0.f, 0.f, 0.f};
  char* lbase = g_smem + tid * 16;
#define GLDS_ISSUE(STG)                                                                                              \
  do {                                                                                                               \
    char* l_ = lbase + (STG) * 32768;                                                                                \
    __builtin_amdgcn_global_load_lds((const unsigned*)(ga), (LDSP)(l_), 16, 0, 0);                                   \
    if (MI == 8) __builtin_amdgcn_global_load_lds((const unsigned*)(ga + sa), (LDSP)(l_ + 8192), 16, 0, 0);          \
    __builtin_amdgcn_global_load_lds((const unsigned*)(gb), (LDSP)(l_ + 16384), 16, 0, 0);                           \
    __builtin_amdgcn_global_load_lds((const unsigned*)(gb + sb), (LDSP)(l_ + 24576), 16, 0, 0);                      \
    ga += ksA; gb += ksB;                                                                                            \
  } while (0)
  asm volatile("s_waitcnt vmcnt(0)" ::: "memory");
  __syncthreads();
  const int nk = K >> 5;
  GLDS_ISSUE(0);
  GLDS_ISSUE(1);
  GLDS_ISSUE(2);
  const int rsw = (fq ^ (((fr >> 3) & 1) << 1)) * 16;
  const int aofs = (wr * (MI * 16) + fr) * 64 + rsw;
  const int bofs = 16384 + (wc * 64 + fr) * 64 + rsw;
  if (MI == 8) asm volatile("s_waitcnt vmcnt(8)" ::: "memory"); else asm volatile("s_waitcnt vmcnt(6)" ::: "memory");
  __builtin_amdgcn_s_barrier();
  if (wid >= 4) __builtin_amdgcn_s_barrier();
  int scur = 0, snxt = 3;
  for (int kt = 0; kt < nk; ++kt) {
    const char* st = g_smem + scur * 32768;
    bf16x8 af[MI], bfr[4];
#pragma unroll
    for (int mi = 0; mi < MI; ++mi) af[mi] = *(const bf16x8*)(st + aofs + mi * 1024);
#pragma unroll
    for (int ni = 0; ni < 4; ++ni) bfr[ni] = *(const bf16x8*)(st + bofs + ni * 1024);
    if (kt + 3 < nk) { GLDS_ISSUE(snxt); if (MI == 8) asm volatile("s_waitcnt vmcnt(8) lgkmcnt(0)" ::: "memory"); else asm volatile("s_waitcnt vmcnt(6) lgkmcnt(0)" ::: "memory"); }
    else if (kt + 2 < nk) { if (MI == 8) asm volatile("s_waitcnt vmcnt(4) lgkmcnt(0)" ::: "memory"); else asm volatile("s_waitcnt vmcnt(3) lgkmcnt(0)" ::: "memory"); }
    else asm volatile("s_waitcnt vmcnt(0) lgkmcnt(0)" ::: "memory");
    __builtin_amdgcn_sched_barrier(0);
    __builtin_amdgcn_s_barrier();
    __builtin_amdgcn_sched_barrier(0);
#pragma unroll
    for (int mi = 0; mi < MI; ++mi)
#pragma unroll
      for (int ni = 0; ni < 4; ++ni)
        acc[mi][ni] = TRANS ? MFMA16(bfr[ni], af[mi], acc[mi][ni]) : MFMA16(af[mi], bfr[ni], acc[mi][ni]);
    __builtin_amdgcn_sched_barrier(0);
    __builtin_amdgcn_s_barrier();
    __builtin_amdgcn_sched_barrier(0);
    scur = (scur + 1) & 3;
    snxt = (snxt + 1) & 3;
  }
  if (wid < 4) __builtin_amdgcn_s_barrier();
#undef GLDS_ISSUE
}

DI void transpose_tile(const float* src, int ldn, bf16_t* dst, int ldk, int k0, int n0, int slab_rows = 0) {
  float* t = (float*)HSM;
  const int tid = half_tid();
  __syncthreads();
  f32x4 v[8];
#pragma unroll
  for (int i = 0; i < 8; ++i) {
    const int idx = tid + i * 256, r = idx >> 5, c4 = (idx & 31) * 4;
    v[i] = *(const f32x4*)(src + (size_t)(k0 + r) * ldn + n0 + c4);
  }
#pragma unroll
  for (int i = 0; i < 8; ++i) {
    const int idx = tid + i * 256, r = idx >> 5, c4 = (idx & 31) * 4;
    t[r * 129 + c4 + 0] = v[i][0]; t[r * 129 + c4 + 1] = v[i][1]; t[r * 129 + c4 + 2] = v[i][2]; t[r * 129 + c4 + 3] = v[i][3];
  }
  __syncthreads();
#pragma unroll
  for (int i = 0; i < 4; ++i) {
    const int idx = tid + i * 256, n = idx >> 3, kc = (idx & 7) * 8;
    u32x4 o;
    o[0] = pack_bf16(t[(kc + 0) * 129 + n], t[(kc + 1) * 129 + n]);
    o[1] = pack_bf16(t[(kc + 2) * 129 + n], t[(kc + 3) * 129 + n]);
    o[2] = pack_bf16(t[(kc + 4) * 129 + n], t[(kc + 5) * 129 + n]);
    o[3] = pack_bf16(t[(kc + 6) * 129 + n], t[(kc + 7) * 129 + n]);
    if (slab_rows) *(u32x4*)(dst + slab_idx(n0 + n, k0 + kc, slab_rows)) = o;
    else *(u32x4*)(dst + (size_t)(n0 + n) * ldk + k0 + kc) = o;
  }
}

DI void mod_item(const Params& p, int it) {
  const int tid = half_tid();
  const int l = it / 192, r = it % 192, kc = r / 6, cb = r % 6;
  float* sl = (float*)HSM;
  __syncthreads();
  for (int idx = tid; idx < 576; idx += 256) {
    const int j = idx >> 6, k = idx & 63;
    const float* src = (j == 0) ? p.c_ctx : p.c + (j - 1) * 2048;
    sl[idx] = silu_f(src[kc * 64 + k]);
  }
  __syncthreads();
  const int col = cb * 1024 + tid * 4;
  f32x4 acc[9];
#pragma unroll
  for (int j = 0; j < 9; ++j) acc[j] = (f32x4){0.f, 0.f, 0.f, 0.f};
  const float* w = p.w_mod + ((size_t)l * 2048 + kc * 64) * 6144 + col;
#pragma unroll 4
  for (int k = 0; k < 64; ++k) {
    const f32x4 wv = *(const f32x4*)(w + (size_t)k * 6144);
#pragma unroll
    for (int j = 0; j < 9; ++j) acc[j] += wv * sl[j * 64 + k];
  }
  float* part = p.out + (size_t)(kc * 18 + l * 9) * 6144 + col;
#pragma unroll
  for (int j = 0; j < 9; ++j) *(f32x4*)(part + (size_t)j * 6144) = acc[j];
}

DI void mod_reduce(const Params& p) {
  float* modv = (float*)(p.ws + OFF_MODV);
  for (int e = (blockIdx.x * 512 + opaque_tid()) * 4; e < 18 * 6144; e += gridDim.x * 512 * 4) {
    const int lj = e / 6144, col = e - lj * 6144, l = lj / 9;
    f32x4 a = *(const f32x4*)(p.b_mod + l * 6144 + col);
#pragma unroll 8
    for (int kc = 0; kc < 32; ++kc) a += *(const f32x4*)(p.out + (size_t)kc * 18 * 6144 + e);
    *(f32x4*)(modv + e) = a;
  }
}

DI void fourier_fold_item(const Params& p, int it) {
  const int tid = half_tid();
  const int l = it >> 10, r = it & 1023, k = r >> 1, nb = r & 1;
  const int g = k >> 7, c = k & 127, n = nb * 256 + tid;
  float* tab = (float*)HSM;
  __syncthreads();
  if (tid < 128) { const float rev = (float)tid * (1.f / 128.f); tab[tid] = __builtin_amdgcn_cosf(rev); tab[128 + tid] = __builtin_amdgcn_sinf(rev); }
  __syncthreads();
  const float* w = p.w_fourier + ((size_t)(l * 512 + g * 128)) * 512 + n;
  float ac = 0.f, as = 0.f;
#pragma unroll 16
  for (int j = 0; j < 128; ++j) { const float wv = w[(size_t)j * 512]; const int ti = (c * j) & 127; ac += tab[ti] * wv; as += tab[128 + ti] * wv; }
  bf16_t* dst = (bf16_t*)(p.ws + OFF_WCST);
  dst[((size_t)(l * 1024 + n)) * 512 + k] = (bf16_t)(pack_bf16(ac * 0.08838834764831845f, 0.f) & 0xffffu);
  dst[((size_t)(l * 1024 + 512 + n)) * 512 + k] = (bf16_t)(pack_bf16(as * 0.08838834764831845f, 0.f) & 0xffffu);
}

DI void phase0(const Params& p) {
  const int tid = half_tid();
  constexpr int N_MOD = 384, N_WIN = 2816, N_WOUT = 1024, N_WPW = 64, N_WPOOL = 128, N_CV = 256, N_CK = 1024, N_DCTX = 64, N_DDEC = 1024, N_ROPE = 2, N_FF = 2048, N_SM = 24;
  constexpr int E0 = N_MOD, E1 = E0 + N_WIN, E2 = E1 + N_WOUT, E3 = E2 + N_WPW, E4 = E3 + N_WPOOL, E5 = E4 + N_CV, E6 = E5 + N_CK, E7 = E6 + N_DCTX,
                E8 = E7 + N_DDEC, E9 = E8 + N_ROPE, E10 = E9 + N_FF, E11 = E10 + N_SM;
  for (int itp = blockIdx.x; itp < E11 / 2; itp += gridDim.x) {
    const int it = itp * 2 + half_id();
    if (it < E0) {
      mod_item(p, it);
    } else if (it < E1) {
      const int t = it - E0, l = t / 1408, r = t % 1408, kt = r / 44, nt = r % 44;
      transpose_tile(p.w_in + (size_t)l * 2048 * 5632, 5632, (bf16_t*)(p.ws + OFF_WINT) + (size_t)l * 5632 * 2048, 2048, kt * 64, nt * 128, 5632);
    } else if (it < E2) {
      const int t = it - E1, l = t >> 9, r = t & 511, kt = r >> 4, nt = r & 15;
      transpose_tile(p.w_out + (size_t)l * 2048 * 2048, 2048, (bf16_t*)(p.ws + OFF_WOUTT) + (size_t)l * 2048 * 2048, 2048, kt * 64, nt * 128, 2048);
    } else if (it < E3) {
      const int t = it - E2, l = t >> 5, r = t & 31, kt = r >> 2, nt = r & 3;
      transpose_tile(p.w_conv_pw + (size_t)l * 512 * 512, 512, (bf16_t*)(p.ws + OFF_WPWT) + (size_t)l * 512 * 512, 512, kt * 64, nt * 128);
    } else if (it < E4) {
      const int t = it - E3, lp = t >> 5;
      const int e0 = (t & 31) * 2048 + tid * 8, n = e0 >> 8, k0 = e0 & 255;
      const int g = (lp & 1) * 2 + (n >> 7);
      u32x4 o = (u32x4){0u, 0u, 0u, 0u};
      if ((k0 >> 7) == (n >> 7)) {
        const float* w = p.w_pool + ((size_t)((lp >> 1) * 4 + g) * 128 + (k0 & 127)) * 128 + (n & 127);
#pragma unroll
        for (int e = 0; e < 4; ++e) o[e] = pack_bf16(w[(size_t)(2 * e) * 128], w[(size_t)(2 * e + 1) * 128]);
      }
      *(u32x4*)((bf16_t*)(p.ws + OFF_WPOOLT) + (size_t)lp * 65536 + e0) = o;
    } else if (it < E5) {
      const int t = it - E4, blh = t >> 2, kt = t & 3;
      transpose_tile(p.cache_v + (size_t)blh * 256 * 128, 128, (bf16_t*)(p.ws + OFF_VTC) + (size_t)blh * 128 * 256, 256, kt * 64, 0);
    } else if (it < E6) {
      const size_t e = (size_t)(it - E5) * 2048 + tid * 8;
      const f32x4 a = *(const f32x4*)(p.cache_k + e), b = *(const f32x4*)(p.cache_k + e + 4);
      u32x4 o; o[0] = pack_bf16(a[0], a[1]); o[1] = pack_bf16(a[2], a[3]); o[2] = pack_bf16(b[0], b[1]); o[3] = pack_bf16(b[2], b[3]);
      *(u32x4*)((bf16_t*)(p.ws + OFF_KC) + e) = o;
    } else if (it < E8) {
      const bool dec = it >= E7;
      const int e0 = (dec ? it - E7 : it - E6) * 2048 + tid * 8;
      const int S = dec ? 1024 : 256, sh = dec ? 11 : 9;
      const float nrm = dec ? 0.03125f : 0.0625f, invS = dec ? (1.f / 1024.f) : (1.f / 256.f);
      float v[8];
#pragma unroll
      for (int i = 0; i < 8; ++i) {
        const int e = e0 + i, t = e & (2 * S - 1);
        const int s = e >> sh;
        const int tt = t & (S - 1);
        const float rev = (float)((s * tt) & (S - 1)) * invS;
        v[i] = (t < S) ? __builtin_amdgcn_cosf(rev) * nrm : -__builtin_amdgcn_sinf(rev) * nrm;
      }
      u32x4 o; o[0] = pack_bf16(v[0], v[1]); o[1] = pack_bf16(v[2], v[3]); o[2] = pack_bf16(v[4], v[5]); o[3] = pack_bf16(v[6], v[7]);
      *(u32x4*)((bf16_t*)(p.ws + (dec ? OFF_DDEC : OFF_DCTX)) + (size_t)(e0 >> sh) * (dec ? LDD : LDC) + (e0 & (2 * S - 1))) = o;
    } else if (it < E9) {
      f32x2* rope = (f32x2*)(p.ws + OFF_ROPE);
#pragma unroll
      for (int i = 0; i < 4; ++i) {
        const int idx = tid + i * 256, pos = idx >> 4, f = idx & 15;
        const float inv = exp2f(-(float)f * (13.287712379549449f / 16.f));
        const float ang = (float)pos * inv;
        float rev = ang * 0.15915494309189535f;
        rev -= floorf(rev);
        f32x2 cs; cs.x = __builtin_amdgcn_cosf(rev); cs.y = __builtin_amdgcn_sinf(rev);
        rope[idx] = cs;
      }
    } else if (it < E10) {
      fourier_fold_item(p, it - E9);
    } else {
      const int j = it - E10;
      const float* src; int n, off;
      if (j >= 4 && j < 20) { src = p.conv_dw + (j - 4) * 1984; n = 1984; off = SM_DW + (j - 4) * 1984; }
      else switch (j) {
        case 0: src = p.norm_g; n = 4096; off = SM_NORMG; break;
        case 1: src = p.pool_scale; n = 1024; off = SM_POOLSC; break;
        case 2: src = p.diff_lambda; n = 512; off = SM_DLAM; break;
        case 3: src = p.subln_g; n = 256; off = SM_SUBLN; break;
        case 20: src = p.conv_dw_b; n = 1024; off = SM_DWB; break;
        case 21: src = p.conv_ln_g; n = 1024; off = SM_LNG; break;
        case 22: src = p.conv_ln_b; n = 1024; off = SM_LNB; break;
        default: src = p.final_g; n = 2048; off = SM_FINALG; break;
      }
      float* dst = (float*)(p.ws + OFF_SMALL) + off;
#pragma unroll
      for (int i = 0; i < 4; ++i) { const int e = (tid + i * 256) * 4; if (e < n) *(f32x4*)(dst + e) = *(const f32x4*)(src + e); }
    }
  }
}

DI const float* x_row_l0(const Params& p, int m) { return (m < NCTX) ? p.x_prompt + (size_t)m * DM : p.x_sample + (size_t)(m - NCTX) * DM; }
DI int cvec_of_row(int m) { return (m < NCTX) ? 0 : 1 + ((m - NCTX) >> 10); }

DI void norm_phase(const Params& p, int l) {
  const int tid_ = opaque_tid(); const int lane = tid_ & 63, wid = tid_ >> 6;
  const int rr = lane >> 5, q = lane & 31;
  bf16_t* H = (bf16_t*)(p.ws + OFF_H);
  const float* modv = (const float*)(p.ws + OFF_MODV);
  const float* g = SMALLP(p, SM_NORMG) + l * DM;
  const int step = gridDim.x * 8;
  int mp = blockIdx.x * 8 + wid;
  f32x4 v[16], vn[16];
  auto load_pair = [&](int mpair, f32x4 (&d)[16]) {
    const int m = mpair * 2 + rr;
    const float* x = (l == 0) ? x_row_l0(p, m) : p.out + (size_t)m * DM;
#pragma unroll
    for (int i = 0; i < 8; ++i) { const int c = i * 256 + q * 8; d[2 * i] = *(const f32x4*)(x + c); d[2 * i + 1] = *(const f32x4*)(x + c + 4); }
  };
  if (mp < NTOK / 2) load_pair(mp, v);
  for (; mp < NTOK / 2; mp += step) {
    const bool more = (mp + step < NTOK / 2);
    if (more) load_pair(mp + step, vn);
    const int m = mp * 2 + rr;
    const float* mv = modv + (size_t)(l * 9 + cvec_of_row(m)) * 6144;
    float ss = 0.f;
#pragma unroll
    for (int i = 0; i < 16; ++i)
#pragma unroll
      for (int e = 0; e < 4; ++e) ss += v[i][e] * v[i][e];
#pragma unroll
    for (int o = 16; o >= 1; o >>= 1) ss += __shfl_xor(ss, o);
    const float rstd = rsqrtf(ss * (1.f / 2048.f) + EPS);
#pragma unroll
    for (int i = 0; i < 8; ++i) {
      const int c = i * 256 + q * 8;
      u32x4 o4;
#pragma unroll
      for (int hh = 0; hh < 2; ++hh) {
        const f32x4 gg = *(const f32x4*)(g + c + 4 * hh), sh = *(const f32x4*)(mv + c + 4 * hh), sc = *(const f32x4*)(mv + 2048 + c + 4 * hh);
        f32x4 h;
#pragma unroll
        for (int e = 0; e < 4; ++e) h[e] = v[2 * i + hh][e] * rstd * gg[e] * (1.f + sc[e]) + sh[e];
        o4[2 * hh] = pack_bf16(h[0], h[1]); o4[2 * hh + 1] = pack_bf16(h[2], h[3]);
      }
      *(u32x4*)(H + slab_idx(m, c, NTOK)) = o4;
    }
    if (more) {
#pragma unroll
      for (int i = 0; i < 16; ++i) v[i] = vn[i];
    }
  }
}

DI void final_phase(const Params& p) {
  const int tid_ = opaque_tid(); const int lane = tid_ & 63, wid = tid_ >> 6;
  const int step = gridDim.x * 8;
  int m = blockIdx.x * 8 + wid;
  f32x4 v[8], vn[8];
  if (m < NTOK) {
#pragma unroll
    for (int i = 0; i < 8; ++i) v[i] = *(const f32x4*)(p.out + (size_t)m * DM + (i * 64 + lane) * 4);
  }
  for (; m < NTOK; m += step) {
    const bool more = (m + step < NTOK);
    if (more) {
#pragma unroll
      for (int i = 0; i < 8; ++i) vn[i] = *(const f32x4*)(p.out + (size_t)(m + step) * DM + (i * 64 + lane) * 4);
    }
    float* x = p.out + (size_t)m * DM;
    float ss = 0.f;
#pragma unroll
    for (int i = 0; i < 8; ++i) ss += v[i][0] * v[i][0] + v[i][1] * v[i][1] + v[i][2] * v[i][2] + v[i][3] * v[i][3];
    ss = wave_sum(ss);
    const float rstd = rsqrtf(ss * (1.f / 2048.f) + EPS);
#pragma unroll
    for (int i = 0; i < 8; ++i) {
      const int c = (i * 64 + lane) * 4;
      const f32x4 gg = *(const f32x4*)(SMALLP(p, SM_FINALG) + c);
      f32x4 h;
#pragma unroll
      for (int e = 0; e < 4; ++e) h[e] = v[i][e] * rstd * gg[e];
      *(f32x4*)(x + c) = h;
    }
    if (more) {
#pragma unroll
      for (int i = 0; i < 8; ++i) v[i] = vn[i];
    }
  }
}

DI void g1_tile(const Params& p, int l, int t) {
  const int pm = t & 63, pn = t >> 6;
  const int tid = opaque_tid(), lane = tid & 63, wid = tid >> 6, wr = wid >> 2, wc = wid & 3, fr = lane & 15, fq = lane >> 4;
  const bf16_t* A = (const bf16_t*)(p.ws + OFF_H) + (size_t)pm * 256 * 32;
  const bf16_t* B = (const bf16_t*)(p.ws + OFF_WINT) + (size_t)l * 5632 * 2048 + (size_t)pn * 256 * 32;
  bf16_t* P = (bf16_t*)(p.ws + OFF_P);
  const int m0 = pm * 256, n0 = pn * 256;
  const int nw = n0 + wc * 64;
  const bool dec = m0 >= NCTX;
  f32x4 acc[8][4];
  if (pn == 12 || pn == 13) {
    gemm_main<false, false>(A, 32, (size_t)NTOK * 32, B, 32, (size_t)5632 * 32, DM, acc);
    const int vc = nw - 3072, h = vc >> 7;
    bf16_t* vtn = (bf16_t*)(p.ws + OFF_VTN);
    int S, s0; size_t vbase; int b;
    if (!dec) { b = m0 >> 8; S = 256; s0 = 0; vbase = (size_t)b * 131072; }
    else { const int dm = m0 - NCTX; b = dm >> 10; S = 1024; s0 = dm & 1023; vbase = (size_t)32 * 131072 + (size_t)b * 524288; }
    float* ncv = p.out + 41943040ull + ((size_t)((b * 2 + l) * 4 + h)) * 32768;
#pragma unroll
    for (int mi = 0; mi < 8; ++mi)
#pragma unroll
      for (int ni = 0; ni < 4; ++ni) {
        const int s = s0 + wr * 128 + mi * 16 + 4 * fq, dv = (vc & 127) + ni * 16 + fr;
        *(u32x2*)(vtn + vbase + (size_t)(h * 128 + dv) * S + s) = pack4(acc[mi][ni]);
        if (!dec) {
#pragma unroll
          for (int j = 0; j < 4; ++j) ncv[(size_t)(s + j) * 128 + dv] = acc[mi][ni][j];
        }
      }
  } else {
    const int chunk = pn >> 1;
    if (dec && (chunk == 4 || chunk == 5)) {
      gemm_main<true, false>(A, 32, (size_t)NTOK * 32, B, 32, (size_t)5632 * 32, DM, acc);
      const f32x4* rope = (const f32x4*)(p.ws + OFF_ROPE);
#pragma unroll
      for (int mi = 0; mi < 8; ++mi) {
        const int s = (m0 - NCTX + wr * 128 + mi * 16 + fr) & 1023;
        const int prow = s >> 6, pcol = s & 63;
#pragma unroll
        for (int ax = 0; ax < 2; ++ax) {
          const int pos = ax ? pcol : prow;
          const f32x4 t0 = rope[pos * 8 + fq * 2], t1 = rope[pos * 8 + fq * 2 + 1];
          const float cs[4] = {t0[0], t0[2], t1[0], t1[2]}, sn[4] = {t0[1], t0[3], t1[1], t1[3]};
#pragma unroll
          for (int j = 0; j < 4; ++j) {
            const float x1 = acc[mi][ax * 2][j], x2 = acc[mi][ax * 2 + 1][j];
            acc[mi][ax * 2][j] = x1 * cs[j] - x2 * sn[j];
            acc[mi][ax * 2 + 1][j] = x2 * cs[j] + x1 * sn[j];
          }
        }
      }
      const int pc0 = nw + 4 * fq;
#pragma unroll
      for (int mi = 0; mi < 8; ++mi) {
        const int m = m0 + wr * 128 + mi * 16 + fr;
#pragma unroll
        for (int ni = 0; ni < 4; ++ni) *(u32x2*)(P + (size_t)m * LDP + pc0 + ni * 16) = pack4(acc[mi][ni]);
      }
    } else {
      gemm_main<true, true>(A, 32, (size_t)NTOK * 32, B, 32, (size_t)5632 * 32, DM, acc);
      const int pc0 = (nw < 3072 ? nw : nw - 512) + 8 * fq;
#pragma unroll
      for (int mi = 0; mi < 8; ++mi) {
        const int m = m0 + wr * 128 + mi * 16 + fr;
#pragma unroll
        for (int q = 0; q < 2; ++q) {
          u32x4 o; const u32x2 a = pack4(acc[mi][2 * q]), b = pack4(acc[mi][2 * q + 1]);
          o[0] = a.x; o[1] = a.y; o[2] = b.x; o[3] = b.y;
          *(u32x4*)(P + (size_t)m * LDP + pc0 + q * 32) = o;
        }
      }
      if (!dec && chunk == 5) {
        const int kc = nw - 2560, h = kc >> 7;
        const int b = m0 >> 8;
        float* nck = p.out + 33554432ull + ((size_t)((b * 2 + l) * 4 + h)) * 32768;
#pragma unroll
        for (int mi = 0; mi < 8; ++mi) {
          const int s = wr * 128 + mi * 16 + fr;
#pragma unroll
          for (int q = 0; q < 2; ++q) {
            float* dst = nck + (size_t)s * 128 + (kc & 127) + q * 32 + 8 * fq;
            *(f32x4*)dst = acc[mi][2 * q]; *(f32x4*)(dst + 4) = acc[mi][2 * q + 1];
          }
        }
      }
    }
  }
}

DI void g1_half_tile(const Params& p, int l, int ht) {
  const int t = 1280 + (ht >> 1), pm = t & 63, pn = t >> 6;
  const int tid = opaque_tid(), lane = tid & 63, wid = tid >> 6, wr = wid >> 2, wc = wid & 3, fr = lane & 15, fq = lane >> 4;
  const int m0 = pm * 256 + (ht & 1) * 128, nw = pn * 256 + wc * 64;
  const bf16_t* A = (const bf16_t*)(p.ws + OFF_H) + (size_t)m0 * 32;
  const bf16_t* B = (const bf16_t*)(p.ws + OFF_WINT) + (size_t)l * 5632 * 2048 + (size_t)pn * 256 * 32;
  bf16_t* P = (bf16_t*)(p.ws + OFF_P);
  f32x4 acc[4][4];
  gemm_main<true, true, 4>(A, 32, (size_t)NTOK * 32, B, 32, (size_t)5632 * 32, DM, acc);
  const int pc0 = (nw - 512) + 8 * fq;
#pragma unroll
  for (int mi = 0; mi < 4; ++mi) {
    const int m = m0 + wr * 64 + mi * 16 + fr;
#pragma unroll
    for (int q = 0; q < 2; ++q) {
      u32x4 o; const u32x2 a = pack4(acc[mi][2 * q]), b = pack4(acc[mi][2 * q + 1]);
      o[0] = a.x; o[1] = a.y; o[2] = b.x; o[3] = b.y;
      *(u32x4*)(P + (size_t)m * LDP + pc0 + q * 32) = o;
    }
  }
}

template <int MI = 8>
DI void gated_gemm_tile(const Params& p, const bf16_t* A, int lda, const bf16_t* B, int ldb, int K, int tok0, int ncol0, int gcol, int ycol, const float* colscale) {
  const int tid = opaque_tid(), lane = tid & 63, wid = tid >> 6, wr = wid >> 2, wc = wid & 3, fr = lane & 15, fq = lane >> 4;
  f32x4 acc[MI][4];
  gemm_main<true, true, MI>(A, lda, 32, B, ldb, 32, K, acc);
  const bf16_t* P = (const bf16_t*)(p.ws + OFF_P);
  bf16_t* Y = (bf16_t*)(p.ws + OFF_H);
#pragma unroll
  for (int q = 0; q < 2; ++q) {
    const int n = ncol0 + wc * 64 + q * 32 + 8 * fq;
    f32x4 cs0 = (f32x4){1.f, 1.f, 1.f, 1.f}, cs1 = cs0;
    if (colscale) { cs0 = *(const f32x4*)(colscale + n); cs1 = *(const f32x4*)(colscale + n + 4); }
#pragma unroll
    for (int mi = 0; mi < MI; ++mi) {
      const int tok = tok0 + wr * (MI * 16) + mi * 16 + fr;
      const u32x4 gw = *(const u32x4*)(P + (size_t)tok * LDP + gcol + n);
      const f32x4 a0 = acc[mi][2 * q], a1 = acc[mi][2 * q + 1];
      u32x4 o;
      o[0] = pack_bf16(a0[0] * cs0[0] * silu_f(bflo(gw[0])), a0[1] * cs0[1] * silu_f(bfhi(gw[0])));
      o[1] = pack_bf16(a0[2] * cs0[2] * silu_f(bflo(gw[1])), a0[3] * cs0[3] * silu_f(bfhi(gw[1])));
      o[2] = pack_bf16(a1[0] * cs1[0] * silu_f(bflo(gw[2])), a1[1] * cs1[1] * silu_f(bfhi(gw[2])));
      o[3] = pack_bf16(a1[2] * cs1[2] * silu_f(bflo(gw[3])), a1[3] * cs1[3] * silu_f(bfhi(gw[3])));
      *(u32x4*)(Y + slab_idx(tok, ycol + n, NTOK)) = o;
    }
  }
}

DI void z_tile(const Params& p, int l, int t) {
  const int pm = t & 63, pn = t >> 6;
  const int tid = opaque_tid(), lane = tid & 63, wid = tid >> 6, wr = wid >> 2, wc = wid & 3, fr = lane & 15, fq = lane >> 4;
  const bf16_t* A = (const bf16_t*)(p.ws + OFF_P) + (size_t)pm * 256 * LDP + PC_FX;
  const bf16_t* B = (const bf16_t*)(p.ws + OFF_WCST) + ((size_t)l * 1024 + pn * 256) * 512;
  f32x4 acc[8][4];
  gemm_main<false, false>(A, LDP, 32, B, 512, 32, 512, acc);
  bf16_t* ZT = (bf16_t*)(p.ws + OFF_ZT);
  const int m0 = pm * 256;
  int S, t0; size_t base;
  if (m0 < NCTX) { S = 256; t0 = 0; base = (size_t)(m0 >> 8) * 262144; }
  else { const int dm = m0 - NCTX; S = 1024; t0 = dm & 1023; base = 32ull * 262144 + (size_t)(dm >> 10) * 512 * LDZ; }
#pragma unroll
  for (int ni = 0; ni < 4; ++ni) {
    const int np = pn * 256 + wc * 64 + ni * 16 + fr, n = np & 511, half = np >> 9;
    bf16_t* row = ZT + base + (size_t)n * (S == 256 ? 512 : LDZ) + half * S + t0;
#pragma unroll
    for (int mi = 0; mi < 8; ++mi) *(u32x2*)(row + wr * 128 + mi * 16 + 4 * fq) = pack4(acc[mi][ni]);
  }
}

DI void out_tile(const Params& p, int l, int t) {
  const int pm = t & 63, pn = t >> 6;
  const int tid = opaque_tid(), lane = tid & 63, wid = tid >> 6, wr = wid >> 2, wc = wid & 3, fr = lane & 15, fq = lane >> 4;
  const bf16_t* A = (const bf16_t*)(p.ws + OFF_H) + (size_t)pm * 256 * 32;
  const bf16_t* B = (const bf16_t*)(p.ws + OFF_WOUTT) + (size_t)l * 2048 * 2048 + (size_t)pn * 256 * 32;
  f32x4 acc[8][4];
  gemm_main<true, true>(A, 32, (size_t)NTOK * 32, B, 32, (size_t)2048 * 32, DM, acc);
  const int m0 = pm * 256;
  const float* gate = (const float*)(p.ws + OFF_MODV) + (size_t)(l * 9 + cvec_of_row(m0)) * 6144 + 4096;
#pragma unroll
  for (int q = 0; q < 2; ++q) {
    const int n = pn * 256 + wc * 64 + q * 32 + 8 * fq;
    const f32x4 g0 = *(const f32x4*)(gate + n), g1 = *(const f32x4*)(gate + n + 4);
#pragma unroll
    for (int mi = 0; mi < 8; ++mi) {
      const int m = m0 + wr * 128 + mi * 16 + fr;
      const float* xin = ((l == 0) ? x_row_l0(p, m) : p.out + (size_t)m * DM) + n;
      const f32x4 x0 = *(const f32x4*)(xin), x1 = *(const f32x4*)(xin + 4);
      float* dst = p.out + (size_t)m * DM + n;
      *(f32x4*)dst = x0 + g0 * acc[mi][2 * q];
      *(f32x4*)(dst + 4) = x1 + g1 * acc[mi][2 * q + 1];
    }
  }
}

DI void seq_of_tok(int tok0, int& S, int& sbase) {
  if (tok0 < NCTX) { S = 256; sbase = tok0 & ~255; } else { S = 1024; sbase = NCTX + ((tok0 - NCTX) & ~1023); }
}

template <int W>
DI void pool_task(const bf16_t* base, int S, int sA, bf16_t* outp) {
  constexpr int HW = W / 2, NR = 7 + W;
  u32x4 rows[NR];
#pragma unroll
  for (int r = 0; r < NR; ++r) {
    const int s = sA - HW + r;
    const bool ok = (s >= 0) && (s < S);
    const u32x4 v = *(const u32x4*)(base + (size_t)min(max(s, 0), S - 1) * LDP);
#pragma unroll
    for (int e = 0; e < 4; ++e) rows[r][e] = ok ? v[e] : 0u;
  }
  float sum[8];
#pragma unroll
  for (int e = 0; e < 8; ++e) sum[e] = 0.f;
#pragma unroll
  for (int r = 0; r < W; ++r)
#pragma unroll
    for (int e = 0; e < 4; ++e) { sum[2 * e] += bflo(rows[r][e]); sum[2 * e + 1] += bfhi(rows[r][e]); }
#pragma unroll
  for (int k = 0; k < 8; ++k) {
    const int s = sA + k;
    const int lo = max(s - HW, 0), hi = min(s - HW + W, S);
    const float inv = 1.f / (float)(hi - lo);
    const u32x4 xv = rows[k + HW];
    u32x4 o4;
#pragma unroll
    for (int e = 0; e < 4; ++e) o4[e] = pack_bf16(sum[2 * e] * inv - bflo(xv[e]), sum[2 * e + 1] * inv - bfhi(xv[e]));
    *(u32x4*)(outp + (size_t)k * 512) = o4;
    if (k < 7) {
#pragma unroll
      for (int e = 0; e < 4; ++e) {
        sum[2 * e] += bflo(rows[k + W][e]) - bflo(rows[k][e]);
        sum[2 * e + 1] += bfhi(rows[k + W][e]) - bfhi(rows[k][e]);
      }
    }
  }
}

DI void pool_item(const Params& p, int t) {
  const int tid = half_tid(), tok0 = t * 32;
  int S, sbase; seq_of_tok(tok0, S, sbase);
  const int g = tid >> 6, run = (tid >> 4) & 3, c0 = g * 128 + (tid & 15) * 8;
  const int sA = tok0 - sbase + run * 8;
  const bf16_t* base = (const bf16_t*)(p.ws + OFF_P) + (size_t)sbase * LDP + PC_PX + c0;
  bf16_t* outp = (bf16_t*)(p.ws + OFF_POOLED) + (size_t)(sbase + sA) * 512 + c0;
  if (g == 0) pool_task<2>(base, S, sA, outp);
  else if (g == 1) pool_task<4>(base, S, sA, outp);
  else if (g == 2) pool_task<8>(base, S, sA, outp);
  else pool_task<16>(base, S, sA, outp);
}

DI void conv_item(const Params& p, int l, int t) {
  const int tid = half_tid(), lane = tid & 63, wid = tid >> 6, tok0 = t * 32;
  int S, sbase; seq_of_tok(tok0, S, sbase);
  const int s0 = tok0 - sbase;
  const bf16_t* P = (const bf16_t*)(p.ws + OFF_P);
  bf16_t* U = (bf16_t*)HSM;
  float* red = (float*)(HSM + 63488);
#pragma unroll 4
  for (int idx = tid; idx < 62 * 64; idx += 256) {
    const int rr = idx >> 6, ch = (idx & 63) * 8, s = s0 - 15 + rr;
    const bool ok = (s >= 0) && (s < S);
    const int sc = min(max(s, 0), S - 1);
    const bf16_t* row = P + (size_t)(sbase + sc) * LDP;
    const u32x4 a = *(const u32x4*)(row + PC_CA + ch), b = *(const u32x4*)(row + PC_CB + ch);
    u32x4 o;
#pragma unroll
    for (int e = 0; e < 4; ++e) { const unsigned v = pack_bf16(bflo(a[e]) * sigmoid_f(bflo(b[e])), bfhi(a[e]) * sigmoid_f(bfhi(b[e]))); o[e] = ok ? v : 0u; }
    *(u32x4*)(U + rr * 512 + ch) = o;
  }
  __syncthreads();
  const int c2 = tid * 2;
  float y0[32], y1[32];
  {
    const f32x2 bb = *(const f32x2*)(SMALLP(p, SM_DWB) + l * 512 + c2);
#pragma unroll
    for (int i = 0; i < 32; ++i) { y0[i] = bb.x; y1[i] = bb.y; }
  }
  const float* dw = SMALLP(p, SM_DW) + (size_t)l * 31 * 512 + c2;
  f32x2 wn = *(const f32x2*)dw;
#pragma unroll 1
  for (int j = 0; j < 31; ++j) {
    const f32x2 w = wn;
    if (j + 1 < 31) wn = *(const f32x2*)(dw + (j + 1) * 512);
    const unsigned wpk = pack_bf16(w.x, w.y), wlo = wpk & 0xffffu, whi = wpk & 0xffff0000u;
    const bf16_t* up = U + j * 512 + c2;
#pragma unroll
    for (int i = 0; i < 32; ++i) {
      const unsigned u = *(const unsigned*)(up + i * 512);
      y0[i] = dot2bf(u, wlo, y0[i]); y1[i] = dot2bf(u, whi, y1[i]);
    }
  }
#pragma unroll
  for (int i = 0; i < 32; ++i) {
    const float s1 = wave_sum_dpp(y0[i] + y1[i]);
    const float s2 = wave_sum_dpp(y0[i] * y0[i] + y1[i] * y1[i]);
    if (lane == 0) { red[(wid * 32 + i) * 2] = s1; red[(wid * 32 + i) * 2 + 1] = s2; }
  }
  __syncthreads();
  const f32x2 lg = *(const f32x2*)(SMALLP(p, SM_LNG) + l * 512 + c2), lb = *(const f32x2*)(SMALLP(p, SM_LNB) + l * 512 + c2);
  bf16_t* out = (bf16_t*)(p.ws + OFF_CONVACT);
#pragma unroll
  for (int i = 0; i < 32; ++i) {
    float s1 = 0.f, s2 = 0.f;
#pragma unroll
    for (int w = 0; w < 4; ++w) { s1 += red[(w * 32 + i) * 2]; s2 += red[(w * 32 + i) * 2 + 1]; }
    const float mean = s1 * (1.f / 512.f), var = s2 * (1.f / 512.f) - mean * mean, rstd = rsqrtf(var + EPS);
    const float a0 = silu_f((y0[i] - mean) * rstd * lg.x + lb.x), a1 = silu_f((y1[i] - mean) * rstd * lg.y + lb.y);
    *(unsigned*)(out + (size_t)(tok0 + i) * 512 + c2) = pack_bf16(a0, a1);
  }
}

DI void attn_item(const Params& p, int l, bool dec, int b, int h, int qt) {
  const int tid = half_tid(), lane = tid & 63, wid = tid >> 6, fr = lane & 15, fq = lane >> 4;
  const int S = dec ? 1024 : 256;
  const int tok0 = dec ? NCTX + b * 1024 : b * 256;
  const int nkt = dec ? 20 : 4, ncache = dec ? 4 : 0;
  const bf16_t* P = (const bf16_t*)(p.ws + OFF_P);
  const float lam_init = (l == 0) ? 0.2f : 0.35550906f;
  float lam;
  {
    const float* dl = SMALLP(p, SM_DLAM) + l * 256;
    const float a = wave_sum(dl[lane] * dl[64 + lane]), c = wave_sum(dl[128 + lane] * dl[192 + lane]);
    lam = __expf(a) - __expf(c) + lam_init;
  }
  const int q0 = qt * 64 + wid * 16;
  bf16x8 qf[2][2];
  {
    const bf16_t* qrow = P + (size_t)(tok0 + q0 + fr) * LDP + PC_Q + h * 128;
#pragma unroll
    for (int m = 0; m < 2; ++m)
#pragma unroll
      for (int ks = 0; ks < 2; ++ks) qf[m][ks] = *(const bf16x8*)(qrow + m * 64 + ks * 32 + fq * 8);
  }
  const size_t blh = (size_t)((b * 2 + l) * 4 + h);
  const bf16_t* kc = (const bf16_t*)(p.ws + OFF_KC) + blh * 32768;
  const bf16_t* vtc = (const bf16_t*)(p.ws + OFF_VTC) + blh * 32768;
  const bf16_t* kn = P + (size_t)tok0 * LDP + PC_K + h * 128;
  const bf16_t* vtn = (const bf16_t*)(p.ws + OFF_VTN) + (dec ? (size_t)32 * 131072 + (size_t)b * 524288 : (size_t)b * 131072) + (size_t)h * 128 * S;
  char* hb = HSM;
  const int kkey = lane >> 4, kpc = lane & 15;
  const int vrow = lane >> 3, vpc = lane & 7;
  auto issue_tile = [&](int kt, int buf) {
    char* kb = hb + buf * 32768 + lane * 16;
    const bf16_t* ksrc; size_t kstride; const bf16_t* vsrc; size_t vstride;
    if (kt < ncache) { ksrc = kc + (size_t)(kt * 64) * 128; kstride = 128; vsrc = vtc + kt * 64; vstride = 256; }
    else { const int kk = (kt - ncache) * 64; ksrc = kn + (size_t)kk * LDP; kstride = LDP; vsrc = vtn + kk; vstride = S; }
#pragma unroll
    for (int i = 0; i < 4; ++i) {
      const int pi = wid + 4 * i;
      const int key = pi * 4 + kkey;
      __builtin_amdgcn_global_load_lds((const unsigned*)(ksrc + (size_t)key * kstride + ((kpc ^ (key & 15)) * 8)), (LDSP)(kb + pi * 1024), 16, 0, 0);
    }
#pragma unroll
    for (int i = 0; i < 4; ++i) {
      const int pi = wid + 4 * i;
      const int dv = pi * 8 + vrow;
      __builtin_amdgcn_global_load_lds((const unsigned*)(vsrc + (size_t)dv * vstride + ((vpc ^ ((dv >> 1) & 7)) * 8)), (LDSP)(kb + 16384 + pi * 1024), 16, 0, 0);
    }
  };
  float m_run[2] = {-INFINITY, -INFINITY}, l_run[2] = {0.f, 0.f};
  f32x4 O[2][8];
#pragma unroll
  for (int m = 0; m < 2; ++m)
#pragma unroll
    for (int d = 0; d < 8; ++d) O[m][d] = (f32x4){0.f, 0.f, 0.f, 0.f};
  const float cexp = 0.125f * 1.4426950408889634f;
  const int vsw = (fr >> 1) & 7;
  issue_tile(0, 0);
#pragma unroll 1
  for (int kt = 0; kt < nkt; ++kt) {
    asm volatile("s_waitcnt vmcnt(0)" ::: "memory");
    __syncthreads();
    if (kt + 1 < nkt) issue_tile(kt + 1, (kt + 1) & 1);
    const char* Ks = hb + (kt & 1) * 32768;
    const char* Vs = Ks + 16384;
    bf16x8 pf[2][2];
#pragma unroll
    for (int m = 0; m < 2; ++m) {
      f32x4 s[4];
#pragma unroll
      for (int ksub = 0; ksub < 4; ++ksub) {
        f32x4 a = (f32x4){0.f, 0.f, 0.f, 0.f};
#pragma unroll
        for (int ks = 0; ks < 2; ++ks) {
          const bf16x8 kf = *(const bf16x8*)(Ks + (ksub * 16 + fr) * 256 + (((m * 8 + ks * 4 + fq) ^ fr) * 16));
          a = MFMA16(kf, qf[m][ks], a);
        }
        s[ksub] = a;
      }
      float mx = s[0][0];
#pragma unroll
      for (int ksub = 0; ksub < 4; ++ksub)
#pragma unroll
        for (int j = 0; j < 4; ++j) mx = fmaxf(mx, s[ksub][j]);
      mx = xrow_max(mx);
      const float mn = fmaxf(m_run[m], mx);
      const float alpha = __builtin_amdgcn_exp2f((m_run[m] - mn) * cexp);
      m_run[m] = mn;
      float ls = 0.f;
#pragma unroll
      for (int ksub = 0; ksub < 4; ++ksub)
#pragma unroll
        for (int j = 0; j < 4; ++j) { float e = __builtin_amdgcn_exp2f((s[ksub][j] - mn) * cexp); asm("" : "+v"(e)); s[ksub][j] = e; ls += e; }
      l_run[m] = l_run[m] * alpha + ls;
      if (__any(alpha != 1.f)) {
#pragma unroll
        for (int d = 0; d < 8; ++d) O[m][d] *= alpha;
      }
#pragma unroll
      for (int k2 = 0; k2 < 2; ++k2) {
        u32x4 w;
        w[0] = pack_bf16(s[2 * k2][0], s[2 * k2][1]); w[1] = pack_bf16(s[2 * k2][2], s[2 * k2][3]);
        w[2] = pack_bf16(s[2 * k2 + 1][0], s[2 * k2 + 1][1]); w[3] = pack_bf16(s[2 * k2 + 1][2], s[2 * k2 + 1][3]);
        pf[m][k2] = __builtin_bit_cast(bf16x8, w);
      }
      asm volatile("" ::: "memory");
    }
#pragma unroll
    for (int k2 = 0; k2 < 2; ++k2) {
      asm volatile("" ::: "memory");
#pragma unroll
      for (int d = 0; d < 8; ++d) {
        const char* vr = Vs + (d * 16 + fr) * 128 + (fq & 1) * 8;
        const int c1 = k2 * 4 + (fq >> 1);
        const s16x4 lo = *(const s16x4*)(vr + ((c1 ^ vsw) * 16)), hi = *(const s16x4*)(vr + (((c1 + 2) ^ vsw) * 16));
        const bf16x8 vf = __builtin_shufflevector(lo, hi, 0, 1, 2, 3, 4, 5, 6, 7);
        O[0][d] = MFMA16(vf, pf[0][k2], O[0][d]);
        O[1][d] = MFMA16(vf, pf[1][k2], O[1][d]);
      }
    }
  }
#pragma unroll
  for (int m = 0; m < 2; ++m) l_run[m] = xrow_sum(l_run[m]);
  const float inv1 = 1.f / l_run[0], inv2 = lam / l_run[1];
  float ss = 0.f;
#pragma unroll
  for (int d = 0; d < 8; ++d)
#pragma unroll
    for (int j = 0; j < 4; ++j) { const float o = O[0][d][j] * inv1 - O[1][d][j] * inv2; O[0][d][j] = o; ss += o * o; }
  ss = xrow_sum(ss);
  const float rstd = rsqrtf(ss * (1.f / 128.f) + EPS) * (1.f - lam_init);
  const int tok = tok0 + q0 + fr;
  bf16_t* Y = (bf16_t*)(p.ws + OFF_H);
#pragma unroll
  for (int d = 0; d < 8; ++d) {
    const int dv = d * 16 + 4 * fq;
    const f32x4 g4 = *(const f32x4*)(SMALLP(p, SM_SUBLN) + l * 128 + dv);
    const u32x2 gw = *(const u32x2*)(P + (size_t)tok * LDP + PC_AG + h * 128 + dv);
    f32x4 o;
    o[0] = O[0][d][0] * rstd * g4[0] * silu_f(bflo(gw.x));
    o[1] = O[0][d][1] * rstd * g4[1] * silu_f(bfhi(gw.x));
    o[2] = O[0][d][2] * rstd * g4[2] * silu_f(bflo(gw.y));
    o[3] = O[0][d][3] * rstd * g4[3] * silu_f(bfhi(gw.y));
    *(u32x2*)(Y + slab_idx(tok, 1024 + h * 128 + dv, NTOK)) = pack4(o);
  }
}

__global__ void __launch_bounds__(512, 2) fwd_megakernel(Params p) {
  cg::grid_group grid = cg::this_grid();
  unsigned* sync = (unsigned*)(p.ws + OFF_SYNC);
  unsigned* queues = (unsigned*)(p.ws + OFF_QUEUE);
  if (threadIdx.x == 0) { g_sh[1] = 0u; g_sh[2] = 0u; }
  __syncthreads();
  if (threadIdx.x == 0) (void)xb_add(&sync[XB_XCNT(xb_xcc_id())], 1u);
  if (p.never) grid.sync();
  phase0(p);
  grid_barrier(sync, 0);
  mod_reduce(p);
  grid_barrier(sync, 0);
  for (int l = 0; l < 2; ++l) {
    norm_phase(p, l);
    grid_barrier(sync, 0);
    for (int t = blockIdx.x; t < 1280; t += gridDim.x) g1_tile(p, l, t);
    for (int ht = blockIdx.x; ht < 256; ht += gridDim.x) g1_half_tile(p, l, ht);
    grid_barrier(sync, 0);
    {
      unsigned* q = queues + 64 * (l * 2);
      for (;;) {
        const int it = queue_next(q);
        if (it >= 1280) break;
        const int hf = half_id();
        if (it < 256) { const int a = it * 2 + hf; attn_item(p, l, true, a >> 6, (a >> 4) & 3, a & 15); }
        else if (it < 512) z_tile(p, l, it - 256);
        else if (it < 768) conv_item(p, l, (it - 512) * 2 + hf);
        else if (it < 1024) { const int a = (it - 768) * 2 + hf; attn_item(p, l, false, a >> 4, (a >> 2) & 3, a & 3); }
        else pool_item(p, (it - 1024) * 2 + hf);
      }
    }
    grid_barrier(sync, 0);
    {
      unsigned* q = queues + 64 * (1 + l * 2);
      for (;;) {
        const int it = queue_next(q);
        if (it >= 448) break;
        if (it < 128) {
          const int seq = it >> 4, mh = (it >> 1) & 7, nt = it & 1;
          gated_gemm_tile<4>(p, (const bf16_t*)(p.ws + OFF_DDEC) + (size_t)mh * 128 * LDD, LDD,
                             (const bf16_t*)(p.ws + OFF_ZT) + 32ull * 262144 + (size_t)seq * 512 * LDZ + (size_t)nt * 256 * LDZ, LDZ, 2048,
                             NCTX + seq * 1024 + mh * 128, nt * 256, PC_FG, 0, nullptr);
        } else if (it < 256) {
          const int t = it - 128, pm = t & 63, pn = t >> 6;
          gated_gemm_tile(p, (const bf16_t*)(p.ws + OFF_CONVACT) + (size_t)pm * 256 * 512, 512,
                          (const bf16_t*)(p.ws + OFF_WPWT) + ((size_t)l * 512 + pn * 256) * 512, 512, 512, pm * 256, pn * 256, PC_CG, 1536, nullptr);
        } else if (it < 320) {
          const int t = it - 256, seq = t >> 1, nt = t & 1;
          gated_gemm_tile(p, (const bf16_t*)(p.ws + OFF_DCTX), LDC, (const bf16_t*)(p.ws + OFF_ZT) + (size_t)seq * 262144 + (size_t)nt * 256 * 512, 512, 512,
                          seq * 256, nt * 256, PC_FG, 0, nullptr);
        } else {
          const int t = it - 320, pm = t & 63, pr = t >> 6;
          gated_gemm_tile(p, (const bf16_t*)(p.ws + OFF_POOLED) + (size_t)pm * 256 * 512 + pr * 256, 512,
                          (const bf16_t*)(p.ws + OFF_WPOOLT) + (size_t)(l * 2 + pr) * 65536, 256, 256, pm * 256, pr * 256, PC_PG, 512, SMALLP(p, SM_POOLSC) + l * 512);
        }
      }
    }
    grid_barrier(sync, 0);
    for (int t = blockIdx.x; t < 64 * 8; t += gridDim.x) out_tile(p, l, t);
    grid_barrier(sync, 0);
  }
  final_phase(p);
}

extern "C" void kernel_launch(void* const* d_in, const int* in_sizes, int n_in, void* d_out, int out_size, void* d_ws, size_t ws_size,
                              hipStream_t stream) {
  static int grid_blocks = 0;
  if (!grid_blocks) {
    int dev = 0, cus = 0, per_cu = 0;
    (void)hipGetDevice(&dev);
    (void)hipDeviceGetAttribute(&cus, hipDeviceAttributeMultiprocessorCount, dev);
    (void)hipFuncSetAttribute((const void*)fwd_megakernel, hipFuncAttributeMaxDynamicSharedMemorySize, (int)kDynLds);
    (void)hipOccupancyMaxActiveBlocksPerMultiprocessor(&per_cu, fwd_megakernel, 512, kDynLds);
    if (per_cu > 1) per_cu = 1;
    if (per_cu < 1) per_cu = 1;
    grid_blocks = cus * per_cu;
  }
  Params p{};
  const float** pp = (const float**)&p;
  for (int i = 0; i < 22; ++i) pp[i] = (const float*)d_in[i];
  p.out = (float*)d_out;
  p.ws = (unsigned char*)d_ws;
  (void)hipMemsetAsync(d_ws, 0, ZERO_BYTES, stream);
  void* args[] = {&p};
  hipError_t e = hipLaunchCooperativeKernel((void*)fwd_megakernel, dim3(grid_blocks), dim3(512), args, kDynLds, stream);
  if (e != hipSuccess) fprintf(stderr, "cooperative launch failed: %s (grid %d)\n", hipGetErrorString(e), grid_blocks);
}
```
